# Optimizing an MI355X kernel written in HIP

```python
import jax, jax.numpy as jnp
from jax import lax
import numpy as np

D_MODEL = 1024
BATCH = 8
SEQ = 2048
DEPTH = 4

HEAD_DIM = 64
N_HEADS_TOTAL = D_MODEL // HEAD_DIM
N_HEADS_SB = N_HEADS_TOTAL // 4
N_HEADS_MOBA = N_HEADS_TOTAL // 2
N_GROUPS_GMLP = N_HEADS_TOTAL - N_HEADS_SB - N_HEADS_MOBA
W_SB = N_HEADS_SB * HEAD_DIM
W_MOBA = N_HEADS_MOBA * HEAD_DIM
W_GMLP = N_GROUPS_GMLP * HEAD_DIM
D_MIX = W_SB + W_MOBA + W_GMLP
IN_COLS = 3 * W_SB + 3 * W_MOBA + 2 * W_GMLP

SB_Q_BLOCK = 128
MOBA_BLOCK = 256
MOBA_TOPK = 3
MOBA_Q_CHUNK = 16
GMLP_CHUNK = 128
ROPE_THETA = 500000.0
ROT_DIM = HEAD_DIM // 4

N_EXPERT_GROUPS = 4
EXPERTS_PER_GROUP = 8
N_EXPERTS = N_EXPERT_GROUPS * EXPERTS_PER_GROUP
D_EXPERT = D_MODEL // 2
MOE_TOP_K = 2
MOE_BLOCK = 256
NORM_EPS = 1e-6
OUT_SCALE = (2 * DEPTH) ** -0.5

kernel_name = "hybrid_stickbreak_moba_gmlp_hmoe"


def _rmsnorm(x, g):
    xf = x.astype(jnp.float32)
    y = xf * lax.rsqrt(jnp.mean(xf * xf, axis=-1, keepdims=True) + NORM_EPS)
    return y.astype(x.dtype) * g


def _partial_rope(x, positions):
    half = ROT_DIM // 2
    inv_freq = jnp.power(ROPE_THETA, -jnp.arange(half, dtype=jnp.float32) / half)
    ang = positions.astype(jnp.float32)[..., None] * inv_freq
    cos = jnp.cos(ang)[:, :, None, :]
    sin = jnp.sin(ang)[:, :, None, :]
    xr = x[..., :ROT_DIM].astype(jnp.float32)
    x1, x2 = xr[..., :half], xr[..., half:]
    rot = jnp.concatenate([x1 * cos - x2 * sin, x2 * cos + x1 * sin], axis=-1)
    return jnp.concatenate([rot.astype(x.dtype), x[..., ROT_DIM:]], axis=-1)


def _stick_breaking_attention(q, k, v):
    S = q.shape[1]
    scale = HEAD_DIM ** -0.5
    outs = []
    for i in range(S // SB_Q_BLOCK):
        t0 = i * SB_Q_BLOCK
        end = t0 + SB_Q_BLOCK
        z = jnp.einsum('bthd,bshd->bhts', q[:, t0:end], k[:, :end]).astype(jnp.float32) * scale
        t_pos = t0 + jnp.arange(SB_Q_BLOCK)
        s_pos = jnp.arange(end)
        causal = s_pos[None, :] < t_pos[:, None]
        log_rest = jnp.where(causal, jax.nn.log_sigmoid(-z), 0.0)
        log_after = lax.cumsum(log_rest, axis=3, reverse=True) - log_rest
        w = jnp.where(causal, jnp.exp(jax.nn.log_sigmoid(z) + log_after), 0.0)
        outs.append(jnp.einsum('bhts,bshd->bthd', w.astype(v.dtype), v[:, :end]))
    return jnp.concatenate(outs, axis=1)


def _moba_attention(q, k, v):
    B, S, H, d = q.shape
    n_blk = -(-S // MOBA_BLOCK)
    s_pad = n_blk * MOBA_BLOCK
    topk = min(MOBA_TOPK, max(n_blk - 1, 1))
    scale = HEAD_DIM ** -0.5
    neg = jnp.float32(-1e30)
    qt = q.transpose(0, 2, 1, 3)
    pad = ((0, 0), (0, 0), (0, s_pad - S), (0, 0))
    kt = jnp.pad(k.transpose(0, 2, 1, 3), pad).reshape(B, H, n_blk, MOBA_BLOCK, d)
    vt = jnp.pad(v.transpose(0, 2, 1, 3), pad).reshape(B, H, n_blk, MOBA_BLOCK, d)
    k_mean = jnp.mean(kt.astype(jnp.float32), axis=3)
    b_idx = jnp.arange(B)[:, None, None, None]
    h_idx = jnp.arange(H)[None, :, None, None]

    def chunk(c):
        t0 = c * MOBA_Q_CHUNK
        qc = lax.dynamic_slice_in_dim(qt, t0, MOBA_Q_CHUNK, axis=2)
        t_pos = t0 + jnp.arange(MOBA_Q_CHUNK)
        own = t0 // MOBA_BLOCK
        gate = jnp.einsum('bhqd,bhnd->bhqn', qc.astype(jnp.float32), k_mean)
        gate = jnp.where(jnp.arange(n_blk) < own, gate, neg)
        _, sel = lax.top_k(gate, topk)
        sel_ok = sel < own
        k_sel = kt[b_idx, h_idx, sel]
        v_sel = vt[b_idx, h_idx, sel]
        s_sel = jnp.einsum('bhqd,bhqnkd->bhqnk', qc, k_sel).astype(jnp.float32) * scale
        s_sel = jnp.where(sel_ok[..., None], s_sel, neg).reshape(B, H, MOBA_Q_CHUNK, topk * MOBA_BLOCK)
        k_own = lax.dynamic_index_in_dim(kt, own, axis=2, keepdims=False)
        v_own = lax.dynamic_index_in_dim(vt, own, axis=2, keepdims=False)
        s_own = jnp.einsum('bhqd,bhkd->bhqk', qc, k_own).astype(jnp.float32) * scale
        key_pos = own * MOBA_BLOCK + jnp.arange(MOBA_BLOCK)
        s_own = jnp.where(key_pos[None, :] <= t_pos[:, None], s_own, neg)
        p = jax.nn.softmax(jnp.concatenate([s_sel, s_own], axis=-1), axis=-1).astype(v.dtype)
        p_sel, p_own = p[..., :topk * MOBA_BLOCK], p[..., topk * MOBA_BLOCK:]
        v_sel = v_sel.reshape(B, H, MOBA_Q_CHUNK, topk * MOBA_BLOCK, d)
        return (jnp.einsum('bhqn,bhqnd->bhqd', p_sel, v_sel)
                + jnp.einsum('bhqk,bhkd->bhqd', p_own, v_own))

    o = lax.map(chunk, jnp.arange(S // MOBA_Q_CHUNK))
    return o.transpose(1, 0, 3, 2, 4).reshape(B, S, H, d)


def _gmlp_spatial_gating(u, v, g_vnorm, w_s, b_s):
    B, S, G, d = v.shape
    u = jax.nn.gelu(u)
    v = _rmsnorm(jax.nn.gelu(v), g_vnorm)
    mask = jnp.tril(jnp.ones((GMLP_CHUNK, GMLP_CHUNK), dtype=w_s.dtype))
    vc = v.reshape(B, S // GMLP_CHUNK, GMLP_CHUNK, G, d)
    mixed = jnp.einsum('gts,bcsgd->bctgd', w_s * mask, vc) + b_s.T[:, :, None]
    return u * mixed.reshape(B, S, G, d)


def _hierarchical_moe(h, w_rg, w_re, w_gate, w_up, w_down):
    T, D = h.shape
    hf = h.astype(jnp.float32)
    p_group = jax.nn.softmax(hf @ w_rg.astype(jnp.float32), axis=-1)
    g_sel = jnp.argmax(p_group, axis=-1)
    p_g = jnp.max(p_group, axis=-1)
    logit_e = (hf @ w_re.astype(jnp.float32)).reshape(T, N_EXPERT_GROUPS, EXPERTS_PER_GROUP)
    logit_e = jnp.take_along_axis(logit_e, g_sel[:, None, None], axis=1)[:, 0]
    top_p, top_i = lax.top_k(jax.nn.softmax(logit_e, axis=-1), MOE_TOP_K)
    top_p = top_p / jnp.sum(top_p, axis=-1, keepdims=True)
    expert_id = (g_sel[:, None] * EXPERTS_PER_GROUP + top_i).reshape(-1).astype(jnp.int32)
    gate_w = (p_g[:, None] * top_p).reshape(-1).astype(h.dtype)
    token_id = jnp.repeat(jnp.arange(T, dtype=jnp.int32), MOE_TOP_K)
    n_slots = T * MOE_TOP_K
    n_blocks = -(-n_slots // MOE_BLOCK) + N_EXPERTS
    order = jnp.argsort(expert_id)
    e_sorted = expert_id[order]
    counts = jnp.bincount(expert_id, length=N_EXPERTS)
    padded = (counts + MOE_BLOCK - 1) // MOE_BLOCK * MOE_BLOCK
    pad_end = jnp.cumsum(padded)
    pad_start = pad_end - padded
    start = jnp.cumsum(counts) - counts
    dest = pad_start[e_sorted] + jnp.arange(n_slots) - start[e_sorted]
    buf_tok = jnp.full((n_blocks * MOE_BLOCK,), T, dtype=jnp.int32).at[dest].set(token_id[order])
    buf_w = jnp.zeros((n_blocks * MOE_BLOCK,), h.dtype).at[dest].set(gate_w[order])
    blk_expert = jnp.minimum(
        jnp.searchsorted(pad_end, jnp.arange(n_blocks) * MOE_BLOCK, side='right'), N_EXPERTS - 1)
    h_pad = jnp.concatenate([h, jnp.zeros((1, D), h.dtype)], axis=0)

    def expert_block(args):
        tok, e = args
        xb = h_pad[tok]
        a = jax.nn.silu(xb @ w_gate[e]) * (xb @ w_up[e])
        return a @ w_down[e]

    y = lax.map(expert_block, (buf_tok.reshape(n_blocks, MOE_BLOCK), blk_expert))
    out = jnp.zeros((T + 1, D), h.dtype).at[buf_tok].add(y.reshape(-1, D) * buf_w[:, None])
    return out[:T]


def setup_inputs(seed: int = 0) -> dict:
    key = jax.random.key(seed)
    ks = jax.random.split(key, 16)
    f32 = jnp.float32
    x = jax.random.normal(ks[0], (BATCH, SEQ, D_MODEL), f32)
    start = jax.random.randint(ks[1], (BATCH, 1), 0, 4096, dtype=jnp.int32)
    positions = (start + jnp.arange(SEQ, dtype=jnp.int32)[None, :]).astype(jnp.int32)
    w_in = jax.random.normal(ks[2], (DEPTH, D_MODEL, IN_COLS), f32) * D_MODEL ** -0.5
    w_out = jax.random.normal(ks[3], (DEPTH, D_MIX, D_MODEL), f32) * D_MIX ** -0.5 * OUT_SCALE
    g_mix_norm = 1.0 + 0.02 * jax.random.normal(ks[4], (DEPTH, D_MODEL), f32)
    g_head_norm = 1.0 + 0.02 * jax.random.normal(ks[5], (DEPTH, N_HEADS_TOTAL, HEAD_DIM), f32)
    g_gmlp_vnorm = 1.0 + 0.02 * jax.random.normal(ks[6], (DEPTH, N_GROUPS_GMLP, HEAD_DIM), f32)
    w_spatial = jax.random.normal(ks[7], (DEPTH, N_GROUPS_GMLP, GMLP_CHUNK, GMLP_CHUNK), f32) * GMLP_CHUNK ** -0.5
    b_spatial = 1.0 + 0.1 * jax.random.normal(ks[8], (DEPTH, N_GROUPS_GMLP, GMLP_CHUNK), f32)
    g_ffn_norm = 1.0 + 0.02 * jax.random.normal(ks[9], (DEPTH, D_MODEL), f32)
    w_router_group = jax.random.normal(ks[10], (DEPTH, D_MODEL, N_EXPERT_GROUPS), f32) * D_MODEL ** -0.5
    w_router_expert = jax.random.normal(ks[11], (DEPTH, D_MODEL, N_EXPERTS), f32) * D_MODEL ** -0.5
    w_expert_gate = jax.random.normal(ks[12], (DEPTH, N_EXPERTS, D_MODEL, D_EXPERT), f32) * D_MODEL ** -0.5
    w_expert_up = jax.random.normal(ks[13], (DEPTH, N_EXPERTS, D_MODEL, D_EXPERT), f32) * D_MODEL ** -0.5
    w_expert_down = jax.random.normal(ks[14], (DEPTH, N_EXPERTS, D_EXPERT, D_MODEL), f32) * D_EXPERT ** -0.5 * OUT_SCALE
    g_final = 1.0 + 0.02 * jax.random.normal(ks[15], (D_MODEL,), f32)
    return {"x": x, "positions": positions, "w_in": w_in, "w_out": w_out,
            "g_mix_norm": g_mix_norm, "g_head_norm": g_head_norm, "g_gmlp_vnorm": g_gmlp_vnorm,
            "w_spatial": w_spatial, "b_spatial": b_spatial, "g_ffn_norm": g_ffn_norm,
            "w_router_group": w_router_group, "w_router_expert": w_router_expert,
            "w_expert_gate": w_expert_gate, "w_expert_up": w_expert_up,
            "w_expert_down": w_expert_down, "g_final": g_final}


def reference(x, positions, w_in, w_out, g_mix_norm, g_head_norm, g_gmlp_vnorm, w_spatial,
              b_spatial, g_ffn_norm, w_router_group, w_router_expert, w_expert_gate,
              w_expert_up, w_expert_down, g_final):
    B, S, _ = x.shape
    widths = [W_SB] * 3 + [W_MOBA] * 3 + [W_GMLP] * 2
    split_points = [int(p) for p in np.cumsum(widths)[:-1]]
    for l in range(DEPTH):
        h = _rmsnorm(x, g_mix_norm[l])
        proj = h @ w_in[l]
        qa, ka, va, qb, kb, vb, uc, vc = jnp.split(proj, split_points, axis=-1)
        o_sb = _stick_breaking_attention(qa.reshape(B, S, N_HEADS_SB, HEAD_DIM),
                                         ka.reshape(B, S, N_HEADS_SB, HEAD_DIM),
                                         va.reshape(B, S, N_HEADS_SB, HEAD_DIM))
        qb = _partial_rope(qb.reshape(B, S, N_HEADS_MOBA, HEAD_DIM), positions)
        kb = _partial_rope(kb.reshape(B, S, N_HEADS_MOBA, HEAD_DIM), positions)
        o_moba = _moba_attention(qb, kb, vb.reshape(B, S, N_HEADS_MOBA, HEAD_DIM))
        o_gmlp = _gmlp_spatial_gating(uc.reshape(B, S, N_GROUPS_GMLP, HEAD_DIM),
                                      vc.reshape(B, S, N_GROUPS_GMLP, HEAD_DIM),
                                      g_gmlp_vnorm[l], w_spatial[l], b_spatial[l])
        o = jnp.concatenate([o_sb, o_moba, o_gmlp], axis=2)
        o = _rmsnorm(o, g_head_norm[l]).reshape(B, S, D_MIX)
        x = x + o @ w_out[l]
        h = _rmsnorm(x, g_ffn_norm[l]).reshape(B * S, D_MODEL)
        y = _hierarchical_moe(h, w_router_group[l], w_router_expert[l], w_expert_gate[l],
                              w_expert_up[l], w_expert_down[l])
        x = x + y.reshape(B, S, D_MODEL)
    return _rmsnorm(x, g_final)
```

```cpp
#include <hip/hip_runtime.h>
#include <cstdint>
#include <cstdio>

constexpr int D = 1024, BATCH = 8, SEQ = 2048, T = BATCH * SEQ, DEPTH = 4;
constexpr int HD = 64;
constexpr int INC = 2816;
constexpr int C_QA = 0, C_KA = 256, C_VA = 512, C_QB = 768, C_KB = 1280, C_VB = 1792, C_UC = 2304, C_VC = 2560;
constexpr int NE = 32, EPG = 8, DE = 512;
constexpr int NSLOT = T * 2;
constexpr int MAXMT = 160;
constexpr float EPS = 1e-6f;

typedef unsigned short bf16;
typedef unsigned u32;

constexpr size_t MiB = 1u << 20;
constexpr size_t WS_CTL = 0, CTL_BYTES = 1 * MiB;
constexpr size_t WS_WR = 1 * MiB;
constexpr size_t WS_ROPE = 2 * MiB;
constexpr size_t WS_RSTD = 3 * MiB;
constexpr size_t WS_RSTD2 = WS_RSTD + 65536;
constexpr size_t WS_SLOTW = WS_RSTD2 + 65536;
constexpr size_t WS_KMEAN = WS_SLOTW + 131072;
constexpr size_t WS_ELIST = 4 * MiB;
constexpr size_t WS_WIN = 8 * MiB;
constexpr size_t WS_WOUT = 30 * MiB;
constexpr size_t WS_WGU = 38 * MiB;
constexpr size_t WS_WD = 294 * MiB;
constexpr size_t WS_X = 422 * MiB;
constexpr size_t WS_XB = 486 * MiB;
constexpr size_t WS_PROJ = 518 * MiB;
constexpr size_t WS_ON = 606 * MiB;
constexpr size_t WS_ABUF = 638 * MiB;
constexpr size_t WS_YS = 678 * MiB;
constexpr size_t WS_END = 742 * MiB;
constexpr int CW_ECNT = 1024;

struct P {
    const float* x; const int* pos; const float* w_in; const float* w_out; const float* g_mix; const float* g_head; const float* g_vn;
    const float* w_sp; const float* b_sp; const float* g_ffn; const float* w_rg; const float* w_re; const float* w_g; const float* w_u;
    const float* w_d; const float* g_fin; float* out; unsigned char* ws;
};

__device__ __forceinline__ bf16 f2bf(float f) { u32 u = __float_as_uint(f); return (bf16)((u + 0x7fffu + ((u >> 16) & 1u)) >> 16); }
__device__ __forceinline__ float bf2f(bf16 h) { return __uint_as_float((u32)h << 16); }
__device__ __forceinline__ u32 pk2(float lo, float hi) { return (u32)f2bf(lo) | ((u32)f2bf(hi) << 16); }
__device__ __forceinline__ float blo(u32 u) { return __uint_as_float(u << 16); }
__device__ __forceinline__ float bhi(u32 u) { return __uint_as_float(u & 0xffff0000u); }
__device__ __forceinline__ float wave_sum(float v) {
#pragma unroll
    for (int o = 1; o < 64; o <<= 1) v += __shfl_xor(v, o);
    return v;
}
__device__ __forceinline__ float dot8(uint4 a, uint4 b) {
    return blo(a.x) * blo(b.x) + bhi(a.x) * bhi(b.x) + blo(a.y) * blo(b.y) + bhi(a.y) * bhi(b.y) +
           blo(a.z) * blo(b.z) + bhi(a.z) * bhi(b.z) + blo(a.w) * blo(b.w) + bhi(a.w) * bhi(b.w);
}
__device__ __forceinline__ float dot_bf16(const bf16* a, const bf16* b, int K) {
    float acc = 0.f;
    for (int k = 0; k < K; k += 8) acc += dot8(*(const uint4*)(a + k), *(const uint4*)(b + k));
    return acc;
}
__device__ __forceinline__ float gelu_tanh(float x) {
    const float u = 0.7978845608028654f * (x + 0.044715f * x * x * x);
    return x / (1.f + __expf(-2.f * u));
}

__device__ __forceinline__ void tr_item(const float* W, int K, int N, bf16* WT, const float* scale, int mode, float* scr, int item, int lane) {
    const int nblk = N / 32, kb = item / nblk, nb = item % nblk, k0 = 64 * kb, n0 = 32 * nb;
#pragma unroll 8
    for (int i = 0; i < 32; ++i) {
        const int kk = 2 * i + (lane >> 5);
        float v = W[(size_t)(k0 + kk) * N + n0 + (lane & 31)];
        if (scale) v *= scale[k0 + kk];
        scr[kk * 33 + (lane & 31)] = v;
    }
    __builtin_amdgcn_s_waitcnt(0xc07f); asm volatile("" ::: "memory");
    const int c = lane & 7;
#pragma unroll
    for (int j = 0; j < 4; ++j) {
        const int n = (lane >> 3) + 8 * j; const float* s = scr + (8 * c) * 33 + n;
        uint4 o; o.x = pk2(s[0 * 33], s[1 * 33]); o.y = pk2(s[2 * 33], s[3 * 33]); o.z = pk2(s[4 * 33], s[5 * 33]); o.w = pk2(s[6 * 33], s[7 * 33]);
        const int ng = n0 + n;
        const int row = mode == 0 ? ng : ((ng >> 7) * 256 + (mode == 2 ? 128 : 0) + (ng & 127));
        *(uint4*)(WT + (size_t)row * K + k0 + 8 * c) = o;
    }
    __builtin_amdgcn_s_waitcnt(0xc07f); asm volatile("" ::: "memory");
}
constexpr int I_WIN = DEPTH * (D / 64) * (INC / 32);
constexpr int I_WOUT = DEPTH * (D / 64) * (D / 32);
constexpr int I_G = DEPTH * NE * (D / 64) * (DE / 32);
constexpr int I_D = DEPTH * NE * (DE / 64) * (D / 32);
constexpr int I_TOTAL = I_WIN + I_WOUT + 2 * I_G + I_D;

__global__ void __launch_bounds__(256) k_convert(P p) {
    __shared__ float scr_all[4 * 64 * 33];
    const int lane = threadIdx.x & 63, wave = threadIdx.x >> 6;
    float* scr = scr_all + wave * 64 * 33;
    const int gw = blockIdx.x * 4 + wave, NGW = gridDim.x * 4;
    unsigned char* ws = p.ws;
    for (int it = gw; it < I_TOTAL; it += NGW) {
        int r = it;
        if (r < I_WIN) { const int per = (D / 64) * (INC / 32), l = r / per; tr_item(p.w_in + (size_t)l * D * INC, D, INC, (bf16*)(ws + WS_WIN) + (size_t)l * INC * D, p.g_mix + l * D, 0, scr, r % per, lane); continue; }
        r -= I_WIN;
        if (r < I_WOUT) { const int per = (D / 64) * (D / 32), l = r / per; tr_item(p.w_out + (size_t)l * D * D, D, D, (bf16*)(ws + WS_WOUT) + (size_t)l * D * D, nullptr, 0, scr, r % per, lane); continue; }
        r -= I_WOUT;
        if (r < 2 * I_G) {
            const int up = r >= I_G; if (up) r -= I_G;
            const int per = (D / 64) * (DE / 32), le = r / per, l = le / NE;
            tr_item((up ? p.w_u : p.w_g) + (size_t)le * D * DE, D, DE, (bf16*)(ws + WS_WGU) + (size_t)le * 1024 * 1024, p.g_ffn + l * D, up ? 2 : 1, scr, r % per, lane); continue;
        }
        r -= 2 * I_G;
        { const int per = (DE / 64) * (D / 32), le = r / per; tr_item(p.w_d + (size_t)le * DE * D, DE, D, (bf16*)(ws + WS_WD) + (size_t)le * 1024 * 512, nullptr, 0, scr, r % per, lane); }
    }
}
__global__ void k_misc(P p) {
    const int idx = blockIdx.x * blockDim.x + threadIdx.x;
    if (idx < DEPTH * 48 * D) {
        const int k = idx % D, j = (idx / D) % 48, l = idx / (48 * D);
        float v = 0.f;
        if (j < 4) v = p.w_rg[((size_t)l * D + k) * 4 + j] * p.g_ffn[l * D + k];
        else if (j < 36) v = p.w_re[((size_t)l * D + k) * NE + (j - 4)] * p.g_ffn[l * D + k];
        ((float*)(p.ws + WS_WR))[idx] = v;
    }
    if (idx < T * 8) {
        const int i = idx & 7, t = idx >> 3;
        const double inv = pow(500000.0, -(double)i / 8.0);
        const double ang = (double)p.pos[t] * inv;
        float* r = (float*)(p.ws + WS_ROPE) + (size_t)idx * 2;
        r[0] = (float)cos(ang); r[1] = (float)sin(ang);
    }
}
__global__ void __launch_bounds__(256) k_xinit(P p) {
    const int lane = threadIdx.x & 63, gw = (blockIdx.x * blockDim.x + threadIdx.x) >> 6, NGW = (gridDim.x * blockDim.x) >> 6;
    float* X = (float*)(p.ws + WS_X); bf16* XB = (bf16*)(p.ws + WS_XB); float* RS = (float*)(p.ws + WS_RSTD);
    for (int m = gw; m < T; m += NGW) {
        const float4* xr = (const float4*)(p.x + (size_t)m * D) + lane; float4 v[4]; float s = 0.f;
#pragma unroll
        for (int j = 0; j < 4; ++j) { v[j] = xr[64 * j]; s += v[j].x * v[j].x + v[j].y * v[j].y + v[j].z * v[j].z + v[j].w * v[j].w; }
        s = wave_sum(s);
        if (lane == 0) RS[m] = rsqrtf(s * (1.f / D) + EPS);
#pragma unroll
        for (int j = 0; j < 4; ++j) {
            ((float4*)(X + (size_t)m * D) + lane)[64 * j] = v[j];
            ((uint2*)(XB + (size_t)m * D) + lane)[64 * j] = make_uint2(pk2(v[j].x, v[j].y), pk2(v[j].z, v[j].w));
        }
    }
}

__global__ void __launch_bounds__(256) k_inproj_naive(P p, int l) {
    const int n = blockIdx.x * 64 + threadIdx.x, m = blockIdx.y * 4 + threadIdx.y;
    const bf16* XB = (const bf16*)(p.ws + WS_XB); const bf16* W = (const bf16*)(p.ws + WS_WIN) + (size_t)l * INC * D;
    const float rs = ((const float*)(p.ws + WS_RSTD))[m];
    float v = dot_bf16(XB + (size_t)m * D, W + (size_t)n * D, D) * rs;
    if (n >= C_QB && n < C_VB) {
        const int d = n & 63;
        if (d < 16) {
            const float o = dot_bf16(XB + (size_t)m * D, W + (size_t)(n ^ 8) * D, D) * rs;
            const float* cs = (const float*)(p.ws + WS_ROPE) + ((size_t)m * 8 + (d & 7)) * 2;
            v = d < 8 ? v * cs[0] - o * cs[1] : v * cs[0] + o * cs[1];
        }
    } else if (n >= C_UC) v = gelu_tanh(v);
    ((bf16*)(p.ws + WS_PROJ))[(size_t)m * INC + n] = f2bf(v);
}

__global__ void k_kmean_naive(P p) {
    const int idx = blockIdx.x * blockDim.x + threadIdx.x;
    const int d = idx & 63, blk = (idx >> 6) & 7, h = (idx >> 9) & 7, b = idx >> 12;
    const bf16* PR = (const bf16*)(p.ws + WS_PROJ);
    float s = 0.f;
    for (int j = 0; j < 256; ++j) s += bf2f(PR[(size_t)(b * SEQ + blk * 256 + j) * INC + C_KB + h * 64 + d]);
    ((float*)(p.ws + WS_KMEAN))[idx] = s * (1.f / 256.f);
}
__global__ void __launch_bounds__(64) k_sb_naive(P p) {
    const int idx = blockIdx.x * 64 + threadIdx.x;
    const int t = idx % SEQ, h = (idx / SEQ) % 4, b = idx / (SEQ * 4);
    const bf16* PR = (const bf16*)(p.ws + WS_PROJ);
    const size_t row = (size_t)b * SEQ + t;
    uint4 q[8];
#pragma unroll
    for (int i = 0; i < 8; ++i) q[i] = *(const uint4*)(PR + row * INC + C_QA + h * 64 + i * 8);
    float acc[64];
#pragma unroll
    for (int i = 0; i < 64; ++i) acc[i] = 0.f;
    float L = 0.f;
    for (int s = t - 1; s >= 0; --s) {
        const bf16* kr = PR + ((size_t)b * SEQ + s) * INC + C_KA + h * 64;
        const bf16* vr = PR + ((size_t)b * SEQ + s) * INC + C_VA + h * 64;
        float z = 0.f;
#pragma unroll
        for (int i = 0; i < 8; ++i) z += dot8(q[i], *(const uint4*)(kr + i * 8));
        z *= 0.125f;
        const float l1p = log1pf(expf(-fabsf(z)));
        const float ls = fminf(z, 0.f) - l1p, lr = fminf(-z, 0.f) - l1p;
        const float w = expf(ls + L);
        L += lr;
#pragma unroll
        for (int i = 0; i < 8; ++i) {
            const uint4 vv = *(const uint4*)(vr + i * 8);
            acc[i * 8 + 0] += w * blo(vv.x); acc[i * 8 + 1] += w * bhi(vv.x); acc[i * 8 + 2] += w * blo(vv.y); acc[i * 8 + 3] += w * bhi(vv.y);
            acc[i * 8 + 4] += w * blo(vv.z); acc[i * 8 + 5] += w * bhi(vv.z); acc[i * 8 + 6] += w * blo(vv.w); acc[i * 8 + 7] += w * bhi(vv.w);
        }
    }
    float* O = (float*)(p.ws + WS_YS) + row * D + h * 64;
#pragma unroll
    for (int i = 0; i < 16; ++i) *(float4*)(O + i * 4) = make_float4(acc[i * 4], acc[i * 4 + 1], acc[i * 4 + 2], acc[i * 4 + 3]);
}
__global__ void __launch_bounds__(64) k_moba_naive(P p) {
    const int idx = blockIdx.x * 64 + threadIdx.x;
    const int t = idx % SEQ, h = (idx / SEQ) % 8, b = idx / (SEQ * 8);
    const bf16* PR = (const bf16*)(p.ws + WS_PROJ);
    const size_t row = (size_t)b * SEQ + t;
    const int own = t >> 8;
    uint4 q[8];
#pragma unroll
    for (int i = 0; i < 8; ++i) q[i] = *(const uint4*)(PR + row * INC + C_QB + h * 64 + i * 8);
    const float* KM = (const float*)(p.ws + WS_KMEAN) + ((size_t)(b * 8 + h) * 8) * 64;
    float g[8];
#pragma unroll
    for (int j = 0; j < 8; ++j) {
        float s = -1e30f;
        if (j < own) {
            s = 0.f;
#pragma unroll
            for (int i = 0; i < 8; ++i) {
                const float* km = KM + j * 64 + i * 8;
                s += blo(q[i].x) * km[0] + bhi(q[i].x) * km[1] + blo(q[i].y) * km[2] + bhi(q[i].y) * km[3] + blo(q[i].z) * km[4] + bhi(q[i].z) * km[5] + blo(q[i].w) * km[6] + bhi(q[i].w) * km[7];
            }
        }
        g[j] = s;
    }
    unsigned selmask = 0; const int nsel = own < 3 ? own : 3;
    for (int r = 0; r < nsel; ++r) {
        float best = -3e38f; int bi = 0;
#pragma unroll
        for (int j = 0; j < 8; ++j) { const bool ok = !((selmask >> j) & 1u) && g[j] > best; if (ok) { best = g[j]; bi = j; } }
        selmask |= 1u << bi;
    }
    float acc[64];
#pragma unroll
    for (int i = 0; i < 64; ++i) acc[i] = 0.f;
    float mx = -3e38f, lsum = 0.f;
    for (int blk = 0; blk <= own; ++blk) {
        if (blk < own && !((selmask >> blk) & 1u)) continue;
        const int s1 = blk == own ? t : blk * 256 + 255;
        for (int s = blk * 256; s <= s1; ++s) {
            const bf16* kr = PR + ((size_t)b * SEQ + s) * INC + C_KB + h * 64;
            const bf16* vr = PR + ((size_t)b * SEQ + s) * INC + C_VB + h * 64;
            float z = 0.f;
#pragma unroll
            for (int i = 0; i < 8; ++i) z += dot8(q[i], *(const uint4*)(kr + i * 8));
            z *= 0.125f;
            const float mn = fmaxf(mx, z), sc = expf(mx - mn), w = expf(z - mn);
            mx = mn; lsum = lsum * sc + w;
#pragma unroll
            for (int i = 0; i < 8; ++i) {
                const uint4 vv = *(const uint4*)(vr + i * 8);
                acc[i * 8 + 0] = acc[i * 8 + 0] * sc + w * blo(vv.x); acc[i * 8 + 1] = acc[i * 8 + 1] * sc + w * bhi(vv.x);
                acc[i * 8 + 2] = acc[i * 8 + 2] * sc + w * blo(vv.y); acc[i * 8 + 3] = acc[i * 8 + 3] * sc + w * bhi(vv.y);
                acc[i * 8 + 4] = acc[i * 8 + 4] * sc + w * blo(vv.z); acc[i * 8 + 5] = acc[i * 8 + 5] * sc + w * bhi(vv.z);
                acc[i * 8 + 6] = acc[i * 8 + 6] * sc + w * blo(vv.w); acc[i * 8 + 7] = acc[i * 8 + 7] * sc + w * bhi(vv.w);
            }
        }
    }
    const float il = 1.f / lsum;
    float* O = (float*)(p.ws + WS_YS) + row * D + 256 + h * 64;
#pragma unroll
    for (int i = 0; i < 16; ++i) *(float4*)(O + i * 4) = make_float4(acc[i * 4] * il, acc[i * 4 + 1] * il, acc[i * 4 + 2] * il, acc[i * 4 + 3] * il);
}
__global__ void k_gvn_naive(P p, int l) {
    const int idx = blockIdx.x * blockDim.x + threadIdx.x;
    const int g = idx & 3, t = idx >> 2;
    const bf16* v = (const bf16*)(p.ws + WS_PROJ) + (size_t)t * INC + C_VC + g * 64;
    float s = 0.f;
    for (int d = 0; d < 64; ++d) { const float x = bf2f(v[d]); s += x * x; }
    const float rs = rsqrtf(s * (1.f / 64.f) + EPS);
    float* o = (float*)(p.ws + WS_ABUF) + (size_t)t * 256 + g * 64;
    for (int d = 0; d < 64; ++d) o[d] = bf2f(v[d]) * rs * p.g_vn[(l * 4 + g) * 64 + d];
}
__global__ void k_gmlp_naive(P p, int l) {
    const int idx = blockIdx.x * blockDim.x + threadIdx.x;
    const int d = idx & 63, g = (idx >> 6) & 3, t = idx >> 8;
    const int tc = t & 127, t0 = t - tc;
    const float* VN = (const float*)(p.ws + WS_ABUF);
    const float* w = p.w_sp + ((size_t)(l * 4 + g) * 128 + tc) * 128;
    float s = 0.f;
    for (int j = 0; j <= tc; ++j) s += w[j] * VN[(size_t)(t0 + j) * 256 + g * 64 + d];
    s += p.b_sp[(l * 4 + g) * 128 + tc];
    const float u = bf2f(((const bf16*)(p.ws + WS_PROJ))[(size_t)t * INC + C_UC + g * 64 + d]);
    ((float*)(p.ws + WS_YS))[(size_t)t * D + 768 + g * 64 + d] = u * s;
}
__global__ void k_headnorm_naive(P p, int l) {
    const int idx = blockIdx.x * blockDim.x + threadIdx.x;
    const int h = idx & 15, t = idx >> 4;
    const float* o = (const float*)(p.ws + WS_YS) + (size_t)t * D + h * 64;
    float s = 0.f;
    for (int d = 0; d < 64; ++d) s += o[d] * o[d];
    const float rs = rsqrtf(s * (1.f / 64.f) + EPS);
    bf16* on = (bf16*)(p.ws + WS_ON) + (size_t)t * D + h * 64;
    for (int d = 0; d < 64; ++d) on[d] = f2bf(o[d] * rs * p.g_head[(l * 16 + h) * 64 + d]);
}

__global__ void __launch_bounds__(256) k_outproj_naive(P p, int l) {
    const int n = blockIdx.x * 64 + threadIdx.x, m = blockIdx.y * 4 + threadIdx.y;
    const bf16* A = (const bf16*)(p.ws + WS_ON); const bf16* W = (const bf16*)(p.ws + WS_WOUT) + (size_t)l * D * D;
    float* X = (float*)(p.ws + WS_X);
    const float v = X[(size_t)m * D + n] + dot_bf16(A + (size_t)m * D, W + (size_t)n * D, D);
    X[(size_t)m * D + n] = v;
    ((bf16*)(p.ws + WS_XB))[(size_t)m * D + n] = f2bf(v);
}

typedef float f32x4 __attribute__((ext_vector_type(4)));
__device__ __forceinline__ void router_tile(const P& p, int l, int tile, float* lg  , int lane) {
    const int r = lane & 15, q = lane >> 4, tok0 = tile * 16;
    const float* X = (const float*)(p.ws + WS_X) + (size_t)(tok0 + r) * D + q * 4;
    const float* W = (const float*)(p.ws + WS_WR) + (size_t)l * 48 * D + (size_t)r * D + q * 4;
    f32x4 acc[3] = {{0.f, 0.f, 0.f, 0.f}, {0.f, 0.f, 0.f, 0.f}, {0.f, 0.f, 0.f, 0.f}};
    float ss = 0.f;
#pragma unroll 4
    for (int kk = 0; kk < 64; ++kk) {
        const float4 xa = *(const float4*)(X + kk * 16);
        ss += xa.x * xa.x + xa.y * xa.y + xa.z * xa.z + xa.w * xa.w;
#pragma unroll
        for (int nt = 0; nt < 3; ++nt) {
            const float4 wb = *(const float4*)(W + (size_t)nt * 16 * D + kk * 16);
            acc[nt] = __builtin_amdgcn_mfma_f32_16x16x4f32(xa.x, wb.x, acc[nt], 0, 0, 0);
            acc[nt] = __builtin_amdgcn_mfma_f32_16x16x4f32(xa.y, wb.y, acc[nt], 0, 0, 0);
            acc[nt] = __builtin_amdgcn_mfma_f32_16x16x4f32(xa.z, wb.z, acc[nt], 0, 0, 0);
            acc[nt] = __builtin_amdgcn_mfma_f32_16x16x4f32(xa.w, wb.w, acc[nt], 0, 0, 0);
        }
    }
    ss += __shfl_xor(ss, 16); ss += __shfl_xor(ss, 32);
    const float rs_mine = rsqrtf(ss * (1.f / D) + EPS);
#pragma unroll
    for (int nt = 0; nt < 3; ++nt)
#pragma unroll
        for (int reg = 0; reg < 4; ++reg) lg[(q * 4 + reg) * 48 + nt * 16 + r] = acc[nt][reg];
    __builtin_amdgcn_s_waitcnt(0xc07f); asm volatile("" ::: "memory");
    if (lane < 16) {
        const int tok = tok0 + lane; const float rs = rs_mine;
        ((float*)(p.ws + WS_RSTD2))[tok] = rs;
        const float* L = lg + lane * 48;
        float g0 = L[0] * rs, g1 = L[1] * rs, g2 = L[2] * rs, g3 = L[3] * rs;
        int gs = 0; float gm = g0;
        if (g1 > gm) { gm = g1; gs = 1; } if (g2 > gm) { gm = g2; gs = 2; } if (g3 > gm) { gm = g3; gs = 3; }
        const float pg = 1.f / (expf(g0 - gm) + expf(g1 - gm) + expf(g2 - gm) + expf(g3 - gm));
        float e[8];
#pragma unroll
        for (int j = 0; j < 8; ++j) e[j] = L[4 + gs * 8 + j] * rs;
        int i1 = 0; float m1 = e[0];
#pragma unroll
        for (int j = 1; j < 8; ++j) if (e[j] > m1) { m1 = e[j]; i1 = j; }
        int i2 = -1; float m2 = -3e38f;
#pragma unroll
        for (int j = 0; j < 8; ++j) if (j != i1 && e[j] > m2) { m2 = e[j]; i2 = j; }
        const float p2 = expf(m2 - m1), inv = 1.f / (1.f + p2);
        const float w1 = pg * inv, w2 = pg * p2 * inv;
        const int e1 = gs * 8 + i1, e2 = gs * 8 + i2;
        u32* ecnt = (u32*)(p.ws + WS_CTL) + CW_ECNT + l * 32;
        int* elist = (int*)(p.ws + WS_ELIST);
        float* sw = (float*)(p.ws + WS_SLOTW);
        const u32 p1 = atomicAdd(ecnt + e1, 1u); elist[(size_t)e1 * NSLOT + p1] = tok * 2;
        const u32 p2i = atomicAdd(ecnt + e2, 1u); elist[(size_t)e2 * NSLOT + p2i] = tok * 2 + 1;
        sw[tok * 2] = w1; sw[tok * 2 + 1] = w2;
    }
    __builtin_amdgcn_s_waitcnt(0xc07f); asm volatile("" ::: "memory");
}
__global__ void __launch_bounds__(256) k_router(P p, int l) {
    __shared__ float lg_all[4 * 16 * 48];
    const int lane = threadIdx.x & 63, wave = threadIdx.x >> 6;
    const int gw = blockIdx.x * 4 + wave, NGW = gridDim.x * 4;
    for (int tile = gw; tile < T / 16; tile += NGW) router_tile(p, l, tile, lg_all + wave * 16 * 48, lane);
}

__device__ __forceinline__ bool find_prow(const u32* ecnt, int prow, int& e, int& i, int& cnt) {
    int base = 0;
    for (int x = 0; x < NE; ++x) { const int c = (int)ecnt[x], mt = (c + 255) >> 8; if (prow < (base + mt) * 256) { e = x; i = prow - base * 256; cnt = c; return i < c; } base += mt; }
    return false;
}
__global__ void __launch_bounds__(256) k_moe1_naive(P p, int l) {
    const int c = blockIdx.x * 64 + threadIdx.x, prow = blockIdx.y * 4 + threadIdx.y;
    const u32* ecnt = (const u32*)(p.ws + WS_CTL) + CW_ECNT + l * 32;
    int e, i, cnt; if (!find_prow(ecnt, prow, e, i, cnt)) return;
    const int slot = ((const int*)(p.ws + WS_ELIST))[(size_t)e * NSLOT + i], tok = slot >> 1;
    const bf16* a = (const bf16*)(p.ws + WS_XB) + (size_t)tok * D;
    const bf16* W = (const bf16*)(p.ws + WS_WGU) + (size_t)(l * NE + e) * 1024 * 1024;
    const int rg = (c >> 7) * 256 + (c & 127);
    const float rs = ((const float*)(p.ws + WS_RSTD2))[tok];
    const float g = dot_bf16(a, W + (size_t)rg * D, D) * rs, u = dot_bf16(a, W + (size_t)(rg + 128) * D, D) * rs;
    ((bf16*)(p.ws + WS_ABUF))[(size_t)prow * DE + c] = f2bf(g / (1.f + __expf(-g)) * u);
}
__global__ void __launch_bounds__(256) k_moe2_naive(P p, int l) {
    const int n = blockIdx.x * 64 + threadIdx.x, prow = blockIdx.y * 4 + threadIdx.y;
    const u32* ecnt = (const u32*)(p.ws + WS_CTL) + CW_ECNT + l * 32;
    int e, i, cnt; if (!find_prow(ecnt, prow, e, i, cnt)) return;
    const int slot = ((const int*)(p.ws + WS_ELIST))[(size_t)e * NSLOT + i];
    const bf16* a = (const bf16*)(p.ws + WS_ABUF) + (size_t)prow * DE;
    const bf16* W = (const bf16*)(p.ws + WS_WD) + (size_t)(l * NE + e) * 1024 * 512;
    const float y = dot_bf16(a, W + (size_t)n * DE, DE) * ((const float*)(p.ws + WS_SLOTW))[slot];
    ((bf16*)(p.ws + WS_YS))[(size_t)slot * D + n] = f2bf(y);
}
__global__ void __launch_bounds__(256) k_combine(P p, int l) {
    const int lane = threadIdx.x & 63, gw = (blockIdx.x * blockDim.x + threadIdx.x) >> 6, NGW = (gridDim.x * blockDim.x) >> 6;
    float* X = (float*)(p.ws + WS_X); bf16* XB = (bf16*)(p.ws + WS_XB); float* RS = (float*)(p.ws + WS_RSTD);
    const bf16* YS = (const bf16*)(p.ws + WS_YS);
    for (int m = gw; m < T; m += NGW) {
        float4 v[4]; float s = 0.f;
#pragma unroll
        for (int j = 0; j < 4; ++j) {
            v[j] = ((const float4*)(X + (size_t)m * D) + lane)[64 * j];
            const uint2 a = ((const uint2*)(YS + (size_t)(2 * m) * D) + lane)[64 * j], b = ((const uint2*)(YS + (size_t)(2 * m + 1) * D) + lane)[64 * j];
            v[j].x += blo(a.x) + blo(b.x); v[j].y += bhi(a.x) + bhi(b.x); v[j].z += blo(a.y) + blo(b.y); v[j].w += bhi(a.y) + bhi(b.y);
            s += v[j].x * v[j].x + v[j].y * v[j].y + v[j].z * v[j].z + v[j].w * v[j].w;
        }
        s = wave_sum(s);
        const float rs = rsqrtf(s * (1.f / D) + EPS);
        if (l == DEPTH - 1) {
#pragma unroll
            for (int j = 0; j < 4; ++j) {
                const float4 g = ((const float4*)p.g_fin + lane)[64 * j];
                ((float4*)(p.out + (size_t)m * D) + lane)[64 * j] = make_float4(v[j].x * rs * g.x, v[j].y * rs * g.y, v[j].z * rs * g.z, v[j].w * rs * g.w);
            }
        } else {
            if (lane == 0) RS[m] = rs;
#pragma unroll
            for (int j = 0; j < 4; ++j) {
                ((float4*)(X + (size_t)m * D) + lane)[64 * j] = v[j];
                ((uint2*)(XB + (size_t)m * D) + lane)[64 * j] = make_uint2(pk2(v[j].x, v[j].y), pk2(v[j].z, v[j].w));
            }
        }
    }
}

extern "C" void kernel_launch(void* const* d_in, const int* in_sizes, int n_in, void* d_out, int out_size, void* d_ws, size_t ws_size, hipStream_t stream) {
    if (n_in != 16 || out_size != T * D || ws_size < WS_END) { fprintf(stderr, "kernel_launch: unexpected sizes (n_in %d out %d ws %zu)\n", n_in, out_size, ws_size); return; }
    P p{};
    p.x = (const float*)d_in[0]; p.pos = (const int*)d_in[1]; p.w_in = (const float*)d_in[2]; p.w_out = (const float*)d_in[3];
    p.g_mix = (const float*)d_in[4]; p.g_head = (const float*)d_in[5]; p.g_vn = (const float*)d_in[6]; p.w_sp = (const float*)d_in[7];
    p.b_sp = (const float*)d_in[8]; p.g_ffn = (const float*)d_in[9]; p.w_rg = (const float*)d_in[10]; p.w_re = (const float*)d_in[11];
    p.w_g = (const float*)d_in[12]; p.w_u = (const float*)d_in[13]; p.w_d = (const float*)d_in[14]; p.g_fin = (const float*)d_in[15];
    p.out = (float*)d_out; p.ws = (unsigned char*)d_ws;
    (void)hipMemsetAsync((char*)d_ws + WS_CTL, 0, CTL_BYTES, stream);
    k_convert<<<2048, 256, 0, stream>>>(p);
    k_misc<<<(DEPTH * 48 * D + 255) / 256, 256, 0, stream>>>(p);
    k_xinit<<<1024, 256, 0, stream>>>(p);
    for (int l = 0; l < DEPTH; ++l) {
        k_inproj_naive<<<dim3(INC / 64, T / 4), dim3(64, 4), 0, stream>>>(p, l);
        k_kmean_naive<<<BATCH * 8 * 8 * 64 / 256, 256, 0, stream>>>(p);
        k_sb_naive<<<BATCH * 4 * SEQ / 64, 64, 0, stream>>>(p);
        k_moba_naive<<<BATCH * 8 * SEQ / 64, 64, 0, stream>>>(p);
        k_gvn_naive<<<T * 4 / 256, 256, 0, stream>>>(p, l);
        k_gmlp_naive<<<T * 256 / 256, 256, 0, stream>>>(p, l);
        k_headnorm_naive<<<T * 16 / 256, 256, 0, stream>>>(p, l);
        k_outproj_naive<<<dim3(D / 64, T / 4), dim3(64, 4), 0, stream>>>(p, l);
        k_router<<<256, 256, 0, stream>>>(p, l);
        k_moe1_naive<<<dim3(DE / 64, MAXMT * 256 / 4), dim3(64, 4), 0, stream>>>(p, l);
        k_moe2_naive<<<dim3(D / 64, MAXMT * 256 / 4), dim3(64, 4), 0, stream>>>(p, l);
        k_combine<<<1024, 256, 0, stream>>>(p, l);
    }
}
```

```cpp
#include <hip/hip_runtime.h>
#include <cstdint>
#include <cstdio>

constexpr int D = 1024, BATCH = 8, SEQ = 2048, T = BATCH * SEQ, DEPTH = 4;
constexpr int HD = 64;
constexpr int INC = 2816;
constexpr int C_QA = 0, C_KA = 256, C_VA = 512, C_QB = 768, C_KB = 1280, C_VB = 1792, C_UC = 2304, C_VC = 2560;
constexpr int NE = 32, EPG = 8, DE = 512;
constexpr int NSLOT = T * 2;
constexpr int MAXMT = 160;
constexpr float EPS = 1e-6f;

typedef unsigned short bf16;
typedef unsigned u32;
#define LAS __attribute__((address_space(3)))
#define GAS __attribute__((address_space(1)))

constexpr size_t MiB = 1u << 20;
constexpr size_t WS_CTL = 0, CTL_BYTES = 1 * MiB;
constexpr size_t WS_WR = 1 * MiB;
constexpr size_t WS_ROPE = 2 * MiB;
constexpr size_t WS_RSTD = 3 * MiB;
constexpr size_t WS_RSTD2 = WS_RSTD + 65536;
constexpr size_t WS_SLOTW = WS_RSTD2 + 65536;
constexpr size_t WS_KMEAN = WS_SLOTW + 131072;
constexpr size_t WS_ELIST = 4 * MiB;
constexpr size_t WS_WIN = 8 * MiB;
constexpr size_t WS_WOUT = 30 * MiB;
constexpr size_t WS_WGU = 38 * MiB;
constexpr size_t WS_WD = 294 * MiB;
constexpr size_t WS_X = 422 * MiB;
constexpr size_t WS_XB = 486 * MiB;
constexpr size_t WS_PROJ = 518 * MiB;
constexpr size_t WS_ON = 606 * MiB;
constexpr size_t WS_ABUF = 638 * MiB;
constexpr size_t WS_YS = 678 * MiB;
constexpr size_t WS_END = 742 * MiB;
constexpr int CW_ECNT = 1024;
constexpr int CW_BAR = 4096;
constexpr int RING_BYTES = 131072;
constexpr int LDS_TBL = RING_BYTES;
constexpr int LDS_MISC = RING_BYTES + 1024;
constexpr int LDS_PTRS = RING_BYTES + 2048;
constexpr int LDS_BYTES = 147456;
constexpr int NWAVES = 8;

struct P {
    const float* x; const int* pos; const float* w_in; const float* w_out; const float* g_mix; const float* g_head; const float* g_vn;
    const float* w_sp; const float* b_sp; const float* g_ffn; const float* w_rg; const float* w_re; const float* w_g; const float* w_u;
    const float* w_d; const float* g_fin; float* out; unsigned char* ws;
};

__device__ __forceinline__ bf16 f2bf(float f) { u32 u = __float_as_uint(f); return (bf16)((u + 0x7fffu + ((u >> 16) & 1u)) >> 16); }
__device__ __forceinline__ float bf2f(bf16 h) { return __uint_as_float((u32)h << 16); }
__device__ __forceinline__ u32 pk2(float lo, float hi) { return (u32)f2bf(lo) | ((u32)f2bf(hi) << 16); }
__device__ __forceinline__ float blo(u32 u) { return __uint_as_float(u << 16); }
__device__ __forceinline__ float bhi(u32 u) { return __uint_as_float(u & 0xffff0000u); }
__device__ __forceinline__ float wave_sum(float v) {
#pragma unroll
    for (int o = 1; o < 64; o <<= 1) v += __shfl_xor(v, o);
    return v;
}
__device__ __forceinline__ float dot8(uint4 a, uint4 b) {
    return blo(a.x) * blo(b.x) + bhi(a.x) * bhi(b.x) + blo(a.y) * blo(b.y) + bhi(a.y) * bhi(b.y) +
           blo(a.z) * blo(b.z) + bhi(a.z) * bhi(b.z) + blo(a.w) * blo(b.w) + bhi(a.w) * bhi(b.w);
}
__device__ __forceinline__ float gelu_tanh(float x) {
    const float u = 0.7978845608028654f * (x + 0.044715f * x * x * x);
    return x / (1.f + __expf(-2.f * u));
}
#define LDS_WAIT() asm volatile("s_waitcnt lgkmcnt(0)" ::: "memory")
__device__ __forceinline__ int lane_id_opaque() { int ln; asm volatile("v_mbcnt_lo_u32_b32 %0, -1, 0\n\tv_mbcnt_hi_u32_b32 %0, -1, %0" : "=v"(ln)); return ln; }

namespace pg8 {
typedef unsigned short bf16_t;
typedef short bf16x8 __attribute__((ext_vector_type(8)));
typedef float f32x4 __attribute__((ext_vector_type(4)));
typedef unsigned u32x4 __attribute__((ext_vector_type(4)));
typedef unsigned u32x2 __attribute__((ext_vector_type(2)));
constexpr int BM = 256, BK = 64, HALF = 128, HTB = HALF * BK * 2, STAGE_BYTES = 8 * HTB, NXCD = 8, WGM = 8;

__host__ __device__ __forceinline__ int lds_byte(int r, int c) { const int st = (r >> 4) * 2 + (c >> 5), rr = r & 15, cc = c & 31, ob = rr * 64 + cc * 2; return st * 1024 + (ob ^ (((ob >> 9) & 1) << 5)); }
__host__ __device__ __forceinline__ void stage_rc(int b, int& R, int& C) { const int st = b / 1024, sb = b % 1024, swz = sb ^ (((sb >> 9) & 1) << 5); R = (st >> 1) * 16 + swz / 64; C = (st & 1) * 32 + (swz % 64) / 2; }
__host__ __device__ __forceinline__ int perm32(int rho) { const int n = rho >> 4, i = rho & 15; return 8 * (i >> 2) + 4 * n + (i & 3); }

struct Unit { int pm, pn, e, r0, nvalid; };

struct StaticOrder {
    static constexpr bool GATHER = false;
    int nM, nN, nwg, G, c; const bf16_t* Bt;
    __device__ void init(int M, int N, int G_, int c_, const bf16_t* Bt_) { nM = M / BM; nN = N / BM; nwg = nM * nN; G = G_; c = c_; Bt = Bt_; }
    __device__ __forceinline__ bool next(int i, Unit& u) const {
        const long L = (long)i * G + c; if (L >= nwg) return false;
        int wgid = (int)L; { const int q = nwg / NXCD, r = nwg % NXCD, xcd = wgid % NXCD, off = wgid / NXCD; wgid = (xcd < r ? xcd * (q + 1) : r * (q + 1) + (xcd - r) * q) + off; }
        const int nig = WGM * nN, gid = wgid / nig, fm = gid * WGM, gsz = (nM - fm) < WGM ? (nM - fm) : WGM;
        u.pm = fm + ((wgid % nig) % gsz); u.pn = (wgid % nig) / gsz; u.e = 0; u.r0 = 0; u.nvalid = 256; return true;
    }
    __device__ __forceinline__ void a_offs(const Unit& u, int K, const int (&R)[2], const int (&C)[2], unsigned (&v)[2][2]) const {
#pragma unroll
        for (int h = 0; h < 2; ++h)
#pragma unroll
            for (int i = 0; i < 2; ++i) v[h][i] = (unsigned)((u.pm * BM + h * HALF + R[i]) * K + C[i]) * 2u;
    }
    __device__ __forceinline__ const char* b_ptr(const Unit& u, int K) const { return (const char*)(Bt + (size_t)u.pn * BM * K); }
};
template <bool GATHER_, int NN>
struct MoeOrder {
    static constexpr bool GATHER = GATHER_;
    const LAS int* tbl; const int* elist; const bf16_t* Bt; size_t estride; int G, c;
    __device__ __forceinline__ bool next(int i, Unit& u) const {
        const int L = i * G + c, nmt = tbl[32]; if (L >= nmt * NN) return false;
        const int mt = L / NN; u.pn = L % NN; u.pm = mt;
        int e = 0;
#pragma unroll 1
        while (tbl[e + 1] <= mt) ++e;
        u.e = e; u.r0 = (mt - tbl[e]) * 256; const int rem = tbl[33 + e] - u.r0; u.nvalid = rem < 256 ? rem : 256; return true;
    }
    __device__ __forceinline__ void a_offs(const Unit& u, int K, const int (&R)[2], const int (&C)[2], unsigned (&v)[2][2]) const {
#pragma unroll
        for (int h = 0; h < 2; ++h)
#pragma unroll
            for (int i = 0; i < 2; ++i) {
                const int r = h * HALF + R[i]; int row;
                if (GATHER) { row = 0; if (r < u.nvalid) row = elist[(size_t)u.e * NSLOT + u.r0 + r] >> 1; }
                else row = u.pm * BM + r;
                v[h][i] = (unsigned)(row * K + C[i]) * 2u;
            }
    }
    __device__ __forceinline__ const char* b_ptr(const Unit& u, int K) const { return (const char*)(Bt + (size_t)u.e * estride + (size_t)u.pn * BM * K); }
};

__device__ __forceinline__ unsigned cvt_pk_bf16(float lo, float hi) { unsigned r; asm volatile("v_cvt_pk_bf16_f32 %0, %1, %2" : "=v"(r) : "v"(lo), "v"(hi)); return r; }

struct EpiInProj {
    static constexpr bool PERM = true;
    bf16_t* O; const float* rstd; const float* rope;
    __device__ __forceinline__ void operator()(const f32x4 (&acc)[2][2][4][2], const Unit& u, int wr, int wc, int fr, int fq) const {
        const int mode = (u.pn >= 3 && u.pn <= 6) ? 1 : (u.pn >= 9 ? 2 : 0);
        const int row0 = u.pm * BM + wr * 64 + fr, col0 = u.pn * BM + wc * 32 + 8 * fq;
        const bool ropew = (mode == 1) && ((wc & 1) == 0);
#pragma unroll
        for (int ai = 0; ai < 2; ++ai)
#pragma unroll
            for (int m = 0; m < 4; ++m) {
                const int row = row0 + ai * HALF + m * 16; const float rs = rstd[row];
                bf16_t* rowp = O + (size_t)row * INC + col0;
#pragma unroll
                for (int bj = 0; bj < 2; ++bj) {
                    f32x4 v0 = acc[ai][bj][m][0] * rs, v1 = acc[ai][bj][m][1] * rs;
                    if (ropew) {
                        const f32x4* cs = (const f32x4*)(rope + (size_t)row * 16);
                        const f32x4 c0 = cs[0], c1 = cs[1], c2 = cs[2], c3 = cs[3];
                        f32x4 p0, p1;
#pragma unroll
                        for (int j = 0; j < 4; ++j) { p0[j] = __shfl_xor(v0[j], 16); p1[j] = __shfl_xor(v1[j], 16); }
                        const float sg = fq == 0 ? -1.f : 1.f;
                        if (fq < 2) {
                            v0[0] = v0[0] * c0[0] + sg * p0[0] * c0[1]; v0[1] = v0[1] * c0[2] + sg * p0[1] * c0[3];
                            v0[2] = v0[2] * c1[0] + sg * p0[2] * c1[1]; v0[3] = v0[3] * c1[2] + sg * p0[3] * c1[3];
                            v1[0] = v1[0] * c2[0] + sg * p1[0] * c2[1]; v1[1] = v1[1] * c2[2] + sg * p1[1] * c2[3];
                            v1[2] = v1[2] * c3[0] + sg * p1[2] * c3[1]; v1[3] = v1[3] * c3[2] + sg * p1[3] * c3[3];
                        }
                    }
                    if (mode == 2) {
#pragma unroll
                        for (int j = 0; j < 4; ++j) { v0[j] = gelu_tanh(v0[j]); v1[j] = gelu_tanh(v1[j]); }
                    }
                    u32x4 w; w.x = cvt_pk_bf16(v0[0], v0[1]); w.y = cvt_pk_bf16(v0[2], v0[3]); w.z = cvt_pk_bf16(v1[0], v1[1]); w.w = cvt_pk_bf16(v1[2], v1[3]);
                    *(u32x4*)(rowp + bj * HALF) = w;
                }
            }
    }
};
struct EpiOutProj {
    static constexpr bool PERM = false;
    float* X; bf16_t* XB;
    __device__ __forceinline__ void operator()(const f32x4 (&acc)[2][2][4][2], const Unit& u, int wr, int wc, int fr, int fq) const {
        const int row0 = u.pm * BM + wr * 64 + fr, col0 = u.pn * BM + wc * 32 + 4 * fq;
#pragma unroll
        for (int ai = 0; ai < 2; ++ai)
#pragma unroll
            for (int m = 0; m < 4; ++m) {
                const size_t off = (size_t)(row0 + ai * HALF + m * 16) * D + col0;
#pragma unroll
                for (int bj = 0; bj < 2; ++bj)
#pragma unroll
                    for (int n = 0; n < 2; ++n) {
                        const size_t o = off + bj * HALF + n * 16;
                        const f32x4 x = *(const f32x4*)(X + o) + acc[ai][bj][m][n];
                        *(f32x4*)(X + o) = x;
                        u32x2 w; w.x = cvt_pk_bf16(x[0], x[1]); w.y = cvt_pk_bf16(x[2], x[3]);
                        *(u32x2*)(XB + o) = w;
                    }
            }
    }
};
struct EpiMoe1 {
    static constexpr bool PERM = true;
    bf16_t* AB; const float* rstd2; const int* elist;
    __device__ __forceinline__ void operator()(const f32x4 (&acc)[2][2][4][2], const Unit& u, int wr, int wc, int fr, int fq) const {
        const int col0 = u.pn * HALF + wc * 32 + 8 * fq;
#pragma unroll
        for (int ai = 0; ai < 2; ++ai)
#pragma unroll
            for (int m = 0; m < 4; ++m) {
                const int r = ai * HALF + wr * 64 + m * 16 + fr;
                int tok = 0; if (r < u.nvalid) tok = elist[(size_t)u.e * NSLOT + u.r0 + r] >> 1;
                const float rs = rstd2[tok];
                float a[8];
#pragma unroll
                for (int n = 0; n < 2; ++n)
#pragma unroll
                    for (int j = 0; j < 4; ++j) { const float g = acc[ai][0][m][n][j] * rs, uu = acc[ai][1][m][n][j] * rs; a[n * 4 + j] = g / (1.f + __expf(-g)) * uu; }
                u32x4 w; w.x = cvt_pk_bf16(a[0], a[1]); w.y = cvt_pk_bf16(a[2], a[3]); w.z = cvt_pk_bf16(a[4], a[5]); w.w = cvt_pk_bf16(a[6], a[7]);
                *(u32x4*)(AB + (size_t)(u.pm * BM + r) * DE + col0) = w;
            }
    }
};
struct EpiMoe2 {
    static constexpr bool PERM = true;
    bf16_t* YS; const float* slotw; const int* elist;
    __device__ __forceinline__ void operator()(const f32x4 (&acc)[2][2][4][2], const Unit& u, int wr, int wc, int fr, int fq) const {
        const int col0 = u.pn * BM + wc * 32 + 8 * fq;
#pragma unroll
        for (int ai = 0; ai < 2; ++ai)
#pragma unroll
            for (int m = 0; m < 4; ++m) {
                const int r = ai * HALF + wr * 64 + m * 16 + fr;
                if (r < u.nvalid) {
                    const int slot = elist[(size_t)u.e * NSLOT + u.r0 + r]; const float w8 = slotw[slot];
#pragma unroll
                    for (int bj = 0; bj < 2; ++bj) {
                        const f32x4 v0 = acc[ai][bj][m][0] * w8, v1 = acc[ai][bj][m][1] * w8;
                        u32x4 w; w.x = cvt_pk_bf16(v0[0], v0[1]); w.y = cvt_pk_bf16(v0[2], v0[3]); w.z = cvt_pk_bf16(v1[0], v1[1]); w.w = cvt_pk_bf16(v1[2], v1[3]);
                        *(u32x4*)(YS + (size_t)slot * D + col0 + bj * HALF) = w;
                    }
                }
            }
    }
};

template <class Epi, class Sched, bool ALIGN_EPI>
__device__ __forceinline__ void gemm_phase(LAS unsigned char* lds, const bf16_t* Abase, const int K, const Sched& S, const Epi& E, const int wave) {
    int wid_ = wave; asm volatile("" : "+s"(wid_));
    const int lane = lane_id_opaque(), wid = wid_, tid = wid * 64 + lane, wr = wid >> 2, wc = wid & 3, fr = lane & 15, fq = lane >> 4;
    const int nt = K / BK;
    int Rr[2], Cc[2]; unsigned voffB[2];
#pragma unroll
    for (int i = 0; i < 2; ++i) { int R, C; stage_rc(tid * 16 + i * 8192, R, C); Rr[i] = R; Cc[i] = C; const int Rb = Epi::PERM ? ((R & ~31) + perm32(R & 31)) : R; voffB[i] = (unsigned)(Rb * K + C) * 2u; }
    const size_t kstep = (size_t)(BK * 2);
    const size_t hstep = (size_t)HALF * K * 2;
    const unsigned ldsw = (unsigned)wid * 1024u;
    const int aoff = lds_byte(wr * 64 + fr, fq * 8), boff = lds_byte(wc * 32 + fr, fq * 8);
#define PG8_SA(b, h) (((b) * 2 + (h)) * HTB)
#define PG8_SB(b, h) ((4 + (b) * 2 + (h)) * HTB)
#define PG8_STAGE(bufoff, gbase, voff) do { _Pragma("unroll") for (int _i = 0; _i < 2; ++_i) \
        __builtin_amdgcn_global_load_lds((const unsigned*)((const char*)(gbase) + (voff)[_i]), (LAS unsigned*)(lds + (bufoff) + ldsw + _i * 8192), 16, 0, 0); } while (0)
#define PG8_LDA(dst, b, h) do { _Pragma("unroll") for (int m = 0; m < 4; ++m) _Pragma("unroll") for (int k = 0; k < 2; ++k) dst[m][k] = *(const LAS bf16x8*)(lds + PG8_SA(b, h) + aoff + m * 2048 + k * 1024); } while (0)
#define PG8_LDB(dst, b, h) do { _Pragma("unroll") for (int n = 0; n < 2; ++n) _Pragma("unroll") for (int k = 0; k < 2; ++k) dst[n][k] = *(const LAS bf16x8*)(lds + PG8_SB(b, h) + boff + n * 2048 + k * 1024); } while (0)
#define PG8_MMA(ai, bj, At, Bt) do { __builtin_amdgcn_s_setprio(1); _Pragma("unroll") for (int m = 0; m < 4; ++m) _Pragma("unroll") for (int n = 0; n < 2; ++n) _Pragma("unroll") for (int k = 0; k < 2; ++k) \
        acc[ai][bj][m][n] = __builtin_amdgcn_mfma_f32_16x16x32_bf16(Bt[n][k], At[m][k], acc[ai][bj][m][n], 0, 0, 0); __builtin_amdgcn_s_setprio(0); } while (0)
#define PG8_WAIT_V(n) asm volatile("s_waitcnt vmcnt(" #n ")" ::: "memory")
#define PG8_WAIT_L(n) asm volatile("s_waitcnt lgkmcnt(" #n ")" ::: "memory")
#define PG8_BAR __builtin_amdgcn_s_barrier()
#define PG8_SCHED __builtin_amdgcn_sched_barrier(0)
    Unit cur, nxt; int ui = 0;
    if (!S.next(0, cur)) return;
    f32x4 acc[2][2][4][2];
#pragma unroll
    for (int a = 0; a < 2; ++a)
#pragma unroll
        for (int b = 0; b < 2; ++b)
#pragma unroll
            for (int m = 0; m < 4; ++m)
#pragma unroll
                for (int n = 0; n < 2; ++n) acc[a][b][m][n] = (f32x4){0.f, 0.f, 0.f, 0.f};
    bf16x8 At[4][2], B0[2][2], B1[2][2];
    unsigned vAc[2][2], vAn[2][2];
    unsigned voffA[2];
    const char* const A0 = (const char*)Abase; const char* cA = A0; const char* cB = S.b_ptr(cur, K);
    if constexpr (Sched::GATHER) S.a_offs(cur, K, Rr, Cc, vAc);
    else { voffA[0] = (unsigned)(Rr[0] * K + Cc[0]) * 2u; voffA[1] = (unsigned)(Rr[1] * K + Cc[1]) * 2u; cA = A0 + (size_t)cur.pm * 2 * hstep; }
#define PG8_STAGE_A(bufoff, koff, NEXT, h) do { if constexpr (Sched::GATHER) { unsigned _v[2] = {(NEXT) ? vAn[h][0] : vAc[h][0], (NEXT) ? vAn[h][1] : vAc[h][1]}; PG8_STAGE(bufoff, A0 + (koff), _v); } \
        else { PG8_STAGE(bufoff, ((NEXT) ? nA : cA) + (koff) + (h) * hstep, voffA); } } while (0)
    const char* nA = cA;
    PG8_STAGE(PG8_SB(0, 0), cB, voffB); PG8_STAGE(PG8_SB(0, 1), cB + hstep, voffB); PG8_STAGE_A(PG8_SA(0, 0), 0, false, 0); PG8_STAGE_A(PG8_SA(0, 1), 0, false, 1);
    if (wr == 1) PG8_BAR;
    PG8_WAIT_V(2); PG8_BAR;
    PG8_STAGE(PG8_SB(1, 0), cB + kstep, voffB); PG8_STAGE_A(PG8_SA(1, 0), kstep, false, 0); PG8_STAGE(PG8_SB(1, 1), cB + hstep + kstep, voffB);
    PG8_WAIT_V(6); PG8_BAR;
    for (;;) {
        const bool has_next = S.next(ui + 1, nxt);
        const char* nB = cB; nA = cA;
        if (has_next) {
            nB = S.b_ptr(nxt, K);
            if constexpr (Sched::GATHER) S.a_offs(nxt, K, Rr, Cc, vAn); else nA = A0 + (size_t)nxt.pm * 2 * hstep;
        } else if constexpr (Sched::GATHER) {
#pragma unroll
            for (int h = 0; h < 2; ++h)
#pragma unroll
                for (int i = 0; i < 2; ++i) vAn[h][i] = vAc[h][i];
        }
        for (int t = 0; t < nt; t += 2) {
            const bool last = (t == nt - 2);
            const size_t k1 = (size_t)(t + 1) * kstep, k2 = last ? 0 : (size_t)(t + 2) * kstep, k3 = k2 + kstep;
            const char* b2 = last ? nB : cB + (size_t)(t + 2) * kstep; const char* b3 = b2 + kstep;
            PG8_LDB(B0, 0, 0); PG8_LDB(B1, 0, 1); PG8_SCHED; PG8_LDA(At, 0, 0); PG8_STAGE_A(PG8_SA(1, 1), k1, false, 1);
            PG8_WAIT_V(8); PG8_WAIT_L(0); PG8_BAR; PG8_MMA(0, 0, At, B0); PG8_MMA(0, 1, At, B1); PG8_BAR; PG8_SCHED;
            PG8_LDA(At, 0, 1); PG8_STAGE(PG8_SB(0, 0), b2, voffB); PG8_STAGE(PG8_SB(0, 1), b2 + hstep, voffB); PG8_STAGE_A(PG8_SA(0, 0), k2, last, 0);
            PG8_WAIT_V(8); PG8_WAIT_L(0); PG8_BAR; PG8_MMA(1, 0, At, B0); PG8_MMA(1, 1, At, B1); PG8_BAR; PG8_SCHED;
            PG8_LDB(B0, 1, 0); PG8_LDB(B1, 1, 1); PG8_SCHED; PG8_LDA(At, 1, 0); PG8_STAGE_A(PG8_SA(0, 1), k2, last, 1);
            PG8_WAIT_V(8); PG8_WAIT_L(0); PG8_BAR; PG8_MMA(0, 0, At, B0); PG8_MMA(0, 1, At, B1); PG8_BAR; PG8_SCHED;
            PG8_LDA(At, 1, 1); PG8_STAGE(PG8_SB(1, 0), b3, voffB); PG8_STAGE(PG8_SB(1, 1), b3 + hstep, voffB); PG8_STAGE_A(PG8_SA(1, 0), k3, last, 0);
            PG8_WAIT_V(8); PG8_WAIT_L(0); PG8_BAR; PG8_MMA(1, 0, At, B0); PG8_MMA(1, 1, At, B1); PG8_BAR; PG8_SCHED;
        }
        if constexpr (ALIGN_EPI) { if (wr == 0) PG8_BAR; }
        E(acc, cur, wr, wc, fr, fq);
        if (!has_next) break;
#pragma unroll
        for (int a = 0; a < 2; ++a)
#pragma unroll
            for (int b = 0; b < 2; ++b)
#pragma unroll
                for (int m = 0; m < 4; ++m)
#pragma unroll
                    for (int n = 0; n < 2; ++n) acc[a][b][m][n] = (f32x4){0.f, 0.f, 0.f, 0.f};
        cur = nxt; cB = nB; cA = nA; ++ui;
        if constexpr (Sched::GATHER) {
#pragma unroll
            for (int h = 0; h < 2; ++h)
#pragma unroll
                for (int i = 0; i < 2; ++i) vAc[h][i] = vAn[h][i];
        }
        if constexpr (ALIGN_EPI) { if (wr == 1) PG8_BAR; }
    }
    PG8_WAIT_V(0);
    if constexpr (!ALIGN_EPI) { if (wr == 0) PG8_BAR; }
    PG8_BAR;
#undef PG8_SA
#undef PG8_SB
#undef PG8_STAGE
#undef PG8_STAGE_A
#undef PG8_LDA
#undef PG8_LDB
#undef PG8_MMA
#undef PG8_WAIT_V
#undef PG8_WAIT_L
#undef PG8_BAR
#undef PG8_SCHED
}
}

#define XB_TMO      128
#define XB_XCNT(j)  (256  + 64 * (j))
#define XB_XSUB(j)  (1280 + 64 * (j))
#define XB_XGEN(j)  (2304 + 64 * (j))
#define XB_TOP      3328
#define XB_TOPGEN   3392
#define XCD_BAR_WORDS 3456
#define XB_SPIN_CAP (1u << 18)
__device__ __forceinline__ unsigned xb_ld(unsigned* p)              { return __hip_atomic_load(p, __ATOMIC_RELAXED, __HIP_MEMORY_SCOPE_AGENT); }
__device__ __forceinline__ unsigned xb_add(unsigned* p, unsigned v) { return __hip_atomic_fetch_add(p, v, __ATOMIC_RELAXED, __HIP_MEMORY_SCOPE_AGENT); }
__device__ __forceinline__ unsigned xb_xcc_id() { return (unsigned)__builtin_amdgcn_s_getreg((3 << 11) | 20) & 0xFu; }
#define XB_SPIN(cond, bar) do { unsigned _sp = 0; while (cond) { __builtin_amdgcn_s_sleep(1); \
    if ((++_sp & 255u) == 0u) { if (xb_ld(&(bar)[XB_TMO])) break; if (_sp > XB_SPIN_CAP) { atomicAdd(&(bar)[XB_TMO], 1u); break; } } } } while (0)
struct XcdBarrier { unsigned* bar; unsigned x; volatile LAS unsigned* st; };
__device__ __forceinline__ XcdBarrier xcd_barrier_post(unsigned* bar, volatile LAS unsigned* st) {
    XcdBarrier b; b.bar = bar; b.x = xb_xcc_id(); b.st = st;
    if (threadIdx.x == 0) (void)xb_add(&bar[XB_XCNT(b.x)], 1u);
    return b;
}
__device__ __forceinline__ void xcd_barrier_complete(unsigned* bar, unsigned x, unsigned& nloc, unsigned& nx) {
    const unsigned G = gridDim.x * gridDim.y * gridDim.z;
    unsigned sum, cnt, mine, sp = 0u;
    for (;;) {
        sum = 0u; cnt = 0u; mine = 0u;
#pragma unroll
        for (unsigned j = 0; j < 16; ++j) { const unsigned c = xb_ld(&bar[XB_XCNT(j)]); sum += c; cnt += (c > 0u) ? 1u : 0u; mine = (j == x) ? c : mine; }
        if (sum == G) break;
        __builtin_amdgcn_s_sleep(1);
        if ((++sp & 255u) == 0u) { if (xb_ld(&bar[XB_TMO])) break; if (sp > XB_SPIN_CAP) { atomicAdd(&bar[XB_TMO], 1u); break; } }
    }
    nloc = mine > 0u ? mine : 1u; nx = cnt > 0u ? cnt : 1u;
}
__device__ __forceinline__ void xcd_barrier(const XcdBarrier& b, const bool t0  ) {
    asm volatile("s_waitcnt vmcnt(0)" ::: "memory");
    __syncthreads();
    if (t0) {
        unsigned* bar = b.bar;
        __builtin_amdgcn_s_waitcnt(0);
        unsigned nloc = b.st[0], nx = b.st[1];
        if (nloc == 0u) { xcd_barrier_complete(bar, b.x, nloc, nx); b.st[0] = nloc; b.st[1] = nx; }
        const unsigned old = xb_add(&bar[XB_XSUB(b.x)], 1u);
        const unsigned gen = old / nloc;
        if (old + 1u == (gen + 1u) * nloc) {
            __builtin_amdgcn_fence(__ATOMIC_RELEASE, "agent");
            asm volatile("s_waitcnt vmcnt(0)" ::: "memory");
            const unsigned og = xb_add(&bar[XB_TOP], 1u);
            const unsigned tg = og / nx;
            if (og + 1u == (tg + 1u) * nx) xb_add(&bar[XB_TOPGEN], 1u);
            else XB_SPIN(xb_ld(&bar[XB_TOPGEN]) == tg, bar);
            __builtin_amdgcn_fence(__ATOMIC_ACQUIRE, "agent");
            xb_add(&bar[XB_XGEN(b.x)], 1u);
            asm volatile("s_waitcnt vmcnt(0)" ::: "memory");
        } else {
            XB_SPIN(xb_ld(&bar[XB_XGEN(b.x)]) == gen, bar);
            __builtin_amdgcn_fence(__ATOMIC_ACQUIRE, "agent");
            asm volatile("s_waitcnt vmcnt(0)" ::: "memory");
        }
    }
    __syncthreads();
}

__device__ __forceinline__ void tr_item(const float* W, int K, int N, bf16* WT, const float* scale, int mode, LAS float* scr, int item, int lane) {
    const int nblk = N / 32, kb = item / nblk, nb = item % nblk, k0 = 64 * kb, n0 = 32 * nb;
#pragma unroll 8
    for (int i = 0; i < 32; ++i) {
        const int kk = 2 * i + (lane >> 5);
        float v = W[(size_t)(k0 + kk) * N + n0 + (lane & 31)];
        if (scale) v *= scale[k0 + kk];
        scr[kk * 33 + (lane & 31)] = v;
    }
    LDS_WAIT();
    const int c = lane & 7;
#pragma unroll
    for (int j = 0; j < 4; ++j) {
        const int n = (lane >> 3) + 8 * j; const LAS float* s = scr + (8 * c) * 33 + n;
        uint4 o; o.x = pk2(s[0 * 33], s[1 * 33]); o.y = pk2(s[2 * 33], s[3 * 33]); o.z = pk2(s[4 * 33], s[5 * 33]); o.w = pk2(s[6 * 33], s[7 * 33]);
        const int ng = n0 + n;
        const int row = mode == 0 ? ng : ((ng >> 7) * 256 + (mode == 2 ? 128 : 0) + (ng & 127));
        *(uint4*)(WT + (size_t)row * K + k0 + 8 * c) = o;
    }
    LDS_WAIT();
}
constexpr int I_WIN = DEPTH * (D / 64) * (INC / 32);
constexpr int I_WOUT = DEPTH * (D / 64) * (D / 32);
constexpr int I_G = DEPTH * NE * (D / 64) * (DE / 32);
constexpr int I_D = DEPTH * NE * (DE / 64) * (D / 32);
constexpr int I_TOTAL = I_WIN + I_WOUT + 2 * I_G + I_D;

__device__ __forceinline__ void phase_prologue(const P& p, LAS unsigned char* lds, int gw, int NGW, int wave, int lane) {
    unsigned char* ws = p.ws;
    LAS float* scr = (LAS float*)(lds + wave * (64 * 33 * 4));
    for (int it = gw; it < I_TOTAL; it += NGW) {
        int r = it;
        if (r < I_WIN) { const int per = (D / 64) * (INC / 32), l = r / per; tr_item(p.w_in + (size_t)l * D * INC, D, INC, (bf16*)(ws + WS_WIN) + (size_t)l * INC * D, p.g_mix + l * D, 0, scr, r % per, lane); continue; }
        r -= I_WIN;
        if (r < I_WOUT) { const int per = (D / 64) * (D / 32), l = r / per; tr_item(p.w_out + (size_t)l * D * D, D, D, (bf16*)(ws + WS_WOUT) + (size_t)l * D * D, nullptr, 0, scr, r % per, lane); continue; }
        r -= I_WOUT;
        if (r < 2 * I_G) {
            const int up = r >= I_G; if (up) r -= I_G;
            const int per = (D / 64) * (DE / 32), le = r / per, l = le / NE;
            tr_item((up ? p.w_u : p.w_g) + (size_t)le * D * DE, D, DE, (bf16*)(ws + WS_WGU) + (size_t)le * 1024 * 1024, p.g_ffn + l * D, up ? 2 : 1, scr, r % per, lane); continue;
        }
        r -= 2 * I_G;
        { const int per = (DE / 64) * (D / 32), le = r / per; tr_item(p.w_d + (size_t)le * DE * D, DE, D, (bf16*)(ws + WS_WD) + (size_t)le * 1024 * 512, nullptr, 0, scr, r % per, lane); }
    }
    for (int idx = gw * 64 + lane; idx < DEPTH * 48 * D; idx += NGW * 64) {
        const int k = idx % D, j = (idx / D) % 48, l = idx / (48 * D);
        float v = 0.f;
        if (j < 4) v = p.w_rg[((size_t)l * D + k) * 4 + j] * p.g_ffn[l * D + k];
        else if (j < 36) v = p.w_re[((size_t)l * D + k) * NE + (j - 4)] * p.g_ffn[l * D + k];
        ((float*)(ws + WS_WR))[idx] = v;
    }
    for (int idx = gw * 64 + lane; idx < T * 8; idx += NGW * 64) {
        const int i = idx & 7, t = idx >> 3;
        const float inv = exp2f(-(float)i * (18.931568569324174f / 8.f));
        const float ang = (float)p.pos[t] * inv;
        float sn, cs; sincosf(ang, &sn, &cs);
        float* r = (float*)(ws + WS_ROPE) + (size_t)idx * 2;
        r[0] = cs; r[1] = sn;
    }
    float* X = (float*)(ws + WS_X); bf16* XB = (bf16*)(ws + WS_XB); float* RS = (float*)(ws + WS_RSTD);
    for (int m = gw; m < T; m += NGW) {
        const float4* xr = (const float4*)(p.x + (size_t)m * D) + lane; float4 v[4]; float s = 0.f;
#pragma unroll
        for (int j = 0; j < 4; ++j) { v[j] = xr[64 * j]; s += v[j].x * v[j].x + v[j].y * v[j].y + v[j].z * v[j].z + v[j].w * v[j].w; }
        s = wave_sum(s);
        if (lane == 0) RS[m] = rsqrtf(s * (1.f / D) + EPS);
#pragma unroll
        for (int j = 0; j < 4; ++j) {
            ((float4*)(X + (size_t)m * D) + lane)[64 * j] = v[j];
            ((uint2*)(XB + (size_t)m * D) + lane)[64 * j] = make_uint2(pk2(v[j].x, v[j].y), pk2(v[j].z, v[j].w));
        }
    }
}

typedef float f32x4 __attribute__((ext_vector_type(4)));
__device__ __forceinline__ void router_tile(const P& p, int l, int tile, LAS float* lg  , int lane) {
    const int r = lane & 15, q = lane >> 4, tok0 = tile * 16;
    const float* X = (const float*)(p.ws + WS_X) + (size_t)(tok0 + r) * D + q * 4;
    const float* W = (const float*)(p.ws + WS_WR) + (size_t)l * 48 * D + (size_t)r * D + q * 4;
    f32x4 acc[3] = {{0.f, 0.f, 0.f, 0.f}, {0.f, 0.f, 0.f, 0.f}, {0.f, 0.f, 0.f, 0.f}};
    float ss = 0.f;
#pragma unroll 4
    for (int kk = 0; kk < 64; ++kk) {
        const float4 xa = *(const float4*)(X + kk * 16);
        ss += xa.x * xa.x + xa.y * xa.y + xa.z * xa.z + xa.w * xa.w;
#pragma unroll
        for (int nt = 0; nt < 3; ++nt) {
            const float4 wb = *(const float4*)(W + (size_t)nt * 16 * D + kk * 16);
            acc[nt] = __builtin_amdgcn_mfma_f32_16x16x4f32(xa.x, wb.x, acc[nt], 0, 0, 0);
            acc[nt] = __builtin_amdgcn_mfma_f32_16x16x4f32(xa.y, wb.y, acc[nt], 0, 0, 0);
            acc[nt] = __builtin_amdgcn_mfma_f32_16x16x4f32(xa.z, wb.z, acc[nt], 0, 0, 0);
            acc[nt] = __builtin_amdgcn_mfma_f32_16x16x4f32(xa.w, wb.w, acc[nt], 0, 0, 0);
        }
    }
    ss += __shfl_xor(ss, 16); ss += __shfl_xor(ss, 32);
    const float rs_mine = rsqrtf(ss * (1.f / D) + EPS);
#pragma unroll
    for (int nt = 0; nt < 3; ++nt)
#pragma unroll
        for (int reg = 0; reg < 4; ++reg) lg[(q * 4 + reg) * 48 + nt * 16 + r] = acc[nt][reg];
    LDS_WAIT();
    if (lane < 16) {
        const int tok = tok0 + lane; const float rs = rs_mine;
        ((float*)(p.ws + WS_RSTD2))[tok] = rs;
        const LAS float* L = lg + lane * 48;
        float g0 = L[0] * rs, g1 = L[1] * rs, g2 = L[2] * rs, g3 = L[3] * rs;
        int gs = 0; float gm = g0;
        if (g1 > gm) { gm = g1; gs = 1; }
        if (g2 > gm) { gm = g2; gs = 2; }
        if (g3 > gm) { gm = g3; gs = 3; }
        const float pg = 1.f / (expf(g0 - gm) + expf(g1 - gm) + expf(g2 - gm) + expf(g3 - gm));
        float e[8];
#pragma unroll
        for (int j = 0; j < 8; ++j) e[j] = L[4 + gs * 8 + j] * rs;
        int i1 = 0; float m1 = e[0];
#pragma unroll
        for (int j = 1; j < 8; ++j) if (e[j] > m1) { m1 = e[j]; i1 = j; }
        int i2 = -1; float m2 = -3e38f;
#pragma unroll
        for (int j = 0; j < 8; ++j) if (j != i1 && e[j] > m2) { m2 = e[j]; i2 = j; }
        const float p2 = expf(m2 - m1), inv = 1.f / (1.f + p2);
        const float w1 = pg * inv, w2 = pg * p2 * inv;
        const int e1 = gs * 8 + i1, e2 = gs * 8 + i2;
        u32* ecnt = (u32*)(p.ws + WS_CTL) + CW_ECNT + l * 32;
        int* elist = (int*)(p.ws + WS_ELIST);
        float* sw = (float*)(p.ws + WS_SLOTW);
        const u32 p1 = atomicAdd(ecnt + e1, 1u); elist[(size_t)e1 * NSLOT + p1] = tok * 2;
        const u32 p2i = atomicAdd(ecnt + e2, 1u); elist[(size_t)e2 * NSLOT + p2i] = tok * 2 + 1;
        sw[tok * 2] = w1; sw[tok * 2 + 1] = w2;
    }
    LDS_WAIT();
}
__device__ __forceinline__ void phase_combine(const P& p, int l, int gw, int NGW, int lane) {
    float* X = (float*)(p.ws + WS_X); bf16* XB = (bf16*)(p.ws + WS_XB); float* RS = (float*)(p.ws + WS_RSTD);
    const bf16* YS = (const bf16*)(p.ws + WS_YS);
    for (int m = gw; m < T; m += NGW) {
        float4 v[4]; float s = 0.f;
#pragma unroll
        for (int j = 0; j < 4; ++j) {
            v[j] = ((const float4*)(X + (size_t)m * D) + lane)[64 * j];
            const uint2 a = ((const uint2*)(YS + (size_t)(2 * m) * D) + lane)[64 * j], b = ((const uint2*)(YS + (size_t)(2 * m + 1) * D) + lane)[64 * j];
            v[j].x += blo(a.x) + blo(b.x); v[j].y += bhi(a.x) + bhi(b.x); v[j].z += blo(a.y) + blo(b.y); v[j].w += bhi(a.y) + bhi(b.y);
            s += v[j].x * v[j].x + v[j].y * v[j].y + v[j].z * v[j].z + v[j].w * v[j].w;
        }
        s = wave_sum(s);
        const float rs = rsqrtf(s * (1.f / D) + EPS);
        if (l == DEPTH - 1) {
#pragma unroll
            for (int j = 0; j < 4; ++j) {
                const float4 g = ((const float4*)p.g_fin + lane)[64 * j];
                ((float4*)(p.out + (size_t)m * D) + lane)[64 * j] = make_float4(v[j].x * rs * g.x, v[j].y * rs * g.y, v[j].z * rs * g.z, v[j].w * rs * g.w);
            }
        } else {
            if (lane == 0) RS[m] = rs;
#pragma unroll
            for (int j = 0; j < 4; ++j) {
                ((float4*)(X + (size_t)m * D) + lane)[64 * j] = v[j];
                ((uint2*)(XB + (size_t)m * D) + lane)[64 * j] = make_uint2(pk2(v[j].x, v[j].y), pk2(v[j].z, v[j].w));
            }
        }
    }
}

__device__ __forceinline__ const void* lptr(LAS unsigned char* lds, int k) {
    const unsigned long long v = ((const LAS unsigned long long*)(lds + LDS_PTRS))[k];
    const unsigned lo = __builtin_amdgcn_readfirstlane((unsigned)v), hi = __builtin_amdgcn_readfirstlane((unsigned)(v >> 32));
    return (const void*)(((unsigned long long)hi << 32) | lo);
}
__device__ __forceinline__ P load_params(LAS unsigned char* lds, unsigned char* ws) {
    P q;
    q.x = (const float*)lptr(lds, 0); q.pos = (const int*)lptr(lds, 1); q.w_in = (const float*)lptr(lds, 2); q.w_out = (const float*)lptr(lds, 3);
    q.g_mix = (const float*)lptr(lds, 4); q.g_head = (const float*)lptr(lds, 5); q.g_vn = (const float*)lptr(lds, 6); q.w_sp = (const float*)lptr(lds, 7);
    q.b_sp = (const float*)lptr(lds, 8); q.g_ffn = (const float*)lptr(lds, 9); q.w_rg = (const float*)lptr(lds, 10); q.w_re = (const float*)lptr(lds, 11);
    q.w_g = (const float*)lptr(lds, 12); q.w_u = (const float*)lptr(lds, 13); q.w_d = (const float*)lptr(lds, 14); q.g_fin = (const float*)lptr(lds, 15);
    q.out = (float*)lptr(lds, 16); q.ws = ws;
    return q;
}
constexpr int NSTEPS = 1 + 7 * DEPTH;
__global__ void __launch_bounds__(NWAVES * 64, 2) mk(P p, int s_lo, int s_hi, int bar_region) {
    extern __shared__ __attribute__((aligned(16))) unsigned char lds_raw[];
    LAS unsigned char* lds = (LAS unsigned char*)lds_raw;
    const int wave = __builtin_amdgcn_readfirstlane(threadIdx.x >> 6);
    const int G = gridDim.x, bx = blockIdx.x;
    const int vcu = (G % 8 == 0) ? (bx % 8) * (G / 8) + bx / 8 : bx;
    const int gw = vcu * NWAVES + wave, NGW = G * NWAVES;
    unsigned char* ws = p.ws;
    volatile LAS unsigned* misc = (volatile LAS unsigned*)(lds + LDS_MISC);
    if (threadIdx.x < 4) misc[threadIdx.x] = 0u;
    if (threadIdx.x == 0) {
        LAS unsigned long long* pp = (LAS unsigned long long*)(lds + LDS_PTRS);
        pp[0] = (unsigned long long)p.x; pp[1] = (unsigned long long)p.pos; pp[2] = (unsigned long long)p.w_in; pp[3] = (unsigned long long)p.w_out;
        pp[4] = (unsigned long long)p.g_mix; pp[5] = (unsigned long long)p.g_head; pp[6] = (unsigned long long)p.g_vn; pp[7] = (unsigned long long)p.w_sp;
        pp[8] = (unsigned long long)p.b_sp; pp[9] = (unsigned long long)p.g_ffn; pp[10] = (unsigned long long)p.w_rg; pp[11] = (unsigned long long)p.w_re;
        pp[12] = (unsigned long long)p.w_g; pp[13] = (unsigned long long)p.w_u; pp[14] = (unsigned long long)p.w_d; pp[15] = (unsigned long long)p.g_fin;
        pp[16] = (unsigned long long)p.out;
    }
    __syncthreads();
    XcdBarrier bar = xcd_barrier_post((unsigned*)(ws + WS_CTL) + CW_BAR + bar_region * XCD_BAR_WORDS, misc);
#define IN(k) (s_lo <= (k) && (k) < s_hi)
#define SEAM(k) do { if (IN(k) && IN((k) + 1)) xcd_barrier(bar, wave == 0 && lane_id_opaque() == 0); } while (0)

#define OPQ_WS(name) unsigned char* name = ws; asm volatile("" : "+s"(name))
#define OPQ_LDS(name) LAS unsigned char* name = lds; asm volatile("" : "+s"(name))
#define OPQ_LANE(name) const int name = lane_id_opaque()
    if (IN(0)) { OPQ_WS(w); OPQ_LDS(ld); OPQ_LANE(ln); const P q = load_params(ld, w); phase_prologue(q, ld, gw, NGW, wave, ln); __syncthreads(); }
    SEAM(0);
#pragma unroll 1
    for (int l = 0; l < DEPTH; ++l) {
        const int s0 = 1 + 7 * l;
        if (IN(s0 + 0)) {
            OPQ_WS(w); OPQ_LDS(ld);
            pg8::StaticOrder S; S.init(T, INC, G, bx, (const bf16*)(w + WS_WIN) + (size_t)l * INC * D);
            pg8::EpiInProj E{(bf16*)(w + WS_PROJ), (const float*)(w + WS_RSTD), (const float*)(w + WS_ROPE)};
            pg8::gemm_phase<pg8::EpiInProj, pg8::StaticOrder, true>(ld, (const bf16*)(w + WS_XB), D, S, E, wave);
        }
        SEAM(s0 + 0);
        SEAM(s0 + 1);
        if (IN(s0 + 2)) {
            OPQ_WS(w); OPQ_LDS(ld);
            pg8::StaticOrder S; S.init(T, D, G, bx, (const bf16*)(w + WS_WOUT) + (size_t)l * D * D);
            pg8::EpiOutProj E{(float*)(w + WS_X), (bf16*)(w + WS_XB)};
            pg8::gemm_phase<pg8::EpiOutProj, pg8::StaticOrder, false>(ld, (const bf16*)(w + WS_ON), D, S, E, wave);
        }
        SEAM(s0 + 2);
        if (IN(s0 + 3)) {
            OPQ_WS(w); OPQ_LDS(ld); OPQ_LANE(ln);
            LAS float* lg = (LAS float*)(ld + wave * 3072);
            P q{}; q.ws = w;
            for (int tile = gw; tile < T / 16; tile += NGW) router_tile(q, l, tile, lg, ln);
            __syncthreads();
        }
        SEAM(s0 + 3);
        if (IN(s0 + 4) || IN(s0 + 5)) {
            { OPQ_WS(w); OPQ_LDS(ld);
              LAS int* tbl = (LAS int*)(ld + LDS_TBL);
              __syncthreads();
              if (wave == 0 && lane_id_opaque() == 0) {
                  const u32* ecnt = (const u32*)(w + WS_CTL) + CW_ECNT + l * 32; int base = 0;
                  for (int e = 0; e < NE; ++e) { const int c = (int)__hip_atomic_load(ecnt + e, __ATOMIC_RELAXED, __HIP_MEMORY_SCOPE_AGENT); tbl[e] = base; tbl[33 + e] = c; base += (c + 255) >> 8; }
                  tbl[32] = base;
              }
              __syncthreads(); }
            if (IN(s0 + 4)) {
                OPQ_WS(w); OPQ_LDS(ld);
                pg8::MoeOrder<true, 4> S{(const LAS int*)(ld + LDS_TBL), (const int*)(w + WS_ELIST), (const bf16*)(w + WS_WGU) + (size_t)l * NE * 1024 * 1024, (size_t)1024 * 1024, G, bx};
                pg8::EpiMoe1 E{(bf16*)(w + WS_ABUF), (const float*)(w + WS_RSTD2), (const int*)(w + WS_ELIST)};
                pg8::gemm_phase<pg8::EpiMoe1, pg8::MoeOrder<true, 4>, true>(ld, (const bf16*)(w + WS_XB), D, S, E, wave);
            }
            SEAM(s0 + 4);
            if (IN(s0 + 5)) {
                OPQ_WS(w); OPQ_LDS(ld);
                pg8::MoeOrder<false, 4> S{(const LAS int*)(ld + LDS_TBL), (const int*)(w + WS_ELIST), (const bf16*)(w + WS_WD) + (size_t)l * NE * 1024 * 512, (size_t)1024 * 512, G, bx};
                pg8::EpiMoe2 E{(bf16*)(w + WS_YS), (const float*)(w + WS_SLOTW), (const int*)(w + WS_ELIST)};
                pg8::gemm_phase<pg8::EpiMoe2, pg8::MoeOrder<false, 4>, true>(ld, (const bf16*)(w + WS_ABUF), DE, S, E, wave);
            }
        }
        SEAM(s0 + 5);
        if (IN(s0 + 6)) { OPQ_WS(w); OPQ_LDS(ld); OPQ_LANE(ln); const P q = load_params(ld, w); phase_combine(q, l, gw, NGW, ln); }
        SEAM(s0 + 6);
    }
#undef IN
#undef SEAM
}

__global__ void k_kmean_naive(P p) {
    const int idx = blockIdx.x * blockDim.x + threadIdx.x;
    const int d = idx & 63, blk = (idx >> 6) & 7, h = (idx >> 9) & 7, b = idx >> 12;
    const bf16* PR = (const bf16*)(p.ws + WS_PROJ);
    float s = 0.f;
    for (int j = 0; j < 256; ++j) s += bf2f(PR[(size_t)(b * SEQ + blk * 256 + j) * INC + C_KB + h * 64 + d]);
    ((float*)(p.ws + WS_KMEAN))[idx] = s * (1.f / 256.f);
}
__global__ void __launch_bounds__(64) k_sb_naive(P p) {
    const int idx = blockIdx.x * 64 + threadIdx.x;
    const int t = idx % SEQ, h = (idx / SEQ) % 4, b = idx / (SEQ * 4);
    const bf16* PR = (const bf16*)(p.ws + WS_PROJ);
    const size_t row = (size_t)b * SEQ + t;
    uint4 q[8];
#pragma unroll
    for (int i = 0; i < 8; ++i) q[i] = *(const uint4*)(PR + row * INC + C_QA + h * 64 + i * 8);
    float acc[64];
#pragma unroll
    for (int i = 0; i < 64; ++i) acc[i] = 0.f;
    float L = 0.f;
    for (int s = t - 1; s >= 0; --s) {
        const bf16* kr = PR + ((size_t)b * SEQ + s) * INC + C_KA + h * 64;
        const bf16* vr = PR + ((size_t)b * SEQ + s) * INC + C_VA + h * 64;
        float z = 0.f;
#pragma unroll
        for (int i = 0; i < 8; ++i) z += dot8(q[i], *(const uint4*)(kr + i * 8));
        z *= 0.125f;
        const float l1p = log1pf(expf(-fabsf(z)));
        const float ls = fminf(z, 0.f) - l1p, lr = fminf(-z, 0.f) - l1p;
        const float w = expf(ls + L);
        L += lr;
#pragma unroll
        for (int i = 0; i < 8; ++i) {
            const uint4 vv = *(const uint4*)(vr + i * 8);
            acc[i * 8 + 0] += w * blo(vv.x); acc[i * 8 + 1] += w * bhi(vv.x); acc[i * 8 + 2] += w * blo(vv.y); acc[i * 8 + 3] += w * bhi(vv.y);
            acc[i * 8 + 4] += w * blo(vv.z); acc[i * 8 + 5] += w * bhi(vv.z); acc[i * 8 + 6] += w * blo(vv.w); acc[i * 8 + 7] += w * bhi(vv.w);
        }
    }
    float* O = (float*)(p.ws + WS_YS) + row * D + h * 64;
#pragma unroll
    for (int i = 0; i < 16; ++i) *(float4*)(O + i * 4) = make_float4(acc[i * 4], acc[i * 4 + 1], acc[i * 4 + 2], acc[i * 4 + 3]);
}
__global__ void __launch_bounds__(64) k_moba_naive(P p) {
    const int idx = blockIdx.x * 64 + threadIdx.x;
    const int t = idx % SEQ, h = (idx / SEQ) % 8, b = idx / (SEQ * 8);
    const bf16* PR = (const bf16*)(p.ws + WS_PROJ);
    const size_t row = (size_t)b * SEQ + t;
    const int own = t >> 8;
    uint4 q[8];
#pragma unroll
    for (int i = 0; i < 8; ++i) q[i] = *(const uint4*)(PR + row * INC + C_QB + h * 64 + i * 8);
    const float* KM = (const float*)(p.ws + WS_KMEAN) + ((size_t)(b * 8 + h) * 8) * 64;
    float g[8];
#pragma unroll
    for (int j = 0; j < 8; ++j) {
        float s = -1e30f;
        if (j < own) {
            s = 0.f;
#pragma unroll
            for (int i = 0; i < 8; ++i) {
                const float* km = KM + j * 64 + i * 8;
                s += blo(q[i].x) * km[0] + bhi(q[i].x) * km[1] + blo(q[i].y) * km[2] + bhi(q[i].y) * km[3] + blo(q[i].z) * km[4] + bhi(q[i].z) * km[5] + blo(q[i].w) * km[6] + bhi(q[i].w) * km[7];
            }
        }
        g[j] = s;
    }
    unsigned selmask = 0; const int nsel = own < 3 ? own : 3;
    for (int r = 0; r < nsel; ++r) {
        float best = -3e38f; int bi = 0;
#pragma unroll
        for (int j = 0; j < 8; ++j) { const bool ok = !((selmask >> j) & 1u) && g[j] > best; if (ok) { best = g[j]; bi = j; } }
        selmask |= 1u << bi;
    }
    float acc[64];
#pragma unroll
    for (int i = 0; i < 64; ++i) acc[i] = 0.f;
    float mx = -3e38f, lsum = 0.f;
    for (int blk = 0; blk <= own; ++blk) {
        if (blk < own && !((selmask >> blk) & 1u)) continue;
        const int s1 = blk == own ? t : blk * 256 + 255;
        for (int s = blk * 256; s <= s1; ++s) {
            const bf16* kr = PR + ((size_t)b * SEQ + s) * INC + C_KB + h * 64;
            const bf16* vr = PR + ((size_t)b * SEQ + s) * INC + C_VB + h * 64;
            float z = 0.f;
#pragma unroll
            for (int i = 0; i < 8; ++i) z += dot8(q[i], *(const uint4*)(kr + i * 8));
            z *= 0.125f;
            const float mn = fmaxf(mx, z), sc = expf(mx - mn), w = expf(z - mn);
            mx = mn; lsum = lsum * sc + w;
#pragma unroll
            for (int i = 0; i < 8; ++i) {
                const uint4 vv = *(const uint4*)(vr + i * 8);
                acc[i * 8 + 0] = acc[i * 8 + 0] * sc + w * blo(vv.x); acc[i * 8 + 1] = acc[i * 8 + 1] * sc + w * bhi(vv.x);
                acc[i * 8 + 2] = acc[i * 8 + 2] * sc + w * blo(vv.y); acc[i * 8 + 3] = acc[i * 8 + 3] * sc + w * bhi(vv.y);
                acc[i * 8 + 4] = acc[i * 8 + 4] * sc + w * blo(vv.z); acc[i * 8 + 5] = acc[i * 8 + 5] * sc + w * bhi(vv.z);
                acc[i * 8 + 6] = acc[i * 8 + 6] * sc + w * blo(vv.w); acc[i * 8 + 7] = acc[i * 8 + 7] * sc + w * bhi(vv.w);
            }
        }
    }
    const float il = 1.f / lsum;
    float* O = (float*)(p.ws + WS_YS) + row * D + 256 + h * 64;
#pragma unroll
    for (int i = 0; i < 16; ++i) *(float4*)(O + i * 4) = make_float4(acc[i * 4] * il, acc[i * 4 + 1] * il, acc[i * 4 + 2] * il, acc[i * 4 + 3] * il);
}
__global__ void k_gvn_naive(P p, int l) {
    const int idx = blockIdx.x * blockDim.x + threadIdx.x;
    const int g = idx & 3, t = idx >> 2;
    const bf16* v = (const bf16*)(p.ws + WS_PROJ) + (size_t)t * INC + C_VC + g * 64;
    float s = 0.f;
    for (int d = 0; d < 64; ++d) { const float x = bf2f(v[d]); s += x * x; }
    const float rs = rsqrtf(s * (1.f / 64.f) + EPS);
    float* o = (float*)(p.ws + WS_ABUF) + (size_t)t * 256 + g * 64;
    for (int d = 0; d < 64; ++d) o[d] = bf2f(v[d]) * rs * p.g_vn[(l * 4 + g) * 64 + d];
}
__global__ void k_gmlp_naive(P p, int l) {
    const int idx = blockIdx.x * blockDim.x + threadIdx.x;
    const int d = idx & 63, g = (idx >> 6) & 3, t = idx >> 8;
    const int tc = t & 127, t0 = t - tc;
    const float* VN = (const float*)(p.ws + WS_ABUF);
    const float* w = p.w_sp + ((size_t)(l * 4 + g) * 128 + tc) * 128;
    float s = 0.f;
    for (int j = 0; j <= tc; ++j) s += w[j] * VN[(size_t)(t0 + j) * 256 + g * 64 + d];
    s += p.b_sp[(l * 4 + g) * 128 + tc];
    const float u = bf2f(((const bf16*)(p.ws + WS_PROJ))[(size_t)t * INC + C_UC + g * 64 + d]);
    ((float*)(p.ws + WS_YS))[(size_t)t * D + 768 + g * 64 + d] = u * s;
}
__global__ void k_headnorm_naive(P p, int l) {
    const int idx = blockIdx.x * blockDim.x + threadIdx.x;
    const int h = idx & 15, t = idx >> 4;
    const float* o = (const float*)(p.ws + WS_YS) + (size_t)t * D + h * 64;
    float s = 0.f;
    for (int d = 0; d < 64; ++d) s += o[d] * o[d];
    const float rs = rsqrtf(s * (1.f / 64.f) + EPS);
    bf16* on = (bf16*)(p.ws + WS_ON) + (size_t)t * D + h * 64;
    for (int d = 0; d < 64; ++d) on[d] = f2bf(o[d] * rs * p.g_head[(l * 16 + h) * 64 + d]);
}

extern "C" void kernel_launch(void* const* d_in, const int* in_sizes, int n_in, void* d_out, int out_size, void* d_ws, size_t ws_size, hipStream_t stream) {
    static int grid = 0;
    if (grid == 0) {
        if (n_in != 16 || out_size != T * D || ws_size < WS_END) { fprintf(stderr, "kernel_launch: unexpected sizes (n_in %d out %d ws %zu)\n", n_in, out_size, ws_size); grid = -1; return; }
        int dev = 0, cus = 0, per_cu = 0;
        if (hipGetDevice(&dev) != hipSuccess || hipDeviceGetAttribute(&cus, hipDeviceAttributeMultiprocessorCount, dev) != hipSuccess) { grid = -1; return; }
        if (hipFuncSetAttribute((const void*)mk, hipFuncAttributeMaxDynamicSharedMemorySize, LDS_BYTES) != hipSuccess) { fprintf(stderr, "kernel_launch: hipFuncSetAttribute failed\n"); grid = -1; return; }
        if (hipOccupancyMaxActiveBlocksPerMultiprocessor(&per_cu, (const void*)mk, NWAVES * 64, LDS_BYTES) != hipSuccess || per_cu < 1) fprintf(stderr, "kernel_launch: occupancy query says %d\n", per_cu);
        (void)hipGetLastError();
        grid = cus;
    }
    if (grid < 0) return;
    P p{};
    p.x = (const float*)d_in[0]; p.pos = (const int*)d_in[1]; p.w_in = (const float*)d_in[2]; p.w_out = (const float*)d_in[3];
    p.g_mix = (const float*)d_in[4]; p.g_head = (const float*)d_in[5]; p.g_vn = (const float*)d_in[6]; p.w_sp = (const float*)d_in[7];
    p.b_sp = (const float*)d_in[8]; p.g_ffn = (const float*)d_in[9]; p.w_rg = (const float*)d_in[10]; p.w_re = (const float*)d_in[11];
    p.w_g = (const float*)d_in[12]; p.w_u = (const float*)d_in[13]; p.w_d = (const float*)d_in[14]; p.g_fin = (const float*)d_in[15];
    p.out = (float*)d_out; p.ws = (unsigned char*)d_ws;
    (void)hipMemsetAsync((char*)d_ws + WS_CTL, 0, CTL_BYTES, stream);
    int region = 0;
    auto launch = [&](int lo, int hi) { hipLaunchKernelGGL(mk, dim3(grid), dim3(NWAVES * 64), LDS_BYTES, stream, p, lo, hi, region); ++region; };
    int lo = 0;
    for (int l = 0; l < DEPTH; ++l) {
        const int s0 = 1 + 7 * l;
        launch(lo, s0 + 1);
        k_kmean_naive<<<BATCH * 8 * 8 * 64 / 256, 256, 0, stream>>>(p);
        k_sb_naive<<<BATCH * 4 * SEQ / 64, 64, 0, stream>>>(p);
        k_moba_naive<<<BATCH * 8 * SEQ / 64, 64, 0, stream>>>(p);
        k_gvn_naive<<<T * 4 / 256, 256, 0, stream>>>(p, l);
        k_gmlp_naive<<<T * 256 / 256, 256, 0, stream>>>(p, l);
        k_headnorm_naive<<<T * 16 / 256, 256, 0, stream>>>(p, l);
        lo = s0 + 2;
    }
    launch(lo, NSTEPS);
}
```

```cpp
#include <hip/hip_runtime.h>
#include <cstdint>
#include <cstdio>

constexpr int D = 1024, BATCH = 8, SEQ = 2048, T = BATCH * SEQ, DEPTH = 4;
constexpr int HD = 64;
constexpr int INC = 2816;
constexpr int C_QA = 0, C_KA = 256, C_VA = 512, C_QB = 768, C_KB = 1280, C_VB = 1792, C_UC = 2304, C_VC = 2560;
constexpr int NE = 32, EPG = 8, DE = 512;
constexpr int NSLOT = T * 2;
constexpr int MAXMT = 160;
constexpr float EPS = 1e-6f;

typedef unsigned short bf16;
typedef unsigned u32;
#define LAS __attribute__((address_space(3)))
#define GAS __attribute__((address_space(1)))

constexpr size_t MiB = 1u << 20;
constexpr size_t WS_CTL = 0, CTL_BYTES = 1 * MiB;
constexpr size_t WS_WR = 1 * MiB;
constexpr size_t WS_ROPE = 2 * MiB;
constexpr size_t WS_RSTD = 3 * MiB;
constexpr size_t WS_RSTD2 = WS_RSTD + 65536;
constexpr size_t WS_SLOTW = WS_RSTD2 + 65536;
constexpr size_t WS_KMEAN = WS_RSTD + 524288;
constexpr size_t WS_ELIST = 4 * MiB;
constexpr size_t WS_WIN = 8 * MiB;
constexpr size_t WS_WOUT = 30 * MiB;
constexpr size_t WS_WGU = 38 * MiB;
constexpr size_t WS_WD = 294 * MiB;
constexpr size_t WS_X = 422 * MiB;
constexpr size_t WS_XB = 486 * MiB;
constexpr size_t WS_PROJ = 518 * MiB;
constexpr size_t WS_ON = 606 * MiB;
constexpr size_t WS_ABUF = 638 * MiB;
constexpr size_t WS_YS = 678 * MiB;
constexpr size_t WS_END = 742 * MiB;
constexpr int CW_ECNT = 1024;
constexpr int CW_BAR = 4096;
constexpr int RING_BYTES = 131072;
constexpr int LDS_TBL = RING_BYTES;
constexpr int LDS_MISC = RING_BYTES + 1024;
constexpr int LDS_PTRS = RING_BYTES + 2048;
constexpr int LDS_BYTES = 147456;
constexpr int NWAVES = 8;

struct P {
    const float* x; const int* pos; const float* w_in; const float* w_out; const float* g_mix; const float* g_head; const float* g_vn;
    const float* w_sp; const float* b_sp; const float* g_ffn; const float* w_rg; const float* w_re; const float* w_g; const float* w_u;
    const float* w_d; const float* g_fin; float* out; unsigned char* ws;
};

__device__ __forceinline__ bf16 f2bf(float f) { u32 u = __float_as_uint(f); return (bf16)((u + 0x7fffu + ((u >> 16) & 1u)) >> 16); }
__device__ __forceinline__ float bf2f(bf16 h) { return __uint_as_float((u32)h << 16); }
__device__ __forceinline__ u32 pk2(float lo, float hi) { return (u32)f2bf(lo) | ((u32)f2bf(hi) << 16); }
__device__ __forceinline__ float blo(u32 u) { return __uint_as_float(u << 16); }
__device__ __forceinline__ float bhi(u32 u) { return __uint_as_float(u & 0xffff0000u); }
__device__ __forceinline__ float wave_sum(float v) {
#pragma unroll
    for (int o = 1; o < 64; o <<= 1) v += __shfl_xor(v, o);
    return v;
}
__device__ __forceinline__ float dot8(uint4 a, uint4 b) {
    return blo(a.x) * blo(b.x) + bhi(a.x) * bhi(b.x) + blo(a.y) * blo(b.y) + bhi(a.y) * bhi(b.y) +
           blo(a.z) * blo(b.z) + bhi(a.z) * bhi(b.z) + blo(a.w) * blo(b.w) + bhi(a.w) * bhi(b.w);
}
__device__ __forceinline__ float gelu_tanh(float x) {
    const float u = 0.7978845608028654f * (x + 0.044715f * x * x * x);
    return x / (1.f + __expf(-2.f * u));
}
#define LDS_WAIT() asm volatile("s_waitcnt lgkmcnt(0)" ::: "memory")
__device__ __forceinline__ int lane_id_opaque() { int ln; asm volatile("v_mbcnt_lo_u32_b32 %0, -1, 0\n\tv_mbcnt_hi_u32_b32 %0, -1, %0" : "=v"(ln)); return ln; }

namespace pg8 {
typedef unsigned short bf16_t;
typedef short bf16x8 __attribute__((ext_vector_type(8)));
typedef float f32x4 __attribute__((ext_vector_type(4)));
typedef unsigned u32x4 __attribute__((ext_vector_type(4)));
typedef unsigned u32x2 __attribute__((ext_vector_type(2)));
constexpr int BM = 256, BK = 64, HALF = 128, HTB = HALF * BK * 2, STAGE_BYTES = 8 * HTB, NXCD = 8, WGM = 8;

__host__ __device__ __forceinline__ int lds_byte(int r, int c) { const int st = (r >> 4) * 2 + (c >> 5), rr = r & 15, cc = c & 31, ob = rr * 64 + cc * 2; return st * 1024 + (ob ^ (((ob >> 9) & 1) << 5)); }
__host__ __device__ __forceinline__ void stage_rc(int b, int& R, int& C) { const int st = b / 1024, sb = b % 1024, swz = sb ^ (((sb >> 9) & 1) << 5); R = (st >> 1) * 16 + swz / 64; C = (st & 1) * 32 + (swz % 64) / 2; }
__host__ __device__ __forceinline__ int perm32(int rho) { const int n = rho >> 4, i = rho & 15; return 8 * (i >> 2) + 4 * n + (i & 3); }

struct Unit { int pm, pn, e, r0, nvalid; };

struct StaticOrder {
    static constexpr bool GATHER = false;
    int nM, nN, nwg, G, c; const bf16_t* Bt;
    __device__ void init(int M, int N, int G_, int c_, const bf16_t* Bt_) { nM = M / BM; nN = N / BM; nwg = nM * nN; G = G_; c = c_; Bt = Bt_; }
    __device__ __forceinline__ bool next(int i, Unit& u) const {
        const long L = (long)i * G + c; if (L >= nwg) return false;
        int wgid = (int)L; { const int q = nwg / NXCD, r = nwg % NXCD, xcd = wgid % NXCD, off = wgid / NXCD; wgid = (xcd < r ? xcd * (q + 1) : r * (q + 1) + (xcd - r) * q) + off; }
        const int nig = WGM * nN, gid = wgid / nig, fm = gid * WGM, gsz = (nM - fm) < WGM ? (nM - fm) : WGM;
        u.pm = fm + ((wgid % nig) % gsz); u.pn = (wgid % nig) / gsz; u.e = 0; u.r0 = 0; u.nvalid = 256; return true;
    }
    __device__ __forceinline__ void a_offs(const Unit& u, int K, const int (&R)[2], const int (&C)[2], unsigned (&v)[2][2]) const {
#pragma unroll
        for (int h = 0; h < 2; ++h)
#pragma unroll
            for (int i = 0; i < 2; ++i) v[h][i] = (unsigned)((u.pm * BM + h * HALF + R[i]) * K + C[i]) * 2u;
    }
    __device__ __forceinline__ const char* b_ptr(const Unit& u, int K) const { return (const char*)(Bt + (size_t)u.pn * BM * K); }
};
template <bool GATHER_, int NN>
struct MoeOrder {
    static constexpr bool GATHER = GATHER_;
    const LAS int* tbl; const int* elist; const bf16_t* Bt; size_t estride; int G, c;
    __device__ __forceinline__ bool next(int i, Unit& u) const {
        const int L = i * G + c, nmt = tbl[32]; if (L >= nmt * NN) return false;
        const int mt = L / NN; u.pn = L % NN; u.pm = mt;
        int e = 0;
#pragma unroll 1
        while (tbl[e + 1] <= mt) ++e;
        u.e = e; u.r0 = (mt - tbl[e]) * 256; const int rem = tbl[33 + e] - u.r0; u.nvalid = rem < 256 ? rem : 256; return true;
    }
    __device__ __forceinline__ void a_offs(const Unit& u, int K, const int (&R)[2], const int (&C)[2], unsigned (&v)[2][2]) const {
#pragma unroll
        for (int h = 0; h < 2; ++h)
#pragma unroll
            for (int i = 0; i < 2; ++i) {
                const int r = h * HALF + R[i]; int row;
                if (GATHER) { row = 0; if (r < u.nvalid) row = elist[(size_t)u.e * NSLOT + u.r0 + r] >> 1; }
                else row = u.pm * BM + r;
                v[h][i] = (unsigned)(row * K + C[i]) * 2u;
            }
    }
    __device__ __forceinline__ const char* b_ptr(const Unit& u, int K) const { return (const char*)(Bt + (size_t)u.e * estride + (size_t)u.pn * BM * K); }
};

__device__ __forceinline__ unsigned cvt_pk_bf16(float lo, float hi) { unsigned r; asm volatile("v_cvt_pk_bf16_f32 %0, %1, %2" : "=v"(r) : "v"(lo), "v"(hi)); return r; }

struct EpiInProj {
    static constexpr bool PERM = true;
    bf16_t* O; const float* rstd; const float* rope; float* kmp;
    __device__ __forceinline__ void operator()(const f32x4 (&acc)[2][2][4][2], const Unit& u, int wr, int wc, int fr, int fq) const {
        const int mode = (u.pn >= 3 && u.pn <= 6) ? 1 : (u.pn >= 9 ? 2 : 0);
        const int row0 = u.pm * BM + wr * 64 + fr, col0 = u.pn * BM + wc * 32 + 8 * fq;
        const bool ropew = (mode == 1) && ((wc & 1) == 0);
        const bool ksum = (u.pn == 5 || u.pn == 6);
        float cs[2][8];
#pragma unroll
        for (int bj = 0; bj < 2; ++bj)
#pragma unroll
            for (int j = 0; j < 8; ++j) cs[bj][j] = 0.f;
#pragma unroll
        for (int ai = 0; ai < 2; ++ai)
#pragma unroll
            for (int m = 0; m < 4; ++m) {
                const int row = row0 + ai * HALF + m * 16; const float rs = rstd[row];
                bf16_t* rowp = O + (size_t)row * INC + col0;
#pragma unroll
                for (int bj = 0; bj < 2; ++bj) {
                    f32x4 v0 = acc[ai][bj][m][0] * rs, v1 = acc[ai][bj][m][1] * rs;
                    if (ropew) {
                        const f32x4* cs4 = (const f32x4*)(rope + (size_t)row * 16);
                        const f32x4 c0 = cs4[0], c1 = cs4[1], c2 = cs4[2], c3 = cs4[3];
                        f32x4 p0, p1;
#pragma unroll
                        for (int j = 0; j < 4; ++j) { p0[j] = __shfl_xor(v0[j], 16); p1[j] = __shfl_xor(v1[j], 16); }
                        const float sg = fq == 0 ? -1.f : 1.f;
                        if (fq < 2) {
                            v0[0] = v0[0] * c0[0] + sg * p0[0] * c0[1]; v0[1] = v0[1] * c0[2] + sg * p0[1] * c0[3];
                            v0[2] = v0[2] * c1[0] + sg * p0[2] * c1[1]; v0[3] = v0[3] * c1[2] + sg * p0[3] * c1[3];
                            v1[0] = v1[0] * c2[0] + sg * p1[0] * c2[1]; v1[1] = v1[1] * c2[2] + sg * p1[1] * c2[3];
                            v1[2] = v1[2] * c3[0] + sg * p1[2] * c3[1]; v1[3] = v1[3] * c3[2] + sg * p1[3] * c3[3];
                        }
                    }
                    if (ksum) {
#pragma unroll
                        for (int j = 0; j < 4; ++j) { cs[bj][j] += v0[j]; cs[bj][4 + j] += v1[j]; }
                    }
                    if (mode == 2) {
#pragma unroll
                        for (int j = 0; j < 4; ++j) { v0[j] = gelu_tanh(v0[j]); v1[j] = gelu_tanh(v1[j]); }
                    }
                    u32x4 w; w.x = cvt_pk_bf16(v0[0], v0[1]); w.y = cvt_pk_bf16(v0[2], v0[3]); w.z = cvt_pk_bf16(v1[0], v1[1]); w.w = cvt_pk_bf16(v1[2], v1[3]);
                    *(u32x4*)(rowp + bj * HALF) = w;
                }
            }
        if (ksum) {
#pragma unroll
            for (int bj = 0; bj < 2; ++bj)
#pragma unroll
                for (int j = 0; j < 8; ++j) { float v = cs[bj][j]; v += __shfl_xor(v, 1); v += __shfl_xor(v, 2); v += __shfl_xor(v, 4); v += __shfl_xor(v, 8); cs[bj][j] = v; }
            if (fr == 0) {
                const int bb = u.pm >> 3, blk = u.pm & 7;
#pragma unroll
                for (int bj = 0; bj < 2; ++bj) {
                    const int hh = (u.pn - 5) * 4 + bj * 2 + (wc >> 1), d0 = (wc & 1) * 32 + 8 * fq;
                    float* dst = kmp + (size_t)wr * (BATCH * 8 * 8 * 64) + ((size_t)((bb * 8 + hh) * 8 + blk)) * 64 + d0;
                    *(f32x4*)dst = (f32x4){cs[bj][0], cs[bj][1], cs[bj][2], cs[bj][3]}; *(f32x4*)(dst + 4) = (f32x4){cs[bj][4], cs[bj][5], cs[bj][6], cs[bj][7]};
                }
            }
        }
    }
};
struct EpiOutProj {
    static constexpr bool PERM = false;
    float* X; bf16_t* XB;
    __device__ __forceinline__ void operator()(const f32x4 (&acc)[2][2][4][2], const Unit& u, int wr, int wc, int fr, int fq) const {
        const int row0 = u.pm * BM + wr * 64 + fr, col0 = u.pn * BM + wc * 32 + 4 * fq;
#pragma unroll
        for (int ai = 0; ai < 2; ++ai)
#pragma unroll
            for (int m = 0; m < 4; ++m) {
                const size_t off = (size_t)(row0 + ai * HALF + m * 16) * D + col0;
#pragma unroll
                for (int bj = 0; bj < 2; ++bj)
#pragma unroll
                    for (int n = 0; n < 2; ++n) {
                        const size_t o = off + bj * HALF + n * 16;
                        const f32x4 x = *(const f32x4*)(X + o) + acc[ai][bj][m][n];
                        *(f32x4*)(X + o) = x;
                        u32x2 w; w.x = cvt_pk_bf16(x[0], x[1]); w.y = cvt_pk_bf16(x[2], x[3]);
                        *(u32x2*)(XB + o) = w;
                    }
            }
    }
};
struct EpiMoe1 {
    static constexpr bool PERM = true;
    bf16_t* AB; const float* rstd2; const int* elist;
    __device__ __forceinline__ void operator()(const f32x4 (&acc)[2][2][4][2], const Unit& u, int wr, int wc, int fr, int fq) const {
        const int col0 = u.pn * HALF + wc * 32 + 8 * fq;
#pragma unroll
        for (int ai = 0; ai < 2; ++ai)
#pragma unroll
            for (int m = 0; m < 4; ++m) {
                const int r = ai * HALF + wr * 64 + m * 16 + fr;
                int tok = 0; if (r < u.nvalid) tok = elist[(size_t)u.e * NSLOT + u.r0 + r] >> 1;
                const float rs = rstd2[tok];
                float a[8];
#pragma unroll
                for (int n = 0; n < 2; ++n)
#pragma unroll
                    for (int j = 0; j < 4; ++j) { const float g = acc[ai][0][m][n][j] * rs, uu = acc[ai][1][m][n][j] * rs; a[n * 4 + j] = g / (1.f + __expf(-g)) * uu; }
                u32x4 w; w.x = cvt_pk_bf16(a[0], a[1]); w.y = cvt_pk_bf16(a[2], a[3]); w.z = cvt_pk_bf16(a[4], a[5]); w.w = cvt_pk_bf16(a[6], a[7]);
                *(u32x4*)(AB + (size_t)(u.pm * BM + r) * DE + col0) = w;
            }
    }
};
struct EpiMoe2 {
    static constexpr bool PERM = true;
    bf16_t* YS; const float* slotw; const int* elist;
    __device__ __forceinline__ void operator()(const f32x4 (&acc)[2][2][4][2], const Unit& u, int wr, int wc, int fr, int fq) const {
        const int col0 = u.pn * BM + wc * 32 + 8 * fq;
#pragma unroll
        for (int ai = 0; ai < 2; ++ai)
#pragma unroll
            for (int m = 0; m < 4; ++m) {
                const int r = ai * HALF + wr * 64 + m * 16 + fr;
                if (r < u.nvalid) {
                    const int slot = elist[(size_t)u.e * NSLOT + u.r0 + r]; const float w8 = slotw[slot];
#pragma unroll
                    for (int bj = 0; bj < 2; ++bj) {
                        const f32x4 v0 = acc[ai][bj][m][0] * w8, v1 = acc[ai][bj][m][1] * w8;
                        u32x4 w; w.x = cvt_pk_bf16(v0[0], v0[1]); w.y = cvt_pk_bf16(v0[2], v0[3]); w.z = cvt_pk_bf16(v1[0], v1[1]); w.w = cvt_pk_bf16(v1[2], v1[3]);
                        *(u32x4*)(YS + (size_t)slot * D + col0 + bj * HALF) = w;
                    }
                }
            }
    }
};

template <class Epi, class Sched, bool ALIGN_EPI>
__device__ __forceinline__ void gemm_phase(LAS unsigned char* lds, const bf16_t* Abase, const int K, const Sched& S, const Epi& E, const int wave) {
    int wid_ = wave; asm volatile("" : "+s"(wid_));
    const int lane = lane_id_opaque(), wid = wid_, tid = wid * 64 + lane, wr = wid >> 2, wc = wid & 3, fr = lane & 15, fq = lane >> 4;
    const int nt = K / BK;
    int Rr[2], Cc[2]; unsigned voffB[2];
#pragma unroll
    for (int i = 0; i < 2; ++i) { int R, C; stage_rc(tid * 16 + i * 8192, R, C); Rr[i] = R; Cc[i] = C; const int Rb = Epi::PERM ? ((R & ~31) + perm32(R & 31)) : R; voffB[i] = (unsigned)(Rb * K + C) * 2u; }
    const size_t kstep = (size_t)(BK * 2);
    const size_t hstep = (size_t)HALF * K * 2;
    const unsigned ldsw = (unsigned)wid * 1024u;
    const int aoff = lds_byte(wr * 64 + fr, fq * 8), boff = lds_byte(wc * 32 + fr, fq * 8);
#define PG8_SA(b, h) (((b) * 2 + (h)) * HTB)
#define PG8_SB(b, h) ((4 + (b) * 2 + (h)) * HTB)
#define PG8_STAGE(bufoff, gbase, voff) do { _Pragma("unroll") for (int _i = 0; _i < 2; ++_i) \
        __builtin_amdgcn_global_load_lds((const unsigned*)((const char*)(gbase) + (voff)[_i]), (LAS unsigned*)(lds + (bufoff) + ldsw + _i * 8192), 16, 0, 0); } while (0)
#define PG8_LDA(dst, b, h) do { _Pragma("unroll") for (int m = 0; m < 4; ++m) _Pragma("unroll") for (int k = 0; k < 2; ++k) dst[m][k] = *(const LAS bf16x8*)(lds + PG8_SA(b, h) + aoff + m * 2048 + k * 1024); } while (0)
#define PG8_LDB(dst, b, h) do { _Pragma("unroll") for (int n = 0; n < 2; ++n) _Pragma("unroll") for (int k = 0; k < 2; ++k) dst[n][k] = *(const LAS bf16x8*)(lds + PG8_SB(b, h) + boff + n * 2048 + k * 1024); } while (0)
#define PG8_MMA(ai, bj, At, Bt) do { __builtin_amdgcn_s_setprio(1); _Pragma("unroll") for (int m = 0; m < 4; ++m) _Pragma("unroll") for (int n = 0; n < 2; ++n) _Pragma("unroll") for (int k = 0; k < 2; ++k) \
        acc[ai][bj][m][n] = __builtin_amdgcn_mfma_f32_16x16x32_bf16(Bt[n][k], At[m][k], acc[ai][bj][m][n], 0, 0, 0); __builtin_amdgcn_s_setprio(0); } while (0)
#define PG8_WAIT_V(n) asm volatile("s_waitcnt vmcnt(" #n ")" ::: "memory")
#define PG8_WAIT_L(n) asm volatile("s_waitcnt lgkmcnt(" #n ")" ::: "memory")
#define PG8_BAR __builtin_amdgcn_s_barrier()
#define PG8_SCHED __builtin_amdgcn_sched_barrier(0)
    Unit cur, nxt; int ui = 0;
    if (!S.next(0, cur)) return;
    f32x4 acc[2][2][4][2];
#pragma unroll
    for (int a = 0; a < 2; ++a)
#pragma unroll
        for (int b = 0; b < 2; ++b)
#pragma unroll
            for (int m = 0; m < 4; ++m)
#pragma unroll
                for (int n = 0; n < 2; ++n) acc[a][b][m][n] = (f32x4){0.f, 0.f, 0.f, 0.f};
    bf16x8 At[4][2], B0[2][2], B1[2][2];
    unsigned vAc[2][2], vAn[2][2];
    unsigned voffA[2];
    const char* const A0 = (const char*)Abase; const char* cA = A0; const char* cB = S.b_ptr(cur, K);
    if constexpr (Sched::GATHER) S.a_offs(cur, K, Rr, Cc, vAc);
    else { voffA[0] = (unsigned)(Rr[0] * K + Cc[0]) * 2u; voffA[1] = (unsigned)(Rr[1] * K + Cc[1]) * 2u; cA = A0 + (size_t)cur.pm * 2 * hstep; }
#define PG8_STAGE_A(bufoff, koff, NEXT, h) do { if constexpr (Sched::GATHER) { unsigned _v[2] = {(NEXT) ? vAn[h][0] : vAc[h][0], (NEXT) ? vAn[h][1] : vAc[h][1]}; PG8_STAGE(bufoff, A0 + (koff), _v); } \
        else { PG8_STAGE(bufoff, ((NEXT) ? nA : cA) + (koff) + (h) * hstep, voffA); } } while (0)
    const char* nA = cA;
    PG8_STAGE(PG8_SB(0, 0), cB, voffB); PG8_STAGE(PG8_SB(0, 1), cB + hstep, voffB); PG8_STAGE_A(PG8_SA(0, 0), 0, false, 0); PG8_STAGE_A(PG8_SA(0, 1), 0, false, 1);
    if (wr == 1) PG8_BAR;
    PG8_WAIT_V(2); PG8_BAR;
    PG8_STAGE(PG8_SB(1, 0), cB + kstep, voffB); PG8_STAGE_A(PG8_SA(1, 0), kstep, false, 0); PG8_STAGE(PG8_SB(1, 1), cB + hstep + kstep, voffB);
    PG8_WAIT_V(6); PG8_BAR;
    for (;;) {
        const bool has_next = S.next(ui + 1, nxt);
        const char* nB = cB; nA = cA;
        if (has_next) {
            nB = S.b_ptr(nxt, K);
            if constexpr (Sched::GATHER) S.a_offs(nxt, K, Rr, Cc, vAn); else nA = A0 + (size_t)nxt.pm * 2 * hstep;
        } else if constexpr (Sched::GATHER) {
#pragma unroll
            for (int h = 0; h < 2; ++h)
#pragma unroll
                for (int i = 0; i < 2; ++i) vAn[h][i] = vAc[h][i];
        }
        for (int t = 0; t < nt; t += 2) {
            const bool last = (t == nt - 2);
            const size_t k1 = (size_t)(t + 1) * kstep, k2 = last ? 0 : (size_t)(t + 2) * kstep, k3 = k2 + kstep;
            const char* b2 = last ? nB : cB + (size_t)(t + 2) * kstep; const char* b3 = b2 + kstep;
            PG8_LDB(B0, 0, 0); PG8_LDB(B1, 0, 1); PG8_SCHED; PG8_LDA(At, 0, 0); PG8_STAGE_A(PG8_SA(1, 1), k1, false, 1);
            PG8_WAIT_V(8); PG8_WAIT_L(0); PG8_BAR; PG8_MMA(0, 0, At, B0); PG8_MMA(0, 1, At, B1); PG8_BAR; PG8_SCHED;
            PG8_LDA(At, 0, 1); PG8_STAGE(PG8_SB(0, 0), b2, voffB); PG8_STAGE(PG8_SB(0, 1), b2 + hstep, voffB); PG8_STAGE_A(PG8_SA(0, 0), k2, last, 0);
            PG8_WAIT_V(8); PG8_WAIT_L(0); PG8_BAR; PG8_MMA(1, 0, At, B0); PG8_MMA(1, 1, At, B1); PG8_BAR; PG8_SCHED;
            PG8_LDB(B0, 1, 0); PG8_LDB(B1, 1, 1); PG8_SCHED; PG8_LDA(At, 1, 0); PG8_STAGE_A(PG8_SA(0, 1), k2, last, 1);
            PG8_WAIT_V(8); PG8_WAIT_L(0); PG8_BAR; PG8_MMA(0, 0, At, B0); PG8_MMA(0, 1, At, B1); PG8_BAR; PG8_SCHED;
            PG8_LDA(At, 1, 1); PG8_STAGE(PG8_SB(1, 0), b3, voffB); PG8_STAGE(PG8_SB(1, 1), b3 + hstep, voffB); PG8_STAGE_A(PG8_SA(1, 0), k3, last, 0);
            PG8_WAIT_V(8); PG8_WAIT_L(0); PG8_BAR; PG8_MMA(1, 0, At, B0); PG8_MMA(1, 1, At, B1); PG8_BAR; PG8_SCHED;
        }
        if constexpr (ALIGN_EPI) { if (wr == 0) PG8_BAR; }
        E(acc, cur, wr, wc, fr, fq);
        if (!has_next) break;
#pragma unroll
        for (int a = 0; a < 2; ++a)
#pragma unroll
            for (int b = 0; b < 2; ++b)
#pragma unroll
                for (int m = 0; m < 4; ++m)
#pragma unroll
                    for (int n = 0; n < 2; ++n) acc[a][b][m][n] = (f32x4){0.f, 0.f, 0.f, 0.f};
        cur = nxt; cB = nB; cA = nA; ++ui;
        if constexpr (Sched::GATHER) {
#pragma unroll
            for (int h = 0; h < 2; ++h)
#pragma unroll
                for (int i = 0; i < 2; ++i) vAc[h][i] = vAn[h][i];
        }
        if constexpr (ALIGN_EPI) { if (wr == 1) PG8_BAR; }
    }
    PG8_WAIT_V(0);
    if constexpr (!ALIGN_EPI) { if (wr == 0) PG8_BAR; }
    PG8_BAR;
#undef PG8_SA
#undef PG8_SB
#undef PG8_STAGE
#undef PG8_STAGE_A
#undef PG8_LDA
#undef PG8_LDB
#undef PG8_MMA
#undef PG8_WAIT_V
#undef PG8_WAIT_L
#undef PG8_BAR
#undef PG8_SCHED
}
}

#define XB_TMO      128
#define XB_XCNT(j)  (256  + 64 * (j))
#define XB_XSUB(j)  (1280 + 64 * (j))
#define XB_XGEN(j)  (2304 + 64 * (j))
#define XB_TOP      3328
#define XB_TOPGEN   3392
#define XCD_BAR_WORDS 3456
#define XB_SPIN_CAP (1u << 18)
__device__ __forceinline__ unsigned xb_ld(unsigned* p)              { return __hip_atomic_load(p, __ATOMIC_RELAXED, __HIP_MEMORY_SCOPE_AGENT); }
__device__ __forceinline__ unsigned xb_add(unsigned* p, unsigned v) { return __hip_atomic_fetch_add(p, v, __ATOMIC_RELAXED, __HIP_MEMORY_SCOPE_AGENT); }
__device__ __forceinline__ unsigned xb_xcc_id() { return (unsigned)__builtin_amdgcn_s_getreg((3 << 11) | 20) & 0xFu; }
#define XB_SPIN(cond, bar) do { unsigned _sp = 0; while (cond) { __builtin_amdgcn_s_sleep(1); \
    if ((++_sp & 255u) == 0u) { if (xb_ld(&(bar)[XB_TMO])) break; if (_sp > XB_SPIN_CAP) { atomicAdd(&(bar)[XB_TMO], 1u); break; } } } } while (0)
struct XcdBarrier { unsigned* bar; unsigned x; volatile LAS unsigned* st; };
__device__ __forceinline__ XcdBarrier xcd_barrier_post(unsigned* bar, volatile LAS unsigned* st) {
    XcdBarrier b; b.bar = bar; b.x = xb_xcc_id(); b.st = st;
    if (threadIdx.x == 0) (void)xb_add(&bar[XB_XCNT(b.x)], 1u);
    return b;
}
__device__ __forceinline__ void xcd_barrier_complete(unsigned* bar, unsigned x, unsigned& nloc, unsigned& nx) {
    const unsigned G = gridDim.x * gridDim.y * gridDim.z;
    unsigned sum, cnt, mine, sp = 0u;
    for (;;) {
        sum = 0u; cnt = 0u; mine = 0u;
#pragma unroll
        for (unsigned j = 0; j < 16; ++j) { const unsigned c = xb_ld(&bar[XB_XCNT(j)]); sum += c; cnt += (c > 0u) ? 1u : 0u; mine = (j == x) ? c : mine; }
        if (sum == G) break;
        __builtin_amdgcn_s_sleep(1);
        if ((++sp & 255u) == 0u) { if (xb_ld(&bar[XB_TMO])) break; if (sp > XB_SPIN_CAP) { atomicAdd(&bar[XB_TMO], 1u); break; } }
    }
    nloc = mine > 0u ? mine : 1u; nx = cnt > 0u ? cnt : 1u;
}
__device__ __forceinline__ void xcd_barrier(const XcdBarrier& b, const bool t0  ) {
    asm volatile("s_waitcnt vmcnt(0)" ::: "memory");
    __syncthreads();
    if (t0) {
        unsigned* bar = b.bar;
        __builtin_amdgcn_s_waitcnt(0);
        unsigned nloc = b.st[0], nx = b.st[1];
        if (nloc == 0u) { xcd_barrier_complete(bar, b.x, nloc, nx); b.st[0] = nloc; b.st[1] = nx; }
        const unsigned old = xb_add(&bar[XB_XSUB(b.x)], 1u);
        const unsigned gen = old / nloc;
        if (old + 1u == (gen + 1u) * nloc) {
            __builtin_amdgcn_fence(__ATOMIC_RELEASE, "agent");
            asm volatile("s_waitcnt vmcnt(0)" ::: "memory");
            const unsigned og = xb_add(&bar[XB_TOP], 1u);
            const unsigned tg = og / nx;
            if (og + 1u == (tg + 1u) * nx) xb_add(&bar[XB_TOPGEN], 1u);
            else XB_SPIN(xb_ld(&bar[XB_TOPGEN]) == tg, bar);
            __builtin_amdgcn_fence(__ATOMIC_ACQUIRE, "agent");
            xb_add(&bar[XB_XGEN(b.x)], 1u);
            asm volatile("s_waitcnt vmcnt(0)" ::: "memory");
        } else {
            XB_SPIN(xb_ld(&bar[XB_XGEN(b.x)]) == gen, bar);
            __builtin_amdgcn_fence(__ATOMIC_ACQUIRE, "agent");
            asm volatile("s_waitcnt vmcnt(0)" ::: "memory");
        }
    }
    __syncthreads();
}

__device__ __forceinline__ void tr_item(const float* W, int K, int N, bf16* WT, const float* scale, int mode, LAS float* scr, int item, int lane) {
    const int nblk = N / 32, kb = item / nblk, nb = item % nblk, k0 = 64 * kb, n0 = 32 * nb;
#pragma unroll 8
    for (int i = 0; i < 32; ++i) {
        const int kk = 2 * i + (lane >> 5);
        float v = W[(size_t)(k0 + kk) * N + n0 + (lane & 31)];
        if (scale) v *= scale[k0 + kk];
        scr[kk * 33 + (lane & 31)] = v;
    }
    LDS_WAIT();
    const int c = lane & 7;
#pragma unroll
    for (int j = 0; j < 4; ++j) {
        const int n = (lane >> 3) + 8 * j; const LAS float* s = scr + (8 * c) * 33 + n;
        uint4 o; o.x = pk2(s[0 * 33], s[1 * 33]); o.y = pk2(s[2 * 33], s[3 * 33]); o.z = pk2(s[4 * 33], s[5 * 33]); o.w = pk2(s[6 * 33], s[7 * 33]);
        const int ng = n0 + n;
        const int row = mode == 0 ? ng : ((ng >> 7) * 256 + (mode == 2 ? 128 : 0) + (ng & 127));
        *(uint4*)(WT + (size_t)row * K + k0 + 8 * c) = o;
    }
    LDS_WAIT();
}
constexpr int I_WIN = DEPTH * (D / 64) * (INC / 32);
constexpr int I_WOUT = DEPTH * (D / 64) * (D / 32);
constexpr int I_G = DEPTH * NE * (D / 64) * (DE / 32);
constexpr int I_D = DEPTH * NE * (DE / 64) * (D / 32);
constexpr int I_TOTAL = I_WIN + I_WOUT + 2 * I_G + I_D;

__device__ __forceinline__ void phase_prologue(const P& p, LAS unsigned char* lds, int gw, int NGW, int wave, int lane) {
    unsigned char* ws = p.ws;
    LAS float* scr = (LAS float*)(lds + wave * (64 * 33 * 4));
    for (int it = gw; it < I_TOTAL; it += NGW) {
        int r = it;
        if (r < I_WIN) { const int per = (D / 64) * (INC / 32), l = r / per; tr_item(p.w_in + (size_t)l * D * INC, D, INC, (bf16*)(ws + WS_WIN) + (size_t)l * INC * D, p.g_mix + l * D, 0, scr, r % per, lane); continue; }
        r -= I_WIN;
        if (r < I_WOUT) { const int per = (D / 64) * (D / 32), l = r / per; tr_item(p.w_out + (size_t)l * D * D, D, D, (bf16*)(ws + WS_WOUT) + (size_t)l * D * D, nullptr, 0, scr, r % per, lane); continue; }
        r -= I_WOUT;
        if (r < 2 * I_G) {
            const int up = r >= I_G; if (up) r -= I_G;
            const int per = (D / 64) * (DE / 32), le = r / per, l = le / NE;
            tr_item((up ? p.w_u : p.w_g) + (size_t)le * D * DE, D, DE, (bf16*)(ws + WS_WGU) + (size_t)le * 1024 * 1024, p.g_ffn + l * D, up ? 2 : 1, scr, r % per, lane); continue;
        }
        r -= 2 * I_G;
        { const int per = (DE / 64) * (D / 32), le = r / per; tr_item(p.w_d + (size_t)le * DE * D, DE, D, (bf16*)(ws + WS_WD) + (size_t)le * 1024 * 512, nullptr, 0, scr, r % per, lane); }
    }
    for (int idx = gw * 64 + lane; idx < DEPTH * 48 * D; idx += NGW * 64) {
        const int k = idx % D, j = (idx / D) % 48, l = idx / (48 * D);
        float v = 0.f;
        if (j < 4) v = p.w_rg[((size_t)l * D + k) * 4 + j] * p.g_ffn[l * D + k];
        else if (j < 36) v = p.w_re[((size_t)l * D + k) * NE + (j - 4)] * p.g_ffn[l * D + k];
        ((float*)(ws + WS_WR))[idx] = v;
    }
    for (int idx = gw * 64 + lane; idx < T * 8; idx += NGW * 64) {
        const int i = idx & 7, t = idx >> 3;
        const float inv = exp2f(-(float)i * (18.931568569324174f / 8.f));
        const float ang = (float)p.pos[t] * inv;
        float sn, cs; sincosf(ang, &sn, &cs);
        float* r = (float*)(ws + WS_ROPE) + (size_t)idx * 2;
        r[0] = cs; r[1] = sn;
    }
    float* X = (float*)(ws + WS_X); bf16* XB = (bf16*)(ws + WS_XB); float* RS = (float*)(ws + WS_RSTD);
    for (int m = gw; m < T; m += NGW) {
        const float4* xr = (const float4*)(p.x + (size_t)m * D) + lane; float4 v[4]; float s = 0.f;
#pragma unroll
        for (int j = 0; j < 4; ++j) { v[j] = xr[64 * j]; s += v[j].x * v[j].x + v[j].y * v[j].y + v[j].z * v[j].z + v[j].w * v[j].w; }
        s = wave_sum(s);
        if (lane == 0) RS[m] = rsqrtf(s * (1.f / D) + EPS);
#pragma unroll
        for (int j = 0; j < 4; ++j) {
            ((float4*)(X + (size_t)m * D) + lane)[64 * j] = v[j];
            ((uint2*)(XB + (size_t)m * D) + lane)[64 * j] = make_uint2(pk2(v[j].x, v[j].y), pk2(v[j].z, v[j].w));
        }
    }
}

typedef float f32x4 __attribute__((ext_vector_type(4)));
__device__ __forceinline__ void router_tile(const P& p, int l, int tile, LAS float* lg  , int lane) {
    const int r = lane & 15, q = lane >> 4, tok0 = tile * 16;
    const float* X = (const float*)(p.ws + WS_X) + (size_t)(tok0 + r) * D + q * 4;
    const float* W = (const float*)(p.ws + WS_WR) + (size_t)l * 48 * D + (size_t)r * D + q * 4;
    f32x4 acc[3] = {{0.f, 0.f, 0.f, 0.f}, {0.f, 0.f, 0.f, 0.f}, {0.f, 0.f, 0.f, 0.f}};
    float ss = 0.f;
#pragma unroll 4
    for (int kk = 0; kk < 64; ++kk) {
        const float4 xa = *(const float4*)(X + kk * 16);
        ss += xa.x * xa.x + xa.y * xa.y + xa.z * xa.z + xa.w * xa.w;
#pragma unroll
        for (int nt = 0; nt < 3; ++nt) {
            const float4 wb = *(const float4*)(W + (size_t)nt * 16 * D + kk * 16);
            acc[nt] = __builtin_amdgcn_mfma_f32_16x16x4f32(xa.x, wb.x, acc[nt], 0, 0, 0);
            acc[nt] = __builtin_amdgcn_mfma_f32_16x16x4f32(xa.y, wb.y, acc[nt], 0, 0, 0);
            acc[nt] = __builtin_amdgcn_mfma_f32_16x16x4f32(xa.z, wb.z, acc[nt], 0, 0, 0);
            acc[nt] = __builtin_amdgcn_mfma_f32_16x16x4f32(xa.w, wb.w, acc[nt], 0, 0, 0);
        }
    }
    ss += __shfl_xor(ss, 16); ss += __shfl_xor(ss, 32);
    const float rs_mine = rsqrtf(ss * (1.f / D) + EPS);
#pragma unroll
    for (int nt = 0; nt < 3; ++nt)
#pragma unroll
        for (int reg = 0; reg < 4; ++reg) lg[(q * 4 + reg) * 48 + nt * 16 + r] = acc[nt][reg];
    LDS_WAIT();
    if (lane < 16) {
        const int tok = tok0 + lane; const float rs = rs_mine;
        ((float*)(p.ws + WS_RSTD2))[tok] = rs;
        const LAS float* L = lg + lane * 48;
        float g0 = L[0] * rs, g1 = L[1] * rs, g2 = L[2] * rs, g3 = L[3] * rs;
        int gs = 0; float gm = g0;
        if (g1 > gm) { gm = g1; gs = 1; }
        if (g2 > gm) { gm = g2; gs = 2; }
        if (g3 > gm) { gm = g3; gs = 3; }
        const float pg = 1.f / (expf(g0 - gm) + expf(g1 - gm) + expf(g2 - gm) + expf(g3 - gm));
        float e[8];
#pragma unroll
        for (int j = 0; j < 8; ++j) e[j] = L[4 + gs * 8 + j] * rs;
        int i1 = 0; float m1 = e[0];
#pragma unroll
        for (int j = 1; j < 8; ++j) if (e[j] > m1) { m1 = e[j]; i1 = j; }
        int i2 = -1; float m2 = -3e38f;
#pragma unroll
        for (int j = 0; j < 8; ++j) if (j != i1 && e[j] > m2) { m2 = e[j]; i2 = j; }
        const float p2 = expf(m2 - m1), inv = 1.f / (1.f + p2);
        const float w1 = pg * inv, w2 = pg * p2 * inv;
        const int e1 = gs * 8 + i1, e2 = gs * 8 + i2;
        u32* ecnt = (u32*)(p.ws + WS_CTL) + CW_ECNT + l * 32;
        int* elist = (int*)(p.ws + WS_ELIST);
        float* sw = (float*)(p.ws + WS_SLOTW);
        const u32 p1 = atomicAdd(ecnt + e1, 1u); elist[(size_t)e1 * NSLOT + p1] = tok * 2;
        const u32 p2i = atomicAdd(ecnt + e2, 1u); elist[(size_t)e2 * NSLOT + p2i] = tok * 2 + 1;
        sw[tok * 2] = w1; sw[tok * 2 + 1] = w2;
    }
    LDS_WAIT();
}
__device__ __forceinline__ void phase_combine(const P& p, int l, int gw, int NGW, int lane) {
    float* X = (float*)(p.ws + WS_X); bf16* XB = (bf16*)(p.ws + WS_XB); float* RS = (float*)(p.ws + WS_RSTD);
    const bf16* YS = (const bf16*)(p.ws + WS_YS);
    for (int m = gw; m < T; m += NGW) {
        float4 v[4]; float s = 0.f;
#pragma unroll
        for (int j = 0; j < 4; ++j) {
            v[j] = ((const float4*)(X + (size_t)m * D) + lane)[64 * j];
            const uint2 a = ((const uint2*)(YS + (size_t)(2 * m) * D) + lane)[64 * j], b = ((const uint2*)(YS + (size_t)(2 * m + 1) * D) + lane)[64 * j];
            v[j].x += blo(a.x) + blo(b.x); v[j].y += bhi(a.x) + bhi(b.x); v[j].z += blo(a.y) + blo(b.y); v[j].w += bhi(a.y) + bhi(b.y);
            s += v[j].x * v[j].x + v[j].y * v[j].y + v[j].z * v[j].z + v[j].w * v[j].w;
        }
        s = wave_sum(s);
        const float rs = rsqrtf(s * (1.f / D) + EPS);
        if (l == DEPTH - 1) {
#pragma unroll
            for (int j = 0; j < 4; ++j) {
                const float4 g = ((const float4*)p.g_fin + lane)[64 * j];
                ((float4*)(p.out + (size_t)m * D) + lane)[64 * j] = make_float4(v[j].x * rs * g.x, v[j].y * rs * g.y, v[j].z * rs * g.z, v[j].w * rs * g.w);
            }
        } else {
            if (lane == 0) RS[m] = rs;
#pragma unroll
            for (int j = 0; j < 4; ++j) {
                ((float4*)(X + (size_t)m * D) + lane)[64 * j] = v[j];
                ((uint2*)(XB + (size_t)m * D) + lane)[64 * j] = make_uint2(pk2(v[j].x, v[j].y), pk2(v[j].z, v[j].w));
            }
        }
    }
}

namespace mix {
typedef short bf16x8 __attribute__((ext_vector_type(8)));
typedef short s16x4 __attribute__((ext_vector_type(4)));
typedef float f32x16 __attribute__((ext_vector_type(16)));
typedef float f32x4 __attribute__((ext_vector_type(4)));
typedef unsigned u32x4 __attribute__((ext_vector_type(4)));
constexpr int L_K = 0, L_V = 16384, SLOTB = 8192;
constexpr int L_WSF = 32768;
constexpr int L_FLAG = 36864;
constexpr int L_KM = 37888;
constexpr int L_OST = 40960, OST_W = 32 * 68 * 4;
constexpr int L_VNT = 40960, VNT_LD = 136;
static_assert(L_OST + 8 * OST_W <= RING_BYTES, "mixer LDS map");
constexpr float NEG_INF = -__builtin_inff();

__device__ __forceinline__ int crow(int r, int hi) { return (r & 3) + 8 * (r >> 2) + 4 * hi; }
__device__ __forceinline__ unsigned cvtpk(float lo, float hi) { unsigned r; asm volatile("v_cvt_pk_bf16_f32 %0, %1, %2" : "=v"(r) : "v"(lo), "v"(hi)); return r; }
__device__ __forceinline__ s16x4 vtr(const LAS unsigned char* p) { typedef short v4i16_t __attribute__((ext_vector_type(4))); return __builtin_bit_cast(s16x4, __builtin_amdgcn_ds_read_tr16_b64_v4i16((LAS v4i16_t*)p)); }

__device__ __forceinline__ void dma_tile(LAS unsigned char* lds, const bf16* Kh, const bf16* Vh, int key0, int slot, int wave, int lane) {
    const bf16* ks = Kh + (size_t)(key0 + lane) * INC + wave * 8;
    const bf16* vs = Vh + (size_t)(key0 + 16 * (wave & 3) + (lane >> 2)) * INC + (wave >> 2) * 32 + (lane & 3) * 8;
    __builtin_amdgcn_global_load_lds((const unsigned*)ks, (LAS unsigned*)(lds + L_K + slot * SLOTB + wave * 1024), 16, 0, 0);
    __builtin_amdgcn_global_load_lds((const unsigned*)vs, (LAS unsigned*)(lds + L_V + slot * SLOTB + wave * 1024), 16, 0, 0);
}
__device__ __forceinline__ void qkt(f32x16& p0, f32x16& p1, const LAS unsigned char* kslot, const bf16x8 (&qr)[4], int r32, int hi) {
    const LAS unsigned char* kb = kslot + hi * 1024 + r32 * 16;
    p0 = (f32x16){0.f, 0.f, 0.f, 0.f, 0.f, 0.f, 0.f, 0.f, 0.f, 0.f, 0.f, 0.f, 0.f, 0.f, 0.f, 0.f}; p1 = p0;
#pragma unroll
    for (int d0 = 0; d0 < 4; ++d0) {
        const bf16x8 b0 = *(const LAS bf16x8*)(kb + d0 * 2048), b1 = *(const LAS bf16x8*)(kb + d0 * 2048 + 512);
        p0 = __builtin_amdgcn_mfma_f32_32x32x16_bf16(b0, qr[d0], p0, 0, 0, 0);
        p1 = __builtin_amdgcn_mfma_f32_32x32x16_bf16(b1, qr[d0], p1, 0, 0, 0);
    }
}
__device__ __forceinline__ void pv(f32x16 (&o)[2], const LAS unsigned char* vslot, const u32x4 (&pa)[4], int lane) {
    const int hi = lane >> 5;
    const LAS unsigned char* vp = vslot + ((lane >> 4) & 1) * 32 + (lane & 3) * 8 + (4 * hi + ((lane & 15) >> 2)) * 64;
#pragma unroll
    for (int d0 = 0; d0 < 2; ++d0)
#pragma unroll
        for (int ks = 0; ks < 4; ++ks) {
            const s16x4 lo = vtr(vp + d0 * 4096 + ks * 1024), hh = vtr(vp + d0 * 4096 + ks * 1024 + 512);
            const bf16x8 vb = (bf16x8){lo[0], lo[1], lo[2], lo[3], hh[0], hh[1], hh[2], hh[3]};
            o[d0] = __builtin_amdgcn_mfma_f32_32x32x16_bf16(__builtin_bit_cast(bf16x8, pa[ks]), vb, o[d0], 0, 0, 0);
        }
}
__device__ __forceinline__ void pack_p(u32x4 (&pa)[4], const f32x16& p0, const f32x16& p1) {
#pragma unroll
    for (int s = 0; s < 2; ++s) {
        pa[s] = (u32x4){cvtpk(p0[8 * s + 0], p0[8 * s + 1]), cvtpk(p0[8 * s + 2], p0[8 * s + 3]), cvtpk(p0[8 * s + 4], p0[8 * s + 5]), cvtpk(p0[8 * s + 6], p0[8 * s + 7])};
        pa[2 + s] = (u32x4){cvtpk(p1[8 * s + 0], p1[8 * s + 1]), cvtpk(p1[8 * s + 2], p1[8 * s + 3]), cvtpk(p1[8 * s + 4], p1[8 * s + 5]), cvtpk(p1[8 * s + 6], p1[8 * s + 7])};
    }
}
__device__ __forceinline__ void store_headnorm(LAS unsigned char* lds, const f32x16 (&o)[2], const LAS float* qs  , const float* gh  , bf16* onrow0  , int wave, int lane) {
    const int r32 = lane & 31, hi = lane >> 5;
    LAS float* st = (LAS float*)(lds + L_OST + wave * OST_W);
#pragma unroll
    for (int r = 0; r < 16; ++r) {
        const int q = crow(r, hi); const float s = qs ? qs[q] : 1.f;
        st[q * 68 + r32] = o[0][r] * s; st[q * 68 + 32 + r32] = o[1][r] * s;
    }
    LDS_WAIT();
    const int q = lane >> 1, part = lane & 1;
    f32x4 x[8]; float ss = 0.f;
#pragma unroll
    for (int i = 0; i < 8; ++i) { x[i] = *(const LAS f32x4*)(st + q * 68 + part * 32 + i * 4); ss += x[i][0] * x[i][0] + x[i][1] * x[i][1] + x[i][2] * x[i][2] + x[i][3] * x[i][3]; }
    ss += __shfl_xor(ss, 1);
    const float rs = rsqrtf(ss * (1.f / 64.f) + EPS);
    bf16* dst = onrow0 + (size_t)q * D + part * 32;
#pragma unroll
    for (int i = 0; i < 4; ++i) {
        const f32x4 g0 = *(const f32x4*)(gh + part * 32 + i * 8), g1 = *(const f32x4*)(gh + part * 32 + i * 8 + 4);
        const f32x4 a = x[2 * i] * rs * g0, b = x[2 * i + 1] * rs * g1;
        *(u32x4*)(dst + i * 8) = (u32x4){cvtpk(a[0], a[1]), cvtpk(a[2], a[3]), cvtpk(b[0], b[1]), cvtpk(b[2], b[3])};
    }
    LDS_WAIT();
}

__device__ __forceinline__ void moba_unit(LAS unsigned char* lds, const bf16* PR, bf16* ON, const float* KMP, const float* gh, int b, int h, int qb, int wave, int lane) {
    const int r32 = lane & 31, hi = lane >> 5, tid = wave * 64 + lane;
    const size_t rowbase = (size_t)b * SEQ;
    const bf16* Qw = PR + (rowbase + qb * 256 + wave * 32) * INC + C_QB + h * 64;
    const bf16* Kh = PR + rowbase * INC + C_KB + h * 64; const bf16* Vh = PR + rowbase * INC + C_VB + h * 64;
    LAS float* km = (LAS float*)(lds + L_KM);
    LAS float* wsf = (LAS float*)(lds + L_WSF) + wave * 128;
    __syncthreads();
    dma_tile(lds, Kh, Vh, 0, 0, wave, lane);
    { const size_t o = ((size_t)(b * 8 + h) * 8) * 64 + tid; km[tid] = KMP[o] + KMP[(size_t)BATCH * 8 * 8 * 64 + o]; }
    bf16x8 qr[4];
#pragma unroll
    for (int ks = 0; ks < 4; ++ks) qr[ks] = *(const bf16x8*)(Qw + (size_t)r32 * INC + ks * 16 + hi * 8);
    __syncthreads();
    unsigned selmask = 0;
    {
        float g[8];
#pragma unroll
        for (int j = 0; j < 8; ++j) {
            float s = 0.f;
#pragma unroll
            for (int ks = 0; ks < 4; ++ks)
#pragma unroll
                for (int e = 0; e < 8; ++e) s += bf2f((bf16)qr[ks][e]) * km[j * 64 + ks * 16 + hi * 8 + e];
            s += __shfl_xor(s, 32);
            g[j] = j < qb ? s : -1e30f;
        }
        const int nsel = qb < 3 ? qb : 3;
        for (int r = 0; r < nsel; ++r) {
            float best = -3e38f; int bi = 0;
#pragma unroll
            for (int j = 0; j < 8; ++j) { const bool ok = !((selmask >> j) & 1u) && g[j] > best; if (ok) { best = g[j]; bi = j; } }
            selmask |= 1u << bi;
        }
    }
    unsigned wneed = 0;
#pragma unroll
    for (int j = 0; j < 8; ++j) if (__any((selmask >> j) & 1u)) wneed |= 1u << j;
    wneed = __builtin_amdgcn_readfirstlane(wneed);
    float m = -1e30f, l = 0.f; f32x16 o[2];
    o[0] = (f32x16){0.f, 0.f, 0.f, 0.f, 0.f, 0.f, 0.f, 0.f, 0.f, 0.f, 0.f, 0.f, 0.f, 0.f, 0.f, 0.f}; o[1] = o[0];
    const int NT = 4 * (qb + 1);
    const float SC = 0.125f * 1.4426950408889634f;
    for (int tt = 0; tt < NT; ++tt) {
        asm volatile("s_waitcnt vmcnt(0)" ::: "memory");
        __syncthreads();
        if (tt + 1 < NT) dma_tile(lds, Kh, Vh, 64 * (tt + 1), (tt + 1) & 1, wave, lane);
        const int blk = tt >> 2; const bool own = blk == qb;
        const bool act = own ? ((tt & 3) <= (wave >> 1)) : ((wneed >> blk) & 1u);
        if (act) {
            f32x16 p0, p1;
            qkt(p0, p1, lds + L_K + (tt & 1) * SLOTB, qr, r32, hi);
            const bool selme = (selmask >> blk) & 1u;
            const int qrel = 32 * wave + r32 - 64 * (tt & 3);
            float rm = NEG_INF;
#pragma unroll
            for (int r = 0; r < 16; ++r) {
                const int kk = crow(r, hi);
                const bool v0 = own ? (kk <= qrel) : selme, v1 = own ? (kk + 32 <= qrel) : selme;
                p0[r] = v0 ? p0[r] * SC : NEG_INF; p1[r] = v1 ? p1[r] * SC : NEG_INF;
                rm = fmaxf(rm, fmaxf(p0[r], p1[r]));
            }
            rm = fmaxf(rm, __shfl_xor(rm, 32));
            const float mn = fmaxf(m, rm), alpha = __builtin_amdgcn_exp2f(m - mn);
            m = mn;
            float rs = 0.f;
#pragma unroll
            for (int r = 0; r < 16; ++r) { p0[r] = __builtin_amdgcn_exp2f(p0[r] - mn); p1[r] = __builtin_amdgcn_exp2f(p1[r] - mn); rs += p0[r] + p1[r]; }
            rs += __shfl_xor(rs, 32);
            l = l * alpha + rs;
            if (__any(alpha != 1.f)) {
                if (hi == 0) wsf[r32] = alpha;
                LDS_WAIT();
#pragma unroll
                for (int r = 0; r < 16; ++r) { const float a = wsf[crow(r, hi)]; o[0][r] *= a; o[1][r] *= a; }
            }
            u32x4 pa[4]; pack_p(pa, p0, p1);
            pv(o, lds + L_V + (tt & 1) * SLOTB, pa, lane);
        }
    }
    if (hi == 0) wsf[32 + r32] = 1.f / l;
    LDS_WAIT();
    store_headnorm(lds, o, wsf + 32, gh, ON + (rowbase + qb * 256 + wave * 32) * D + 256 + h * 64, wave, lane);
}

__device__ __forceinline__ void sb_unit(LAS unsigned char* lds, const bf16* PR, bf16* ON, const float* gh, int b, int h, int qb, int wave, int lane) {
    const int r32 = lane & 31, hi = lane >> 5;
    const size_t rowbase = (size_t)b * SEQ;
    const bf16* Qw = PR + (rowbase + qb * 256 + wave * 32) * INC + C_QA + h * 64;
    const bf16* Kh = PR + rowbase * INC + C_KA + h * 64; const bf16* Vh = PR + rowbase * INC + C_VA + h * 64;
    volatile LAS int* flag = (volatile LAS int*)(lds + L_FLAG);
    __syncthreads();
    const int jt0 = 4 * qb + 3, jtd = 4 * qb + (wave >> 1);
    dma_tile(lds, Kh, Vh, 64 * jt0, 0, wave, lane);
    bf16x8 qr[4];
#pragma unroll
    for (int ks = 0; ks < 4; ++ks) qr[ks] = *(const bf16x8*)(Qw + (size_t)r32 * INC + ks * 16 + hi * 8);
    float L = 0.f; f32x16 o[2];
    o[0] = (f32x16){0.f, 0.f, 0.f, 0.f, 0.f, 0.f, 0.f, 0.f, 0.f, 0.f, 0.f, 0.f, 0.f, 0.f, 0.f, 0.f}; o[1] = o[0];
    bool active = true;
    for (int step = 0;; ++step) {
        const int jt = jt0 - step;
        asm volatile("s_waitcnt vmcnt(0)" ::: "memory");
        __syncthreads();
        if (step > 0) { int any = 0;
#pragma unroll
            for (int w = 0; w < 8; ++w) any |= flag[((step - 1) & 1) * 8 + w];
            if (!any) break; }
        if (jt < 0) break;
        if (jt > 0) dma_tile(lds, Kh, Vh, 64 * (jt - 1), (step + 1) & 1, wave, lane);
        if (active && jt <= jtd) {
            f32x16 p0, p1;
            qkt(p0, p1, lds + L_K + (step & 1) * SLOTB, qr, r32, hi);
            const int trel = 256 * qb + 32 * wave + r32 - 64 * jt;
            float gs[8];
#pragma unroll
            for (int k = 0; k < 8; ++k) gs[k] = 0.f;
            f32x16 q0, q1;
#pragma unroll
            for (int r = 0; r < 16; ++r) {
                const int kk = crow(r, hi);
                { const float z = p0[r] * 0.125f, l1p = __logf(1.f + __expf(-fabsf(z))); const bool v = kk < trel;
                  q0[r] = v ? fminf(-z, 0.f) - l1p : 0.f; p0[r] = v ? fminf(z, 0.f) - l1p : NEG_INF; gs[r >> 2] += q0[r]; }
                { const float z = p1[r] * 0.125f, l1p = __logf(1.f + __expf(-fabsf(z))); const bool v = kk + 32 < trel;
                  q1[r] = v ? fminf(-z, 0.f) - l1p : 0.f; p1[r] = v ? fminf(z, 0.f) - l1p : NEG_INF; gs[4 + (r >> 2)] += q1[r]; }
            }
            float aft[8]; float run = 0.f;
#pragma unroll
            for (int k = 7; k >= 0; --k) { const float og = __shfl_xor(gs[k], 32); aft[k] = run + (hi == 0 ? og : 0.f); run += gs[k] + og; }
#pragma unroll
            for (int k = 0; k < 4; ++k) {
                float a = L + aft[k];
                p0[4 * k + 3] = __expf(p0[4 * k + 3] + a); a += q0[4 * k + 3];
                p0[4 * k + 2] = __expf(p0[4 * k + 2] + a); a += q0[4 * k + 2];
                p0[4 * k + 1] = __expf(p0[4 * k + 1] + a); a += q0[4 * k + 1];
                p0[4 * k + 0] = __expf(p0[4 * k + 0] + a);
                float c = L + aft[4 + k];
                p1[4 * k + 3] = __expf(p1[4 * k + 3] + c); c += q1[4 * k + 3];
                p1[4 * k + 2] = __expf(p1[4 * k + 2] + c); c += q1[4 * k + 2];
                p1[4 * k + 1] = __expf(p1[4 * k + 1] + c); c += q1[4 * k + 1];
                p1[4 * k + 0] = __expf(p1[4 * k + 0] + c);
            }
            L += run;
            u32x4 pa[4]; pack_p(pa, p0, p1);
            pv(o, lds + L_V + (step & 1) * SLOTB, pa, lane);
            if (__all(L < -88.f)) active = false;
        }
        if (lane == 0) flag[(step & 1) * 8 + wave] = (active && jt > 0) ? 1 : 0;
    }
    store_headnorm(lds, o, nullptr, gh, ON + (rowbase + qb * 256 + wave * 32) * D + h * 64, wave, lane);
}

__device__ __forceinline__ void gmlp_unit(LAS unsigned char* lds, const bf16* PR, bf16* ON, const float* gvn  , const float* wsp  , const float* bsp  , const float* gh  , int b, int c, int g, int wave, int lane) {
    const int tid = wave * 64 + lane;
    const size_t row0 = (size_t)b * SEQ + c * 128;
    LAS bf16* vnT = (LAS bf16*)(lds + L_VNT);
    __syncthreads();
    {
        const int s = tid >> 2, part = tid & 3;
        const bf16* vr = PR + (row0 + s) * INC + C_VC + g * 64 + part * 16;
        const uint4 a = *(const uint4*)vr, bq = *(const uint4*)(vr + 8);
        float x[16] = {blo(a.x), bhi(a.x), blo(a.y), bhi(a.y), blo(a.z), bhi(a.z), blo(a.w), bhi(a.w), blo(bq.x), bhi(bq.x), blo(bq.y), bhi(bq.y), blo(bq.z), bhi(bq.z), blo(bq.w), bhi(bq.w)};
        float ss = 0.f;
#pragma unroll
        for (int i = 0; i < 16; ++i) ss += x[i] * x[i];
        ss += __shfl_xor(ss, 1); ss += __shfl_xor(ss, 2);
        const float rs = rsqrtf(ss * (1.f / 64.f) + EPS);
#pragma unroll
        for (int i = 0; i < 16; ++i) vnT[(part * 16 + i) * VNT_LD + s] = f2bf(x[i] * rs * gvn[part * 16 + i]);
    }
    __syncthreads();
    const int fr = lane & 15, fq = lane >> 4, t = 16 * wave + fr;
    f32x4 acc[4] = {{0.f, 0.f, 0.f, 0.f}, {0.f, 0.f, 0.f, 0.f}, {0.f, 0.f, 0.f, 0.f}, {0.f, 0.f, 0.f, 0.f}};
    const int nks = (wave >> 1) + 1;
    for (int ks = 0; ks < nks; ++ks) {
        const int s0 = 32 * ks + 8 * fq;
        const f32x4 w0 = *(const f32x4*)(wsp + (size_t)t * 128 + s0), w1 = *(const f32x4*)(wsp + (size_t)t * 128 + s0 + 4);
        float wv[8] = {w0[0], w0[1], w0[2], w0[3], w1[0], w1[1], w1[2], w1[3]};
#pragma unroll
        for (int j = 0; j < 8; ++j) if (s0 + j > t) wv[j] = 0.f;
        const u32x4 au = (u32x4){cvtpk(wv[0], wv[1]), cvtpk(wv[2], wv[3]), cvtpk(wv[4], wv[5]), cvtpk(wv[6], wv[7])};
#pragma unroll
        for (int n = 0; n < 4; ++n) {
            const bf16x8 bv = *(const LAS bf16x8*)(vnT + (16 * n + fr) * VNT_LD + s0);
            acc[n] = __builtin_amdgcn_mfma_f32_16x16x32_bf16(__builtin_bit_cast(bf16x8, au), bv, acc[n], 0, 0, 0);
        }
    }
    __syncthreads();
    LAS float* st = (LAS float*)(lds + L_OST + wave * OST_W);
#pragma unroll
    for (int reg = 0; reg < 4; ++reg) {
        const int tl = 4 * fq + reg, tt = 16 * wave + tl; const float bb = bsp[tt];
#pragma unroll
        for (int n = 0; n < 4; ++n) st[tl * 68 + 16 * n + fr] = acc[n][reg] + bb;
    }
    LDS_WAIT();
    {
        const int tl = lane >> 2, part = lane & 3, tt = 16 * wave + tl;
        const bf16* ur = PR + (row0 + tt) * INC + C_UC + g * 64 + part * 16;
        const uint4 ua = *(const uint4*)ur, ub = *(const uint4*)(ur + 8);
        const float u[16] = {blo(ua.x), bhi(ua.x), blo(ua.y), bhi(ua.y), blo(ua.z), bhi(ua.z), blo(ua.w), bhi(ua.w), blo(ub.x), bhi(ub.x), blo(ub.y), bhi(ub.y), blo(ub.z), bhi(ub.z), blo(ub.w), bhi(ub.w)};
        float v[16]; float ss = 0.f;
#pragma unroll
        for (int i = 0; i < 4; ++i) { const f32x4 m4 = *(const LAS f32x4*)(st + tl * 68 + part * 16 + i * 4);
#pragma unroll
            for (int j = 0; j < 4; ++j) { v[4 * i + j] = u[4 * i + j] * m4[j]; ss += v[4 * i + j] * v[4 * i + j]; } }
        ss += __shfl_xor(ss, 1); ss += __shfl_xor(ss, 2);
        const float rs = rsqrtf(ss * (1.f / 64.f) + EPS);
        bf16* dst = ON + (row0 + tt) * D + 768 + g * 64 + part * 16;
#pragma unroll
        for (int i = 0; i < 2; ++i) {
            const f32x4 g0 = *(const f32x4*)(gh + part * 16 + i * 8), g1 = *(const f32x4*)(gh + part * 16 + i * 8 + 4);
            *(u32x4*)(dst + i * 8) = (u32x4){cvtpk(v[8 * i + 0] * rs * g0[0], v[8 * i + 1] * rs * g0[1]), cvtpk(v[8 * i + 2] * rs * g0[2], v[8 * i + 3] * rs * g0[3]),
                                             cvtpk(v[8 * i + 4] * rs * g1[0], v[8 * i + 5] * rs * g1[1]), cvtpk(v[8 * i + 6] * rs * g1[2], v[8 * i + 7] * rs * g1[3])};
        }
    }
    LDS_WAIT();
}
}
__device__ __forceinline__ const void* lptr(LAS unsigned char* lds, int k) {
    const unsigned long long v = ((const LAS unsigned long long*)(lds + LDS_PTRS))[k];
    const unsigned lo = __builtin_amdgcn_readfirstlane((unsigned)v), hi = __builtin_amdgcn_readfirstlane((unsigned)(v >> 32));
    return (const void*)(((unsigned long long)hi << 32) | lo);
}
__device__ __forceinline__ P load_params(LAS unsigned char* lds, unsigned char* ws) {
    P q;
    q.x = (const float*)lptr(lds, 0); q.pos = (const int*)lptr(lds, 1); q.w_in = (const float*)lptr(lds, 2); q.w_out = (const float*)lptr(lds, 3);
    q.g_mix = (const float*)lptr(lds, 4); q.g_head = (const float*)lptr(lds, 5); q.g_vn = (const float*)lptr(lds, 6); q.w_sp = (const float*)lptr(lds, 7);
    q.b_sp = (const float*)lptr(lds, 8); q.g_ffn = (const float*)lptr(lds, 9); q.w_rg = (const float*)lptr(lds, 10); q.w_re = (const float*)lptr(lds, 11);
    q.w_g = (const float*)lptr(lds, 12); q.w_u = (const float*)lptr(lds, 13); q.w_d = (const float*)lptr(lds, 14); q.g_fin = (const float*)lptr(lds, 15);
    q.out = (float*)lptr(lds, 16); q.ws = ws;
    return q;
}
constexpr int NSTEPS = 1 + 7 * DEPTH;
__global__ void __launch_bounds__(NWAVES * 64, 2) mk(P p, int s_lo, int s_hi, int bar_region, int mix_mask) {
    extern __shared__ __attribute__((aligned(16))) unsigned char lds_raw[];
    LAS unsigned char* lds = (LAS unsigned char*)lds_raw;
    const int wave = __builtin_amdgcn_readfirstlane(threadIdx.x >> 6);
    const int G = gridDim.x, bx = blockIdx.x;
    const int vcu = (G % 8 == 0) ? (bx % 8) * (G / 8) + bx / 8 : bx;
    const int gw = vcu * NWAVES + wave, NGW = G * NWAVES;
    unsigned char* ws = p.ws;
    volatile LAS unsigned* misc = (volatile LAS unsigned*)(lds + LDS_MISC);
    if (threadIdx.x < 4) misc[threadIdx.x] = 0u;
    if (threadIdx.x == 0) {
        LAS unsigned long long* pp = (LAS unsigned long long*)(lds + LDS_PTRS);
        pp[0] = (unsigned long long)p.x; pp[1] = (unsigned long long)p.pos; pp[2] = (unsigned long long)p.w_in; pp[3] = (unsigned long long)p.w_out;
        pp[4] = (unsigned long long)p.g_mix; pp[5] = (unsigned long long)p.g_head; pp[6] = (unsigned long long)p.g_vn; pp[7] = (unsigned long long)p.w_sp;
        pp[8] = (unsigned long long)p.b_sp; pp[9] = (unsigned long long)p.g_ffn; pp[10] = (unsigned long long)p.w_rg; pp[11] = (unsigned long long)p.w_re;
        pp[12] = (unsigned long long)p.w_g; pp[13] = (unsigned long long)p.w_u; pp[14] = (unsigned long long)p.w_d; pp[15] = (unsigned long long)p.g_fin;
        pp[16] = (unsigned long long)p.out;
    }
    __syncthreads();
    XcdBarrier bar = xcd_barrier_post((unsigned*)(ws + WS_CTL) + CW_BAR + bar_region * XCD_BAR_WORDS, misc);
#define IN(k) (s_lo <= (k) && (k) < s_hi)
#define SEAM(k) do { if (IN(k) && IN((k) + 1)) xcd_barrier(bar, wave == 0 && lane_id_opaque() == 0); } while (0)

#define OPQ_WS(name) unsigned char* name = ws; asm volatile("" : "+s"(name))
#define OPQ_LDS(name) LAS unsigned char* name = lds; asm volatile("" : "+s"(name))
#define OPQ_LANE(name) const int name = lane_id_opaque()
    if (IN(0)) { OPQ_WS(w); OPQ_LDS(ld); OPQ_LANE(ln); const P q = load_params(ld, w); phase_prologue(q, ld, gw, NGW, wave, ln); __syncthreads(); }
    SEAM(0);
#pragma unroll 1
    for (int l = 0; l < DEPTH; ++l) {
        const int s0 = 1 + 7 * l;
        if (IN(s0 + 0)) {
            OPQ_WS(w); OPQ_LDS(ld);
            pg8::StaticOrder S; S.init(T, INC, G, bx, (const bf16*)(w + WS_WIN) + (size_t)l * INC * D);
            pg8::EpiInProj E{(bf16*)(w + WS_PROJ), (const float*)(w + WS_RSTD), (const float*)(w + WS_ROPE), (float*)(w + WS_KMEAN)};
            pg8::gemm_phase<pg8::EpiInProj, pg8::StaticOrder, true>(ld, (const bf16*)(w + WS_XB), D, S, E, wave);
        }
        SEAM(s0 + 0);
        if (IN(s0 + 1)) {
            OPQ_WS(w); OPQ_LDS(ld); OPQ_LANE(ln);
            int wv = wave; asm volatile("" : "+s"(wv));
            const bf16* PR = (const bf16*)(w + WS_PROJ); bf16* ON = (bf16*)(w + WS_ON);
            const float* ghead = (const float*)lptr(ld, 5) + (size_t)l * 16 * 64;
            if (mix_mask & 1) {
                for (int u = vcu; u < 256; u += G) {
                    const int bh = u >> 2, i = u & 3;
                    mix::moba_unit(ld, PR, ON, (const float*)(w + WS_KMEAN), ghead + (4 + (bh & 7)) * 64, bh >> 3, bh & 7, 7 - i, wv, ln);
                    mix::moba_unit(ld, PR, ON, (const float*)(w + WS_KMEAN), ghead + (4 + (bh & 7)) * 64, bh >> 3, bh & 7, i, wv, ln);
                }
            }
            if (mix_mask & 2) {
                for (int u = vcu; u < 256; u += G) mix::sb_unit(ld, PR, ON, ghead + ((u >> 3) & 3) * 64, u >> 5, (u >> 3) & 3, u & 7, wv, ln);
            }
            if (mix_mask & 4) {
                const float* gvn = (const float*)lptr(ld, 6) + (size_t)l * 4 * 64;
                const float* wsp = (const float*)lptr(ld, 7) + (size_t)l * 4 * 128 * 128;
                const float* bsp = (const float*)lptr(ld, 8) + (size_t)l * 4 * 128;
                for (int u = vcu; u < 512; u += G) {
                    const int g = u & 3, c = (u >> 2) & 15, b = u >> 6;
                    mix::gmlp_unit(ld, PR, ON, gvn + g * 64, wsp + (size_t)g * 128 * 128, bsp + g * 128, ghead + (12 + g) * 64, b, c, g, wv, ln);
                }
            }
            __syncthreads();
        }
        SEAM(s0 + 1);
        if (IN(s0 + 2)) {
            OPQ_WS(w); OPQ_LDS(ld);
            pg8::StaticOrder S; S.init(T, D, G, bx, (const bf16*)(w + WS_WOUT) + (size_t)l * D * D);
            pg8::EpiOutProj E{(float*)(w + WS_X), (bf16*)(w + WS_XB)};
            pg8::gemm_phase<pg8::EpiOutProj, pg8::StaticOrder, false>(ld, (const bf16*)(w + WS_ON), D, S, E, wave);
        }
        SEAM(s0 + 2);
        if (IN(s0 + 3)) {
            OPQ_WS(w); OPQ_LDS(ld); OPQ_LANE(ln);
            LAS float* lg = (LAS float*)(ld + wave * 3072);
            P q{}; q.ws = w;
            for (int tile = gw; tile < T / 16; tile += NGW) router_tile(q, l, tile, lg, ln);
            __syncthreads();
        }
        SEAM(s0 + 3);
        if (IN(s0 + 4) || IN(s0 + 5)) {
            { OPQ_WS(w); OPQ_LDS(ld);
              LAS int* tbl = (LAS int*)(ld + LDS_TBL);
              __syncthreads();
              if (wave == 0 && lane_id_opaque() == 0) {
                  const u32* ecnt = (const u32*)(w + WS_CTL) + CW_ECNT + l * 32; int base = 0;
                  for (int e = 0; e < NE; ++e) { const int c = (int)__hip_atomic_load(ecnt + e, __ATOMIC_RELAXED, __HIP_MEMORY_SCOPE_AGENT); tbl[e] = base; tbl[33 + e] = c; base += (c + 255) >> 8; }
                  tbl[32] = base;
              }
              __syncthreads(); }
            if (IN(s0 + 4)) {
                OPQ_WS(w); OPQ_LDS(ld);
                pg8::MoeOrder<true, 4> S{(const LAS int*)(ld + LDS_TBL), (const int*)(w + WS_ELIST), (const bf16*)(w + WS_WGU) + (size_t)l * NE * 1024 * 1024, (size_t)1024 * 1024, G, bx};
                pg8::EpiMoe1 E{(bf16*)(w + WS_ABUF), (const float*)(w + WS_RSTD2), (const int*)(w + WS_ELIST)};
                pg8::gemm_phase<pg8::EpiMoe1, pg8::MoeOrder<true, 4>, true>(ld, (const bf16*)(w + WS_XB), D, S, E, wave);
            }
            SEAM(s0 + 4);
            if (IN(s0 + 5)) {
                OPQ_WS(w); OPQ_LDS(ld);
                pg8::MoeOrder<false, 4> S{(const LAS int*)(ld + LDS_TBL), (const int*)(w + WS_ELIST), (const bf16*)(w + WS_WD) + (size_t)l * NE * 1024 * 512, (size_t)1024 * 512, G, bx};
                pg8::EpiMoe2 E{(bf16*)(w + WS_YS), (const float*)(w + WS_SLOTW), (const int*)(w + WS_ELIST)};
                pg8::gemm_phase<pg8::EpiMoe2, pg8::MoeOrder<false, 4>, true>(ld, (const bf16*)(w + WS_ABUF), DE, S, E, wave);
            }
        }
        SEAM(s0 + 5);
        if (IN(s0 + 6)) { OPQ_WS(w); OPQ_LDS(ld); OPQ_LANE(ln); const P q = load_params(ld, w); phase_combine(q, l, gw, NGW, ln); }
        SEAM(s0 + 6);
    }
#undef IN
#undef SEAM
}

__global__ void k_kmean_naive(P p) {
    const int idx = blockIdx.x * blockDim.x + threadIdx.x;
    const int d = idx & 63, blk = (idx >> 6) & 7, h = (idx >> 9) & 7, b = idx >> 12;
    const bf16* PR = (const bf16*)(p.ws + WS_PROJ);
    float s = 0.f;
    for (int j = 0; j < 256; ++j) s += bf2f(PR[(size_t)(b * SEQ + blk * 256 + j) * INC + C_KB + h * 64 + d]);
    ((float*)(p.ws + WS_KMEAN + 262144))[idx] = s * (1.f / 256.f);
}
__global__ void __launch_bounds__(64) k_sb_naive(P p) {
    const int idx = blockIdx.x * 64 + threadIdx.x;
    const int t = idx % SEQ, h = (idx / SEQ) % 4, b = idx / (SEQ * 4);
    const bf16* PR = (const bf16*)(p.ws + WS_PROJ);
    const size_t row = (size_t)b * SEQ + t;
    uint4 q[8];
#pragma unroll
    for (int i = 0; i < 8; ++i) q[i] = *(const uint4*)(PR + row * INC + C_QA + h * 64 + i * 8);
    float acc[64];
#pragma unroll
    for (int i = 0; i < 64; ++i) acc[i] = 0.f;
    float L = 0.f;
    for (int s = t - 1; s >= 0; --s) {
        const bf16* kr = PR + ((size_t)b * SEQ + s) * INC + C_KA + h * 64;
        const bf16* vr = PR + ((size_t)b * SEQ + s) * INC + C_VA + h * 64;
        float z = 0.f;
#pragma unroll
        for (int i = 0; i < 8; ++i) z += dot8(q[i], *(const uint4*)(kr + i * 8));
        z *= 0.125f;
        const float l1p = log1pf(expf(-fabsf(z)));
        const float ls = fminf(z, 0.f) - l1p, lr = fminf(-z, 0.f) - l1p;
        const float w = expf(ls + L);
        L += lr;
#pragma unroll
        for (int i = 0; i < 8; ++i) {
            const uint4 vv = *(const uint4*)(vr + i * 8);
            acc[i * 8 + 0] += w * blo(vv.x); acc[i * 8 + 1] += w * bhi(vv.x); acc[i * 8 + 2] += w * blo(vv.y); acc[i * 8 + 3] += w * bhi(vv.y);
            acc[i * 8 + 4] += w * blo(vv.z); acc[i * 8 + 5] += w * bhi(vv.z); acc[i * 8 + 6] += w * blo(vv.w); acc[i * 8 + 7] += w * bhi(vv.w);
        }
    }
    float* O = (float*)(p.ws + WS_YS) + row * D + h * 64;
#pragma unroll
    for (int i = 0; i < 16; ++i) *(float4*)(O + i * 4) = make_float4(acc[i * 4], acc[i * 4 + 1], acc[i * 4 + 2], acc[i * 4 + 3]);
}
__global__ void __launch_bounds__(64) k_moba_naive(P p) {
    const int idx = blockIdx.x * 64 + threadIdx.x;
    const int t = idx % SEQ, h = (idx / SEQ) % 8, b = idx / (SEQ * 8);
    const bf16* PR = (const bf16*)(p.ws + WS_PROJ);
    const size_t row = (size_t)b * SEQ + t;
    const int own = t >> 8;
    uint4 q[8];
#pragma unroll
    for (int i = 0; i < 8; ++i) q[i] = *(const uint4*)(PR + row * INC + C_QB + h * 64 + i * 8);
    const float* KM = (const float*)(p.ws + WS_KMEAN + 262144) + ((size_t)(b * 8 + h) * 8) * 64;
    float g[8];
#pragma unroll
    for (int j = 0; j < 8; ++j) {
        float s = -1e30f;
        if (j < own) {
            s = 0.f;
#pragma unroll
            for (int i = 0; i < 8; ++i) {
                const float* km = KM + j * 64 + i * 8;
                s += blo(q[i].x) * km[0] + bhi(q[i].x) * km[1] + blo(q[i].y) * km[2] + bhi(q[i].y) * km[3] + blo(q[i].z) * km[4] + bhi(q[i].z) * km[5] + blo(q[i].w) * km[6] + bhi(q[i].w) * km[7];
            }
        }
        g[j] = s;
    }
    unsigned selmask = 0; const int nsel = own < 3 ? own : 3;
    for (int r = 0; r < nsel; ++r) {
        float best = -3e38f; int bi = 0;
#pragma unroll
        for (int j = 0; j < 8; ++j) { const bool ok = !((selmask >> j) & 1u) && g[j] > best; if (ok) { best = g[j]; bi = j; } }
        selmask |= 1u << bi;
    }
    float acc[64];
#pragma unroll
    for (int i = 0; i < 64; ++i) acc[i] = 0.f;
    float mx = -3e38f, lsum = 0.f;
    for (int blk = 0; blk <= own; ++blk) {
        if (blk < own && !((selmask >> blk) & 1u)) continue;
        const int s1 = blk == own ? t : blk * 256 + 255;
        for (int s = blk * 256; s <= s1; ++s) {
            const bf16* kr = PR + ((size_t)b * SEQ + s) * INC + C_KB + h * 64;
            const bf16* vr = PR + ((size_t)b * SEQ + s) * INC + C_VB + h * 64;
            float z = 0.f;
#pragma unroll
            for (int i = 0; i < 8; ++i) z += dot8(q[i], *(const uint4*)(kr + i * 8));
            z *= 0.125f;
            const float mn = fmaxf(mx, z), sc = expf(mx - mn), w = expf(z - mn);
            mx = mn; lsum = lsum * sc + w;
#pragma unroll
            for (int i = 0; i < 8; ++i) {
                const uint4 vv = *(const uint4*)(vr + i * 8);
                acc[i * 8 + 0] = acc[i * 8 + 0] * sc + w * blo(vv.x); acc[i * 8 + 1] = acc[i * 8 + 1] * sc + w * bhi(vv.x);
                acc[i * 8 + 2] = acc[i * 8 + 2] * sc + w * blo(vv.y); acc[i * 8 + 3] = acc[i * 8 + 3] * sc + w * bhi(vv.y);
                acc[i * 8 + 4] = acc[i * 8 + 4] * sc + w * blo(vv.z); acc[i * 8 + 5] = acc[i * 8 + 5] * sc + w * bhi(vv.z);
                acc[i * 8 + 6] = acc[i * 8 + 6] * sc + w * blo(vv.w); acc[i * 8 + 7] = acc[i * 8 + 7] * sc + w * bhi(vv.w);
            }
        }
    }
    const float il = 1.f / lsum;
    float* O = (float*)(p.ws + WS_YS) + row * D + 256 + h * 64;
#pragma unroll
    for (int i = 0; i < 16; ++i) *(float4*)(O + i * 4) = make_float4(acc[i * 4] * il, acc[i * 4 + 1] * il, acc[i * 4 + 2] * il, acc[i * 4 + 3] * il);
}
__global__ void k_gvn_naive(P p, int l) {
    const int idx = blockIdx.x * blockDim.x + threadIdx.x;
    const int g = idx & 3, t = idx >> 2;
    const bf16* v = (const bf16*)(p.ws + WS_PROJ) + (size_t)t * INC + C_VC + g * 64;
    float s = 0.f;
    for (int d = 0; d < 64; ++d) { const float x = bf2f(v[d]); s += x * x; }
    const float rs = rsqrtf(s * (1.f / 64.f) + EPS);
    float* o = (float*)(p.ws + WS_ABUF) + (size_t)t * 256 + g * 64;
    for (int d = 0; d < 64; ++d) o[d] = bf2f(v[d]) * rs * p.g_vn[(l * 4 + g) * 64 + d];
}
__global__ void k_gmlp_naive(P p, int l) {
    const int idx = blockIdx.x * blockDim.x + threadIdx.x;
    const int d = idx & 63, g = (idx >> 6) & 3, t = idx >> 8;
    const int tc = t & 127, t0 = t - tc;
    const float* VN = (const float*)(p.ws + WS_ABUF);
    const float* w = p.w_sp + ((size_t)(l * 4 + g) * 128 + tc) * 128;
    float s = 0.f;
    for (int j = 0; j <= tc; ++j) s += w[j] * VN[(size_t)(t0 + j) * 256 + g * 64 + d];
    s += p.b_sp[(l * 4 + g) * 128 + tc];
    const float u = bf2f(((const bf16*)(p.ws + WS_PROJ))[(size_t)t * INC + C_UC + g * 64 + d]);
    ((float*)(p.ws + WS_YS))[(size_t)t * D + 768 + g * 64 + d] = u * s;
}
__global__ void k_headnorm_naive(P p, int l) {
    const int idx = blockIdx.x * blockDim.x + threadIdx.x;
    const int h = idx & 15, t = idx >> 4;
    const float* o = (const float*)(p.ws + WS_YS) + (size_t)t * D + h * 64;
    float s = 0.f;
    for (int d = 0; d < 64; ++d) s += o[d] * o[d];
    const float rs = rsqrtf(s * (1.f / 64.f) + EPS);
    bf16* on = (bf16*)(p.ws + WS_ON) + (size_t)t * D + h * 64;
    for (int d = 0; d < 64; ++d) on[d] = f2bf(o[d] * rs * p.g_head[(l * 16 + h) * 64 + d]);
}

extern "C" void kernel_launch(void* const* d_in, const int* in_sizes, int n_in, void* d_out, int out_size, void* d_ws, size_t ws_size, hipStream_t stream) {
    static int grid = 0;
    if (grid == 0) {
        if (n_in != 16 || out_size != T * D || ws_size < WS_END) { fprintf(stderr, "kernel_launch: unexpected sizes (n_in %d out %d ws %zu)\n", n_in, out_size, ws_size); grid = -1; return; }
        int dev = 0, cus = 0, per_cu = 0;
        if (hipGetDevice(&dev) != hipSuccess || hipDeviceGetAttribute(&cus, hipDeviceAttributeMultiprocessorCount, dev) != hipSuccess) { grid = -1; return; }
        if (hipFuncSetAttribute((const void*)mk, hipFuncAttributeMaxDynamicSharedMemorySize, LDS_BYTES) != hipSuccess) { fprintf(stderr, "kernel_launch: hipFuncSetAttribute failed\n"); grid = -1; return; }
        if (hipOccupancyMaxActiveBlocksPerMultiprocessor(&per_cu, (const void*)mk, NWAVES * 64, LDS_BYTES) != hipSuccess || per_cu < 1) fprintf(stderr, "kernel_launch: occupancy query says %d\n", per_cu);
        (void)hipGetLastError();
        grid = cus;
    }
    if (grid < 0) return;
    P p{};
    p.x = (const float*)d_in[0]; p.pos = (const int*)d_in[1]; p.w_in = (const float*)d_in[2]; p.w_out = (const float*)d_in[3];
    p.g_mix = (const float*)d_in[4]; p.g_head = (const float*)d_in[5]; p.g_vn = (const float*)d_in[6]; p.w_sp = (const float*)d_in[7];
    p.b_sp = (const float*)d_in[8]; p.g_ffn = (const float*)d_in[9]; p.w_rg = (const float*)d_in[10]; p.w_re = (const float*)d_in[11];
    p.w_g = (const float*)d_in[12]; p.w_u = (const float*)d_in[13]; p.w_d = (const float*)d_in[14]; p.g_fin = (const float*)d_in[15];
    p.out = (float*)d_out; p.ws = (unsigned char*)d_ws;
    (void)hipMemsetAsync((char*)d_ws + WS_CTL, 0, CTL_BYTES, stream);
    int region = 0;
#ifndef NAIVE_MIX
#define NAIVE_MIX 0
#endif
#ifndef MIX_MASK
#define MIX_MASK 7
#endif
    auto launch = [&](int lo, int hi) { hipLaunchKernelGGL(mk, dim3(grid), dim3(NWAVES * 64), LDS_BYTES, stream, p, lo, hi, region, (int)MIX_MASK); ++region; };
#if NAIVE_MIX
    int lo = 0;
    for (int l = 0; l < DEPTH; ++l) {
        const int s0 = 1 + 7 * l;
        launch(lo, s0 + 1);
        k_kmean_naive<<<BATCH * 8 * 8 * 64 / 256, 256, 0, stream>>>(p);
        k_sb_naive<<<BATCH * 4 * SEQ / 64, 64, 0, stream>>>(p);
        k_moba_naive<<<BATCH * 8 * SEQ / 64, 64, 0, stream>>>(p);
        k_gvn_naive<<<T * 4 / 256, 256, 0, stream>>>(p, l);
        k_gmlp_naive<<<T * 256 / 256, 256, 0, stream>>>(p, l);
        k_headnorm_naive<<<T * 16 / 256, 256, 0, stream>>>(p, l);
        lo = s0 + 1;
    }
    launch(lo, NSTEPS);
#else
    launch(0, NSTEPS);
#endif
}
```

```cpp
#include <hip/hip_runtime.h>
#include <cstdint>
#include <cstdio>

constexpr int D = 1024, BATCH = 8, SEQ = 2048, T = BATCH * SEQ, DEPTH = 4;
constexpr int HD = 64;
constexpr int INC = 2816;
constexpr int C_QA = 0, C_KA = 256, C_VA = 512, C_QB = 768, C_KB = 1280, C_VB = 1792, C_UC = 2304, C_VC = 2560;
constexpr int NE = 32, EPG = 8, DE = 512;
constexpr int NSLOT = T * 2;
constexpr int MAXMT = 160;
constexpr float EPS = 1e-6f;

typedef unsigned short bf16;
typedef unsigned u32;
#define LAS __attribute__((address_space(3)))
#define GAS __attribute__((address_space(1)))

constexpr size_t MiB = 1u << 20;
constexpr size_t WS_CTL = 0, CTL_BYTES = 1 * MiB;
constexpr size_t WS_WR = 1 * MiB;
constexpr size_t WS_ROPE = 2 * MiB;
constexpr size_t WS_RSTD = 3 * MiB;
constexpr size_t WS_RSTD2 = WS_RSTD + 65536;
constexpr size_t WS_SLOTW = WS_RSTD2 + 65536;
constexpr size_t WS_KMEAN = WS_RSTD + 524288;
constexpr size_t WS_ELIST = 4 * MiB;
constexpr size_t WS_WIN = 8 * MiB;
constexpr size_t WS_WOUT = 30 * MiB;
constexpr size_t WS_WGU = 38 * MiB;
constexpr size_t WS_WD = 294 * MiB;
constexpr size_t WS_X = 422 * MiB;
constexpr size_t WS_XB = 486 * MiB;
constexpr size_t WS_PROJ = 518 * MiB;
constexpr size_t WS_ON = 606 * MiB;
constexpr size_t WS_ABUF = 638 * MiB;
constexpr size_t WS_YS = 678 * MiB;
constexpr size_t WS_END = 742 * MiB;
constexpr int CW_ECNT = 1024;
constexpr int CW_BAR = 4096;
constexpr int RING_BYTES = 131072;
constexpr int RT_LD = 2080;
constexpr int RT_IMG = 36 * RT_LD;
constexpr int LDS_CTL = 150528;
constexpr int LDS_TBL = LDS_CTL;
constexpr int LDS_MISC = LDS_CTL + 1024;
constexpr int LDS_PTRS = LDS_CTL + 2048;
constexpr int LDS_BYTES = 163840;
static_assert(2 * RT_IMG <= LDS_CTL && LDS_PTRS + 17 * 8 <= LDS_BYTES, "LDS map");
constexpr int NWAVES = 8;

struct P {
    const float* x; const int* pos; const float* w_in; const float* w_out; const float* g_mix; const float* g_head; const float* g_vn;
    const float* w_sp; const float* b_sp; const float* g_ffn; const float* w_rg; const float* w_re; const float* w_g; const float* w_u;
    const float* w_d; const float* g_fin; float* out; unsigned char* ws;
};

__device__ __forceinline__ bf16 f2bf(float f) { u32 u = __float_as_uint(f); return (bf16)((u + 0x7fffu + ((u >> 16) & 1u)) >> 16); }
__device__ __forceinline__ float bf2f(bf16 h) { return __uint_as_float((u32)h << 16); }
__device__ __forceinline__ u32 pk2(float lo, float hi) { return (u32)f2bf(lo) | ((u32)f2bf(hi) << 16); }
__device__ __forceinline__ float blo(u32 u) { return __uint_as_float(u << 16); }
__device__ __forceinline__ float bhi(u32 u) { return __uint_as_float(u & 0xffff0000u); }
__device__ __forceinline__ float wave_sum(float v) {
#pragma unroll
    for (int o = 1; o < 64; o <<= 1) v += __shfl_xor(v, o);
    return v;
}
__device__ __forceinline__ float dot8(uint4 a, uint4 b) {
    return blo(a.x) * blo(b.x) + bhi(a.x) * bhi(b.x) + blo(a.y) * blo(b.y) + bhi(a.y) * bhi(b.y) +
           blo(a.z) * blo(b.z) + bhi(a.z) * bhi(b.z) + blo(a.w) * blo(b.w) + bhi(a.w) * bhi(b.w);
}
__device__ __forceinline__ float gelu_tanh(float x) {
    const float u = 0.7978845608028654f * (x + 0.044715f * x * x * x);
    return x / (1.f + __expf(-2.f * u));
}
#define LDS_WAIT() asm volatile("s_waitcnt lgkmcnt(0)" ::: "memory")
__device__ __forceinline__ int lane_id_opaque() { int ln; asm volatile("v_mbcnt_lo_u32_b32 %0, -1, 0\n\tv_mbcnt_hi_u32_b32 %0, -1, %0" : "=v"(ln)); return ln; }

namespace pg8 {
typedef unsigned short bf16_t;
typedef short bf16x8 __attribute__((ext_vector_type(8)));
typedef float f32x4 __attribute__((ext_vector_type(4)));
typedef unsigned u32x4 __attribute__((ext_vector_type(4)));
typedef unsigned u32x2 __attribute__((ext_vector_type(2)));
constexpr int BM = 256, BK = 64, HALF = 128, HTB = HALF * BK * 2, STAGE_BYTES = 8 * HTB, NXCD = 8, WGM = 8;

__host__ __device__ __forceinline__ int lds_byte(int r, int c) { const int st = (r >> 4) * 2 + (c >> 5), rr = r & 15, cc = c & 31, ob = rr * 64 + cc * 2; return st * 1024 + (ob ^ (((ob >> 9) & 1) << 5)); }
__host__ __device__ __forceinline__ void stage_rc(int b, int& R, int& C) { const int st = b / 1024, sb = b % 1024, swz = sb ^ (((sb >> 9) & 1) << 5); R = (st >> 1) * 16 + swz / 64; C = (st & 1) * 32 + (swz % 64) / 2; }
__host__ __device__ __forceinline__ int perm32(int rho) { const int n = rho >> 4, i = rho & 15; return 8 * (i >> 2) + 4 * n + (i & 3); }

struct Unit { int pm, pn, e, r0, nvalid; };

struct StaticOrder {
    static constexpr bool GATHER = false;
    int nM, nN, nwg, G, c; const bf16_t* Bt;
    __device__ void init(int M, int N, int G_, int c_, const bf16_t* Bt_) { nM = M / BM; nN = N / BM; nwg = nM * nN; G = G_; c = c_; Bt = Bt_; }
    __device__ __forceinline__ bool next(int i, Unit& u) const {
        const long L = (long)i * G + c; if (L >= nwg) return false;
        int wgid = (int)L; { const int q = nwg / NXCD, r = nwg % NXCD, xcd = wgid % NXCD, off = wgid / NXCD; wgid = (xcd < r ? xcd * (q + 1) : r * (q + 1) + (xcd - r) * q) + off; }
        const int nig = WGM * nN, gid = wgid / nig, fm = gid * WGM, gsz = (nM - fm) < WGM ? (nM - fm) : WGM;
        u.pm = fm + ((wgid % nig) % gsz); u.pn = (wgid % nig) / gsz; u.e = 0; u.r0 = 0; u.nvalid = 256; return true;
    }
    __device__ __forceinline__ void a_offs(const Unit& u, int K, const int (&R)[2], const int (&C)[2], unsigned (&v)[2][2]) const {
#pragma unroll
        for (int h = 0; h < 2; ++h)
#pragma unroll
            for (int i = 0; i < 2; ++i) v[h][i] = (unsigned)((u.pm * BM + h * HALF + R[i]) * K + C[i]) * 2u;
    }
    __device__ __forceinline__ const char* b_ptr(const Unit& u, int K) const { return (const char*)(Bt + (size_t)u.pn * BM * K); }
};
template <bool GATHER_, int NN>
struct MoeOrder {
    static constexpr bool GATHER = GATHER_;
    const LAS int* tbl; const int* elist; const bf16_t* Bt; size_t estride; int G, c;
    __device__ __forceinline__ bool next(int i, Unit& u) const {
        const int L = i * G + c, nmt = tbl[32]; if (L >= nmt * NN) return false;
        const int mt = L / NN; u.pn = L % NN; u.pm = mt;
        int e = 0;
#pragma unroll 1
        while (tbl[e + 1] <= mt) ++e;
        u.e = e; u.r0 = (mt - tbl[e]) * 256; const int rem = tbl[33 + e] - u.r0; u.nvalid = rem < 256 ? rem : 256; return true;
    }
    __device__ __forceinline__ void a_offs(const Unit& u, int K, const int (&R)[2], const int (&C)[2], unsigned (&v)[2][2]) const {
#pragma unroll
        for (int h = 0; h < 2; ++h)
#pragma unroll
            for (int i = 0; i < 2; ++i) {
                const int r = h * HALF + R[i]; int row;
                if (GATHER) { row = 0; if (r < u.nvalid) row = elist[(size_t)u.e * NSLOT + u.r0 + r] >> 1; }
                else row = u.pm * BM + r;
                v[h][i] = (unsigned)(row * K + C[i]) * 2u;
            }
    }
    __device__ __forceinline__ const char* b_ptr(const Unit& u, int K) const { return (const char*)(Bt + (size_t)u.e * estride + (size_t)u.pn * BM * K); }
};

__device__ __forceinline__ unsigned cvt_pk_bf16(float lo, float hi) { unsigned r; asm volatile("v_cvt_pk_bf16_f32 %0, %1, %2" : "=v"(r) : "v"(lo), "v"(hi)); return r; }

struct EpiInProj {
    static constexpr bool PERM = true;
    bf16_t* O; const float* rstd; const float* rope; float* kmp;
    __device__ __forceinline__ void operator()(const f32x4 (&acc)[2][2][4][2], const Unit& u, int wr, int wc, int fr, int fq) const {
        const int mode = (u.pn >= 3 && u.pn <= 6) ? 1 : (u.pn >= 9 ? 2 : 0);
        const int row0 = u.pm * BM + wr * 64 + fr, col0 = u.pn * BM + wc * 32 + 8 * fq;
        const bool ropew = (mode == 1) && ((wc & 1) == 0);
        const bool ksum = (u.pn == 5 || u.pn == 6);
        float cs[2][8];
#pragma unroll
        for (int bj = 0; bj < 2; ++bj)
#pragma unroll
            for (int j = 0; j < 8; ++j) cs[bj][j] = 0.f;
#pragma unroll
        for (int ai = 0; ai < 2; ++ai)
#pragma unroll
            for (int m = 0; m < 4; ++m) {
                const int row = row0 + ai * HALF + m * 16; const float rs = rstd[row];
                bf16_t* rowp = O + (size_t)row * INC + col0;
#pragma unroll
                for (int bj = 0; bj < 2; ++bj) {
                    f32x4 v0 = acc[ai][bj][m][0] * rs, v1 = acc[ai][bj][m][1] * rs;
                    if (ropew) {
                        const f32x4* cs4 = (const f32x4*)(rope + (size_t)row * 16);
                        const f32x4 c0 = cs4[0], c1 = cs4[1], c2 = cs4[2], c3 = cs4[3];
                        f32x4 p0, p1;
#pragma unroll
                        for (int j = 0; j < 4; ++j) { p0[j] = __shfl_xor(v0[j], 16); p1[j] = __shfl_xor(v1[j], 16); }
                        const float sg = fq == 0 ? -1.f : 1.f;
                        if (fq < 2) {
                            v0[0] = v0[0] * c0[0] + sg * p0[0] * c0[1]; v0[1] = v0[1] * c0[2] + sg * p0[1] * c0[3];
                            v0[2] = v0[2] * c1[0] + sg * p0[2] * c1[1]; v0[3] = v0[3] * c1[2] + sg * p0[3] * c1[3];
                            v1[0] = v1[0] * c2[0] + sg * p1[0] * c2[1]; v1[1] = v1[1] * c2[2] + sg * p1[1] * c2[3];
                            v1[2] = v1[2] * c3[0] + sg * p1[2] * c3[1]; v1[3] = v1[3] * c3[2] + sg * p1[3] * c3[3];
                        }
                    }
                    if (ksum) {
#pragma unroll
                        for (int j = 0; j < 4; ++j) { cs[bj][j] += v0[j]; cs[bj][4 + j] += v1[j]; }
                    }
                    if (mode == 2) {
#pragma unroll
                        for (int j = 0; j < 4; ++j) { v0[j] = gelu_tanh(v0[j]); v1[j] = gelu_tanh(v1[j]); }
                    }
                    u32x4 w; w.x = cvt_pk_bf16(v0[0], v0[1]); w.y = cvt_pk_bf16(v0[2], v0[3]); w.z = cvt_pk_bf16(v1[0], v1[1]); w.w = cvt_pk_bf16(v1[2], v1[3]);
                    *(u32x4*)(rowp + bj * HALF) = w;
                }
                asm volatile("" ::: "memory");
            }
        if (ksum) {
#pragma unroll
            for (int bj = 0; bj < 2; ++bj)
#pragma unroll
                for (int j = 0; j < 8; ++j) { float v = cs[bj][j]; v += __shfl_xor(v, 1); v += __shfl_xor(v, 2); v += __shfl_xor(v, 4); v += __shfl_xor(v, 8); cs[bj][j] = v; }
            if (fr == 0) {
                const int bb = u.pm >> 3, blk = u.pm & 7;
#pragma unroll
                for (int bj = 0; bj < 2; ++bj) {
                    const int hh = (u.pn - 5) * 4 + bj * 2 + (wc >> 1), d0 = (wc & 1) * 32 + 8 * fq;
                    float* dst = kmp + (size_t)wr * (BATCH * 8 * 8 * 64) + ((size_t)((bb * 8 + hh) * 8 + blk)) * 64 + d0;
                    *(f32x4*)dst = (f32x4){cs[bj][0], cs[bj][1], cs[bj][2], cs[bj][3]}; *(f32x4*)(dst + 4) = (f32x4){cs[bj][4], cs[bj][5], cs[bj][6], cs[bj][7]};
                }
            }
        }
    }
};
struct EpiOutProj {
    static constexpr bool PERM = false;
    float* X; bf16_t* XB; bool dry;
    __device__ __forceinline__ void operator()(const f32x4 (&acc)[2][2][4][2], const Unit& u, int wr, int wc, int fr, int fq) const {
        const int row0 = u.pm * BM + wr * 64 + fr, col0 = u.pn * BM + wc * 32 + 4 * fq;
#pragma unroll
        for (int ai = 0; ai < 2; ++ai)
#pragma unroll
            for (int m = 0; m < 4; ++m) {
                const size_t off = (size_t)(row0 + ai * HALF + m * 16) * D + col0;
#pragma unroll
                for (int bj = 0; bj < 2; ++bj)
#pragma unroll
                    for (int n = 0; n < 2; ++n) {
                        const size_t o = off + bj * HALF + n * 16;
                        const f32x4 x = *(const f32x4*)(X + o) + acc[ai][bj][m][n];
                        if (!dry || x[0] == 123.456f) {
                        *(f32x4*)(X + o) = x;
                        u32x2 w; w.x = cvt_pk_bf16(x[0], x[1]); w.y = cvt_pk_bf16(x[2], x[3]);
                        *(u32x2*)(XB + o) = w; }
                    }
                asm volatile("" ::: "memory");
            }
    }
};
struct EpiMoe1 {
    static constexpr bool PERM = true;
    bf16_t* AB; const float* rstd2; const int* elist;
    __device__ __forceinline__ void operator()(const f32x4 (&acc)[2][2][4][2], const Unit& u, int wr, int wc, int fr, int fq) const {
        const int col0 = u.pn * HALF + wc * 32 + 8 * fq;
#pragma unroll
        for (int ai = 0; ai < 2; ++ai)
#pragma unroll
            for (int m = 0; m < 4; ++m) {
                const int r = ai * HALF + wr * 64 + m * 16 + fr;
                int tok = 0; if (r < u.nvalid) tok = elist[(size_t)u.e * NSLOT + u.r0 + r] >> 1;
                const float rs = rstd2[tok];
                float a[8];
#pragma unroll
                for (int n = 0; n < 2; ++n)
#pragma unroll
                    for (int j = 0; j < 4; ++j) { const float g = acc[ai][0][m][n][j] * rs, uu = acc[ai][1][m][n][j] * rs; a[n * 4 + j] = g / (1.f + __expf(-g)) * uu; }
                u32x4 w; w.x = cvt_pk_bf16(a[0], a[1]); w.y = cvt_pk_bf16(a[2], a[3]); w.z = cvt_pk_bf16(a[4], a[5]); w.w = cvt_pk_bf16(a[6], a[7]);
                *(u32x4*)(AB + (size_t)(u.pm * BM + r) * DE + col0) = w;
                asm volatile("" ::: "memory");
            }
    }
};
struct EpiMoe2 {
    static constexpr bool PERM = true;
    bf16_t* YS; const float* slotw; const int* elist;
    __device__ __forceinline__ void operator()(const f32x4 (&acc)[2][2][4][2], const Unit& u, int wr, int wc, int fr, int fq) const {
        const int col0 = u.pn * BM + wc * 32 + 8 * fq;
#pragma unroll
        for (int ai = 0; ai < 2; ++ai)
#pragma unroll
            for (int m = 0; m < 4; ++m) {
                const int r = ai * HALF + wr * 64 + m * 16 + fr;
                if (r < u.nvalid) {
                    const int slot = elist[(size_t)u.e * NSLOT + u.r0 + r]; const float w8 = slotw[slot];
#pragma unroll
                    for (int bj = 0; bj < 2; ++bj) {
                        const f32x4 v0 = acc[ai][bj][m][0] * w8, v1 = acc[ai][bj][m][1] * w8;
                        u32x4 w; w.x = cvt_pk_bf16(v0[0], v0[1]); w.y = cvt_pk_bf16(v0[2], v0[3]); w.z = cvt_pk_bf16(v1[0], v1[1]); w.w = cvt_pk_bf16(v1[2], v1[3]);
                        *(u32x4*)(YS + (size_t)slot * D + col0 + bj * HALF) = w;
                    }
                }
                asm volatile("" ::: "memory");
            }
    }
};

template <class Epi, class Sched, bool ALIGN_EPI>
__device__ __forceinline__ void gemm_phase(LAS unsigned char* lds, const bf16_t* Abase, const int K, const Sched& S, const Epi& E, const int wave) {
    int wid_ = wave; asm volatile("" : "+s"(wid_));
    const int lane = lane_id_opaque(), wid = wid_, tid = wid * 64 + lane, wr = wid >> 2, wc = wid & 3, fr = lane & 15, fq = lane >> 4;
    const int nt = K / BK;
    int Rr[2], Cc[2]; unsigned voffB[2];
#pragma unroll
    for (int i = 0; i < 2; ++i) { int R, C; stage_rc(tid * 16 + i * 8192, R, C); Rr[i] = R; Cc[i] = C; const int Rb = Epi::PERM ? ((R & ~31) + perm32(R & 31)) : R; voffB[i] = (unsigned)(Rb * K + C) * 2u; }
    const size_t kstep = (size_t)(BK * 2);
    const size_t hstep = (size_t)HALF * K * 2;
    const unsigned ldsw = (unsigned)wid * 1024u;
    const int aoff = lds_byte(wr * 64 + fr, fq * 8), boff = lds_byte(wc * 32 + fr, fq * 8);
#define PG8_SA(b, h) (((b) * 2 + (h)) * HTB)
#define PG8_SB(b, h) ((4 + (b) * 2 + (h)) * HTB)
#define PG8_STAGE(bufoff, gbase, voff) do { _Pragma("unroll") for (int _i = 0; _i < 2; ++_i) \
        __builtin_amdgcn_global_load_lds((const unsigned*)((const char*)(gbase) + (voff)[_i]), (LAS unsigned*)(lds + (bufoff) + ldsw + _i * 8192), 16, 0, 0); } while (0)
#define PG8_LDA(dst, b, h) do { _Pragma("unroll") for (int m = 0; m < 4; ++m) _Pragma("unroll") for (int k = 0; k < 2; ++k) dst[m][k] = *(const LAS bf16x8*)(lds + PG8_SA(b, h) + aoff + m * 2048 + k * 1024); } while (0)
#define PG8_LDB(dst, b, h) do { _Pragma("unroll") for (int n = 0; n < 2; ++n) _Pragma("unroll") for (int k = 0; k < 2; ++k) dst[n][k] = *(const LAS bf16x8*)(lds + PG8_SB(b, h) + boff + n * 2048 + k * 1024); } while (0)
#define PG8_MMA(ai, bj, At, Bt) do { __builtin_amdgcn_s_setprio(1); _Pragma("unroll") for (int m = 0; m < 4; ++m) _Pragma("unroll") for (int n = 0; n < 2; ++n) _Pragma("unroll") for (int k = 0; k < 2; ++k) \
        acc[ai][bj][m][n] = __builtin_amdgcn_mfma_f32_16x16x32_bf16(Bt[n][k], At[m][k], acc[ai][bj][m][n], 0, 0, 0); __builtin_amdgcn_s_setprio(0); } while (0)
#define PG8_WAIT_V(n) asm volatile("s_waitcnt vmcnt(" #n ")" ::: "memory")
#define PG8_WAIT_L(n) asm volatile("s_waitcnt lgkmcnt(" #n ")" ::: "memory")
#define PG8_BAR __builtin_amdgcn_s_barrier()
#define PG8_SCHED __builtin_amdgcn_sched_barrier(0)
    Unit cur, nxt; int ui = 0;
    if (!S.next(0, cur)) return;
    f32x4 acc[2][2][4][2];
#pragma unroll
    for (int a = 0; a < 2; ++a)
#pragma unroll
        for (int b = 0; b < 2; ++b)
#pragma unroll
            for (int m = 0; m < 4; ++m)
#pragma unroll
                for (int n = 0; n < 2; ++n) acc[a][b][m][n] = (f32x4){0.f, 0.f, 0.f, 0.f};
    bf16x8 At[4][2], B0[2][2], B1[2][2];
    unsigned vAc[2][2], vAn[2][2];
    unsigned voffA[2];
    const char* const A0 = (const char*)Abase; const char* cA = A0; const char* cB = S.b_ptr(cur, K);
    if constexpr (Sched::GATHER) S.a_offs(cur, K, Rr, Cc, vAc);
    else { voffA[0] = (unsigned)(Rr[0] * K + Cc[0]) * 2u; voffA[1] = (unsigned)(Rr[1] * K + Cc[1]) * 2u; cA = A0 + (size_t)cur.pm * 2 * hstep; }
#define PG8_STAGE_A(bufoff, koff, NEXT, h) do { if constexpr (Sched::GATHER) { unsigned _v[2] = {(NEXT) ? vAn[h][0] : vAc[h][0], (NEXT) ? vAn[h][1] : vAc[h][1]}; PG8_STAGE(bufoff, A0 + (koff), _v); } \
        else { PG8_STAGE(bufoff, ((NEXT) ? nA : cA) + (koff) + (h) * hstep, voffA); } } while (0)
    const char* nA = cA;
    PG8_STAGE(PG8_SB(0, 0), cB, voffB); PG8_STAGE(PG8_SB(0, 1), cB + hstep, voffB); PG8_STAGE_A(PG8_SA(0, 0), 0, false, 0); PG8_STAGE_A(PG8_SA(0, 1), 0, false, 1);
    if (wr == 1) PG8_BAR;
    PG8_WAIT_V(2); PG8_BAR;
    PG8_STAGE(PG8_SB(1, 0), cB + kstep, voffB); PG8_STAGE_A(PG8_SA(1, 0), kstep, false, 0); PG8_STAGE(PG8_SB(1, 1), cB + hstep + kstep, voffB);
    PG8_WAIT_V(6); PG8_BAR;
    for (;;) {
        const bool has_next = S.next(ui + 1, nxt);
        const char* nB = cB; nA = cA;
        if (has_next) {
            nB = S.b_ptr(nxt, K);
            if constexpr (Sched::GATHER) S.a_offs(nxt, K, Rr, Cc, vAn); else nA = A0 + (size_t)nxt.pm * 2 * hstep;
        } else if constexpr (Sched::GATHER) {
#pragma unroll
            for (int h = 0; h < 2; ++h)
#pragma unroll
                for (int i = 0; i < 2; ++i) vAn[h][i] = vAc[h][i];
        }
        for (int t = 0; t < nt; t += 2) {
            const bool last = (t == nt - 2);
            const size_t k1 = (size_t)(t + 1) * kstep, k2 = last ? 0 : (size_t)(t + 2) * kstep, k3 = k2 + kstep;
            const char* b2 = last ? nB : cB + (size_t)(t + 2) * kstep; const char* b3 = b2 + kstep;
            PG8_LDB(B0, 0, 0); PG8_LDB(B1, 0, 1); PG8_SCHED; PG8_LDA(At, 0, 0); PG8_STAGE_A(PG8_SA(1, 1), k1, false, 1);
            PG8_WAIT_V(8); PG8_WAIT_L(0); PG8_BAR; PG8_MMA(0, 0, At, B0); PG8_MMA(0, 1, At, B1); PG8_BAR; PG8_SCHED;
            PG8_LDA(At, 0, 1); PG8_STAGE(PG8_SB(0, 0), b2, voffB); PG8_STAGE(PG8_SB(0, 1), b2 + hstep, voffB); PG8_STAGE_A(PG8_SA(0, 0), k2, last, 0);
            PG8_WAIT_V(8); PG8_WAIT_L(0); PG8_BAR; PG8_MMA(1, 0, At, B0); PG8_MMA(1, 1, At, B1); PG8_BAR; PG8_SCHED;
            PG8_LDB(B0, 1, 0); PG8_LDB(B1, 1, 1); PG8_SCHED; PG8_LDA(At, 1, 0); PG8_STAGE_A(PG8_SA(0, 1), k2, last, 1);
            PG8_WAIT_V(8); PG8_WAIT_L(0); PG8_BAR; PG8_MMA(0, 0, At, B0); PG8_MMA(0, 1, At, B1); PG8_BAR; PG8_SCHED;
            PG8_LDA(At, 1, 1); PG8_STAGE(PG8_SB(1, 0), b3, voffB); PG8_STAGE(PG8_SB(1, 1), b3 + hstep, voffB); PG8_STAGE_A(PG8_SA(1, 0), k3, last, 0);
            PG8_WAIT_V(8); PG8_WAIT_L(0); PG8_BAR; PG8_MMA(1, 0, At, B0); PG8_MMA(1, 1, At, B1); PG8_BAR; PG8_SCHED;
        }
        if constexpr (ALIGN_EPI) { if (wr == 0) PG8_BAR; }
        E(acc, cur, wr, wc, fr, fq);
        if (!has_next) break;
#pragma unroll
        for (int a = 0; a < 2; ++a)
#pragma unroll
            for (int b = 0; b < 2; ++b)
#pragma unroll
                for (int m = 0; m < 4; ++m)
#pragma unroll
                    for (int n = 0; n < 2; ++n) acc[a][b][m][n] = (f32x4){0.f, 0.f, 0.f, 0.f};
        cur = nxt; cB = nB; cA = nA; ++ui;
        if constexpr (Sched::GATHER) {
#pragma unroll
            for (int h = 0; h < 2; ++h)
#pragma unroll
                for (int i = 0; i < 2; ++i) vAc[h][i] = vAn[h][i];
        }
        if constexpr (ALIGN_EPI) { if (wr == 1) PG8_BAR; }
    }
    PG8_WAIT_V(0);
    if constexpr (!ALIGN_EPI) { if (wr == 0) PG8_BAR; }
    PG8_BAR;
#undef PG8_SA
#undef PG8_SB
#undef PG8_STAGE
#undef PG8_STAGE_A
#undef PG8_LDA
#undef PG8_LDB
#undef PG8_MMA
#undef PG8_WAIT_V
#undef PG8_WAIT_L
#undef PG8_BAR
#undef PG8_SCHED
}
}

#define XB_TMO      128
#define XB_XCNT(j)  (256  + 64 * (j))
#define XB_XSUB(j)  (1280 + 64 * (j))
#define XB_XGEN(j)  (2304 + 64 * (j))
#define XB_TOP      3328
#define XB_TOPGEN   3392
#define XCD_BAR_WORDS 3456
#define XB_SPIN_CAP (1u << 18)
__device__ __forceinline__ unsigned xb_ld(unsigned* p)              { return __hip_atomic_load(p, __ATOMIC_RELAXED, __HIP_MEMORY_SCOPE_AGENT); }
__device__ __forceinline__ unsigned xb_add(unsigned* p, unsigned v) { return __hip_atomic_fetch_add(p, v, __ATOMIC_RELAXED, __HIP_MEMORY_SCOPE_AGENT); }
__device__ __forceinline__ unsigned xb_xcc_id() { return (unsigned)__builtin_amdgcn_s_getreg((3 << 11) | 20) & 0xFu; }
#define XB_SPIN(cond, bar) do { unsigned _sp = 0; while (cond) { __builtin_amdgcn_s_sleep(1); \
    if ((++_sp & 255u) == 0u) { if (xb_ld(&(bar)[XB_TMO])) break; if (_sp > XB_SPIN_CAP) { atomicAdd(&(bar)[XB_TMO], 1u); break; } } } } while (0)
struct XcdBarrier { unsigned* bar; unsigned x; volatile LAS unsigned* st; };
__device__ __forceinline__ XcdBarrier xcd_barrier_post(unsigned* bar, volatile LAS unsigned* st) {
    XcdBarrier b; b.bar = bar; b.x = xb_xcc_id(); b.st = st;
    if (threadIdx.x == 0) (void)xb_add(&bar[XB_XCNT(b.x)], 1u);
    return b;
}
__device__ __forceinline__ void xcd_barrier_complete(unsigned* bar, unsigned x, unsigned& nloc, unsigned& nx) {
    const unsigned G = gridDim.x * gridDim.y * gridDim.z;
    unsigned sum, cnt, mine, sp = 0u;
    for (;;) {
        sum = 0u; cnt = 0u; mine = 0u;
#pragma unroll
        for (unsigned j = 0; j < 16; ++j) { const unsigned c = xb_ld(&bar[XB_XCNT(j)]); sum += c; cnt += (c > 0u) ? 1u : 0u; mine = (j == x) ? c : mine; }
        if (sum == G) break;
        __builtin_amdgcn_s_sleep(1);
        if ((++sp & 255u) == 0u) { if (xb_ld(&bar[XB_TMO])) break; if (sp > XB_SPIN_CAP) { atomicAdd(&bar[XB_TMO], 1u); break; } }
    }
    nloc = mine > 0u ? mine : 1u; nx = cnt > 0u ? cnt : 1u;
}
__device__ __forceinline__ void xcd_barrier(const XcdBarrier& b, const bool t0  ) {
    asm volatile("s_waitcnt vmcnt(0)" ::: "memory");
    __syncthreads();
    if (t0) {
        unsigned* bar = b.bar;
        __builtin_amdgcn_s_waitcnt(0);
        unsigned nloc = b.st[0], nx = b.st[1];
        if (nloc == 0u) { xcd_barrier_complete(bar, b.x, nloc, nx); b.st[0] = nloc; b.st[1] = nx; }
        const unsigned old = xb_add(&bar[XB_XSUB(b.x)], 1u);
        const unsigned gen = old / nloc;
        if (old + 1u == (gen + 1u) * nloc) {
            __builtin_amdgcn_fence(__ATOMIC_RELEASE, "agent");
            asm volatile("s_waitcnt vmcnt(0)" ::: "memory");
            const unsigned og = xb_add(&bar[XB_TOP], 1u);
            const unsigned tg = og / nx;
            if (og + 1u == (tg + 1u) * nx) xb_add(&bar[XB_TOPGEN], 1u);
            else XB_SPIN(xb_ld(&bar[XB_TOPGEN]) == tg, bar);
            __builtin_amdgcn_fence(__ATOMIC_ACQUIRE, "agent");
            xb_add(&bar[XB_XGEN(b.x)], 1u);
            asm volatile("s_waitcnt vmcnt(0)" ::: "memory");
        } else {
            XB_SPIN(xb_ld(&bar[XB_XGEN(b.x)]) == gen, bar);
            __builtin_amdgcn_fence(__ATOMIC_ACQUIRE, "agent");
            asm volatile("s_waitcnt vmcnt(0)" ::: "memory");
        }
    }
    __syncthreads();
}

struct TrDesc { const float* W; bf16* WT; const float* scale; int K, N, mode, item; };
__device__ __forceinline__ void tr_load(const TrDesc& d, float4 (&v)[8], int lane) {
    const int nblk = d.N / 32, kb = d.item / nblk, nb = d.item % nblk, k0 = 64 * kb, n0 = 32 * nb;
    const float* src = d.W + (size_t)(k0 + (lane >> 3)) * d.N + n0 + (lane & 7) * 4;
#pragma unroll
    for (int i = 0; i < 8; ++i) v[i] = *(const float4*)(src + (size_t)(8 * i) * d.N);
}
__device__ __forceinline__ void tr_store(const TrDesc& d, const float4 (&v)[8], LAS float* scr, int lane) {
    const int nblk = d.N / 32, kb = d.item / nblk, nb = d.item % nblk, k0 = 64 * kb, n0 = 32 * nb;
    const int kr = lane >> 3, nq = lane & 7;
#pragma unroll
    for (int i = 0; i < 8; ++i) { LAS float* p = scr + (8 * i + kr) * 33 + 4 * nq; p[0] = v[i].x; p[1] = v[i].y; p[2] = v[i].z; p[3] = v[i].w; }
    LDS_WAIT();
    const int c = lane & 7;
    float sc[8];
#pragma unroll
    for (int e = 0; e < 8; ++e) sc[e] = d.scale ? d.scale[k0 + 8 * c + e] : 1.f;
#pragma unroll
    for (int j = 0; j < 4; ++j) {
        const int n = (lane >> 3) + 8 * j; const LAS float* s = scr + (8 * c) * 33 + n;
        uint4 o; o.x = pk2(s[0 * 33] * sc[0], s[1 * 33] * sc[1]); o.y = pk2(s[2 * 33] * sc[2], s[3 * 33] * sc[3]); o.z = pk2(s[4 * 33] * sc[4], s[5 * 33] * sc[5]); o.w = pk2(s[6 * 33] * sc[6], s[7 * 33] * sc[7]);
        const int ng = n0 + n;
        const int row = d.mode == 0 ? ng : ((ng >> 7) * 256 + (d.mode == 2 ? 128 : 0) + (ng & 127));
        *(uint4*)(d.WT + (size_t)row * d.K + k0 + 8 * c) = o;
    }
    LDS_WAIT();
}
constexpr int I_WIN = DEPTH * (D / 64) * (INC / 32);
constexpr int I_WOUT = DEPTH * (D / 64) * (D / 32);
constexpr int I_G = DEPTH * NE * (D / 64) * (DE / 32);
constexpr int I_D = DEPTH * NE * (DE / 64) * (D / 32);
constexpr int I_TOTAL = I_WIN + I_WOUT + 2 * I_G + I_D;

__device__ __forceinline__ void phase_prologue(const P& p, LAS unsigned char* lds, int gw, int NGW, int wave, int lane) {
    unsigned char* ws = p.ws;
    LAS float* scr = (LAS float*)(lds + wave * (64 * 33 * 4));
    auto desc = [&](int it) {
        TrDesc d; int r = it;
        if (r < I_WIN) { const int per = (D / 64) * (INC / 32), l = r / per; d = TrDesc{p.w_in + (size_t)l * D * INC, (bf16*)(ws + WS_WIN) + (size_t)l * INC * D, p.g_mix + l * D, D, INC, 0, r % per}; return d; }
        r -= I_WIN;
        if (r < I_WOUT) { const int per = (D / 64) * (D / 32), l = r / per; d = TrDesc{p.w_out + (size_t)l * D * D, (bf16*)(ws + WS_WOUT) + (size_t)l * D * D, nullptr, D, D, 0, r % per}; return d; }
        r -= I_WOUT;
        if (r < 2 * I_G) {
            const int up = r >= I_G; if (up) r -= I_G;
            const int per = (D / 64) * (DE / 32), le = r / per, l = le / NE;
            d = TrDesc{(up ? p.w_u : p.w_g) + (size_t)le * D * DE, (bf16*)(ws + WS_WGU) + (size_t)le * 1024 * 1024, p.g_ffn + l * D, D, DE, up ? 2 : 1, r % per}; return d;
        }
        r -= 2 * I_G;
        { const int per = (DE / 64) * (D / 32), le = r / per; d = TrDesc{p.w_d + (size_t)le * DE * D, (bf16*)(ws + WS_WD) + (size_t)le * 1024 * 512, nullptr, DE, D, 0, r % per}; return d; }
    };
    if (gw < I_TOTAL) {
        TrDesc dc = desc(gw); float4 vc[8]; tr_load(dc, vc, lane);
        for (int it = gw; it < I_TOTAL; it += NGW) {
            const int nx = it + NGW; TrDesc dn = dc; float4 vn[8];
            if (nx < I_TOTAL) { dn = desc(nx); tr_load(dn, vn, lane); }
            tr_store(dc, vc, scr, lane);
            dc = dn;
#pragma unroll
            for (int i = 0; i < 8; ++i) vc[i] = vn[i];
        }
    }
    for (int idx = gw * 64 + lane; idx < DEPTH * 36 * D; idx += NGW * 64) {
        const int k = idx % D, j = (idx / D) % 36, l = idx / (36 * D);
        const float v = (j < 4 ? p.w_rg[((size_t)l * D + k) * 4 + j] : p.w_re[((size_t)l * D + k) * NE + (j - 4)]) * p.g_ffn[l * D + k];
        const bf16 h = f2bf(v);
        ((bf16*)(ws + WS_WR))[idx] = h; ((bf16*)(ws + WS_WR))[DEPTH * 36 * D + idx] = f2bf(v - bf2f(h));
    }
    for (int idx = gw * 64 + lane; idx < T * 8; idx += NGW * 64) {
        const int i = idx & 7, t = idx >> 3;
        const float inv = exp2f(-(float)i * (18.931568569324174f / 8.f));
        const float ang = (float)p.pos[t] * inv;
        float sn, cs; sincosf(ang, &sn, &cs);
        float* r = (float*)(ws + WS_ROPE) + (size_t)idx * 2;
        r[0] = cs; r[1] = sn;
    }
    float* X = (float*)(ws + WS_X); bf16* XB = (bf16*)(ws + WS_XB); float* RS = (float*)(ws + WS_RSTD);
    for (int m = gw; m < T; m += NGW) {
        const float4* xr = (const float4*)(p.x + (size_t)m * D) + lane; float4 v[4]; float s = 0.f;
#pragma unroll
        for (int j = 0; j < 4; ++j) { v[j] = xr[64 * j]; s += v[j].x * v[j].x + v[j].y * v[j].y + v[j].z * v[j].z + v[j].w * v[j].w; }
        s = wave_sum(s);
        if (lane == 0) RS[m] = rsqrtf(s * (1.f / D) + EPS);
#pragma unroll
        for (int j = 0; j < 4; ++j) {
            ((float4*)(X + (size_t)m * D) + lane)[64 * j] = v[j];
            ((uint2*)(XB + (size_t)m * D) + lane)[64 * j] = make_uint2(pk2(v[j].x, v[j].y), pk2(v[j].z, v[j].w));
        }
    }
}

typedef float f32x4 __attribute__((ext_vector_type(4)));
__device__ __forceinline__ void phase_router(unsigned char* ws, LAS unsigned char* lds, int l, int vcu, int G, int wave, int lane, bool dry) {
    typedef short bf16x8 __attribute__((ext_vector_type(8)));
    typedef unsigned u32x4 __attribute__((ext_vector_type(4)));
    const int r = lane & 15, q = lane >> 4;
    for (int t4 = vcu; t4 < T / 64; t4 += G) {
        for (int pc = wave; pc < 144; pc += NWAVES) {
            const int img = pc >= 72, pp = pc - img * 72, row = pp >> 1, half = pp & 1;
            const bf16* src = (const bf16*)(ws + WS_WR) + (size_t)img * DEPTH * 36 * D + ((size_t)l * 36 + row) * D + half * 512 + lane * 8;
            __builtin_amdgcn_global_load_lds((const unsigned*)src, (LAS unsigned*)(lds + img * RT_IMG + row * RT_LD + half * 1024), 16, 0, 0);
        }
        asm volatile("s_waitcnt vmcnt(0)" ::: "memory");
        __syncthreads();
        const int tok0 = t4 * 64 + (wave & 3) * 16, kb = (wave >> 2) * 512;
        const float* X = (const float*)(ws + WS_X) + (size_t)(tok0 + r) * D + kb + q * 8;
        f32x4 acc[3] = {{0.f, 0.f, 0.f, 0.f}, {0.f, 0.f, 0.f, 0.f}, {0.f, 0.f, 0.f, 0.f}};
        float ss = 0.f;
        int nrow[3] = {r, 16 + r, 32 + (r & 3)};
#pragma unroll 8
        for (int ks = 0; ks < 16; ++ks) {
            const float4 x0 = *(const float4*)(X + ks * 32), x1 = *(const float4*)(X + ks * 32 + 4);
            ss += x0.x * x0.x + x0.y * x0.y + x0.z * x0.z + x0.w * x0.w + x1.x * x1.x + x1.y * x1.y + x1.z * x1.z + x1.w * x1.w;
            const u32x4 xh = (u32x4){pk2(x0.x, x0.y), pk2(x0.z, x0.w), pk2(x1.x, x1.y), pk2(x1.z, x1.w)};
            const u32x4 xl = (u32x4){pk2(x0.x - blo(xh[0]), x0.y - bhi(xh[0])), pk2(x0.z - blo(xh[1]), x0.w - bhi(xh[1])), pk2(x1.x - blo(xh[2]), x1.y - bhi(xh[2])), pk2(x1.z - blo(xh[3]), x1.w - bhi(xh[3]))};
            const bf16x8 ah = __builtin_bit_cast(bf16x8, xh), al = __builtin_bit_cast(bf16x8, xl);
#pragma unroll
            for (int nt = 0; nt < 3; ++nt) {
                const LAS unsigned char* wp = lds + nrow[nt] * RT_LD + (kb + ks * 32 + q * 8) * 2;
                const bf16x8 bh = *(const LAS bf16x8*)wp, bl = *(const LAS bf16x8*)(wp + RT_IMG);
                acc[nt] = __builtin_amdgcn_mfma_f32_16x16x32_bf16(ah, bh, acc[nt], 0, 0, 0);
                acc[nt] = __builtin_amdgcn_mfma_f32_16x16x32_bf16(ah, bl, acc[nt], 0, 0, 0);
                acc[nt] = __builtin_amdgcn_mfma_f32_16x16x32_bf16(al, bh, acc[nt], 0, 0, 0);
            }
        }
        ss += __shfl_xor(ss, 16); ss += __shfl_xor(ss, 32);
        __syncthreads();
        LAS float* lg = (LAS float*)lds + wave * (16 * 52);
#pragma unroll
        for (int nt = 0; nt < 3; ++nt)
#pragma unroll
            for (int reg = 0; reg < 4; ++reg) lg[(q * 4 + reg) * 52 + nt * 16 + r] = acc[nt][reg];
        if (q == 0) lg[r * 52 + 48] = ss;
        __syncthreads();
        if (wave < 4 && lane < 16 && !dry) {
            const int tok = tok0 + lane;
            const LAS float* L0 = (const LAS float*)lds + wave * (16 * 52) + lane * 52; const LAS float* L1 = L0 + 4 * (16 * 52);
            const float rs = rsqrtf((L0[48] + L1[48]) * (1.f / D) + EPS);
            ((float*)(ws + WS_RSTD2))[tok] = rs;
            float g0 = (L0[0] + L1[0]) * rs, g1 = (L0[1] + L1[1]) * rs, g2 = (L0[2] + L1[2]) * rs, g3 = (L0[3] + L1[3]) * rs;
            int gs = 0; float gm = g0;
            if (g1 > gm) { gm = g1; gs = 1; }
            if (g2 > gm) { gm = g2; gs = 2; }
            if (g3 > gm) { gm = g3; gs = 3; }
            const float pg = 1.f / (expf(g0 - gm) + expf(g1 - gm) + expf(g2 - gm) + expf(g3 - gm));
            float e[8];
#pragma unroll
            for (int j = 0; j < 8; ++j) e[j] = (L0[4 + gs * 8 + j] + L1[4 + gs * 8 + j]) * rs;
            int i1 = 0; float m1 = e[0];
#pragma unroll
            for (int j = 1; j < 8; ++j) if (e[j] > m1) { m1 = e[j]; i1 = j; }
            int i2 = -1; float m2 = -3e38f;
#pragma unroll
            for (int j = 0; j < 8; ++j) if (j != i1 && e[j] > m2) { m2 = e[j]; i2 = j; }
            const float p2 = expf(m2 - m1), inv = 1.f / (1.f + p2);
            const float w1 = pg * inv, w2 = pg * p2 * inv;
            const int e1 = gs * 8 + i1, e2 = gs * 8 + i2;
            u32* ecnt = (u32*)(ws + WS_CTL) + CW_ECNT + l * 32;
            int* elist = (int*)(ws + WS_ELIST);
            float* sw = (float*)(ws + WS_SLOTW);
            const u32 p1 = atomicAdd(ecnt + e1, 1u); elist[(size_t)e1 * NSLOT + p1] = tok * 2;
            const u32 p2i = atomicAdd(ecnt + e2, 1u); elist[(size_t)e2 * NSLOT + p2i] = tok * 2 + 1;
            sw[tok * 2] = w1; sw[tok * 2 + 1] = w2;
        }
        __syncthreads();
    }
}
__device__ __forceinline__ void phase_combine(const P& p, int l, int gw, int NGW, int lane, bool dry = false) {
    float* X = (float*)(p.ws + WS_X); bf16* XB = (bf16*)(p.ws + WS_XB); float* RS = (float*)(p.ws + WS_RSTD);
    const bf16* YS = (const bf16*)(p.ws + WS_YS);
    for (int m = gw; m < T; m += NGW) {
        float4 v[4]; float s = 0.f;
#pragma unroll
        for (int j = 0; j < 4; ++j) {
            v[j] = ((const float4*)(X + (size_t)m * D) + lane)[64 * j];
            const uint2 a = ((const uint2*)(YS + (size_t)(2 * m) * D) + lane)[64 * j], b = ((const uint2*)(YS + (size_t)(2 * m + 1) * D) + lane)[64 * j];
            v[j].x += blo(a.x) + blo(b.x); v[j].y += bhi(a.x) + bhi(b.x); v[j].z += blo(a.y) + blo(b.y); v[j].w += bhi(a.y) + bhi(b.y);
            s += v[j].x * v[j].x + v[j].y * v[j].y + v[j].z * v[j].z + v[j].w * v[j].w;
        }
        s = wave_sum(s);
        const float rs = rsqrtf(s * (1.f / D) + EPS);
        if (dry) { if (rs == 123.f) RS[m] = rs; }
        else if (l == DEPTH - 1) {
#pragma unroll
            for (int j = 0; j < 4; ++j) {
                const float4 g = ((const float4*)p.g_fin + lane)[64 * j];
                ((float4*)(p.out + (size_t)m * D) + lane)[64 * j] = make_float4(v[j].x * rs * g.x, v[j].y * rs * g.y, v[j].z * rs * g.z, v[j].w * rs * g.w);
            }
        } else {
            if (lane == 0) RS[m] = rs;
#pragma unroll
            for (int j = 0; j < 4; ++j) {
                ((float4*)(X + (size_t)m * D) + lane)[64 * j] = v[j];
                ((uint2*)(XB + (size_t)m * D) + lane)[64 * j] = make_uint2(pk2(v[j].x, v[j].y), pk2(v[j].z, v[j].w));
            }
        }
    }
}

namespace mix {
typedef short bf16x8 __attribute__((ext_vector_type(8)));
typedef short s16x4 __attribute__((ext_vector_type(4)));
typedef float f32x16 __attribute__((ext_vector_type(16)));
typedef float f32x4 __attribute__((ext_vector_type(4)));
typedef unsigned u32x4 __attribute__((ext_vector_type(4)));
constexpr int L_K = 0, L_V = 16384, SLOTB = 8192;
constexpr int L_WSF = 32768;
constexpr int L_FLAG = 36864;
constexpr int L_KM = 37888;
constexpr int L_OST = 40960, OST_W = 32 * 68 * 4;
constexpr int L_VNT = 40960, VNT_LD = 136;
static_assert(L_OST + 8 * OST_W <= RING_BYTES, "mixer LDS map");
constexpr float NEG_INF = -__builtin_inff();

__device__ __forceinline__ int crow(int r, int hi) { return (r & 3) + 8 * (r >> 2) + 4 * hi; }
__device__ __forceinline__ unsigned cvtpk(float lo, float hi) { unsigned r; asm volatile("v_cvt_pk_bf16_f32 %0, %1, %2" : "=v"(r) : "v"(lo), "v"(hi)); return r; }
__device__ __forceinline__ s16x4 vtr(const LAS unsigned char* p) { typedef short v4i16_t __attribute__((ext_vector_type(4))); return __builtin_bit_cast(s16x4, __builtin_amdgcn_ds_read_tr16_b64_v4i16((LAS v4i16_t*)p)); }

__device__ __forceinline__ void dma_tile(LAS unsigned char* lds, const bf16* Kh, const bf16* Vh, int key0, int slot, int wave, int lane) {
    const bf16* ks = Kh + (size_t)(key0 + lane) * INC + wave * 8;
    const bf16* vs = Vh + (size_t)(key0 + 16 * (wave & 3) + (lane >> 2)) * INC + (wave >> 2) * 32 + (lane & 3) * 8;
    __builtin_amdgcn_global_load_lds((const unsigned*)ks, (LAS unsigned*)(lds + L_K + slot * SLOTB + wave * 1024), 16, 0, 0);
    __builtin_amdgcn_global_load_lds((const unsigned*)vs, (LAS unsigned*)(lds + L_V + slot * SLOTB + wave * 1024), 16, 0, 0);
}
__device__ __forceinline__ void qkt(f32x16& p0, f32x16& p1, const LAS unsigned char* kslot, const bf16x8 (&qr)[4], int r32, int hi) {
    const LAS unsigned char* kb = kslot + hi * 1024 + r32 * 16;
    p0 = (f32x16){0.f, 0.f, 0.f, 0.f, 0.f, 0.f, 0.f, 0.f, 0.f, 0.f, 0.f, 0.f, 0.f, 0.f, 0.f, 0.f}; p1 = p0;
#pragma unroll
    for (int d0 = 0; d0 < 4; ++d0) {
        const bf16x8 b0 = *(const LAS bf16x8*)(kb + d0 * 2048), b1 = *(const LAS bf16x8*)(kb + d0 * 2048 + 512);
        p0 = __builtin_amdgcn_mfma_f32_32x32x16_bf16(b0, qr[d0], p0, 0, 0, 0);
        p1 = __builtin_amdgcn_mfma_f32_32x32x16_bf16(b1, qr[d0], p1, 0, 0, 0);
    }
}
__device__ __forceinline__ void pv(f32x16 (&o)[2], const LAS unsigned char* vslot, const u32x4 (&pa)[4], int lane) {
    const int hi = lane >> 5;
    const LAS unsigned char* vp = vslot + ((lane >> 4) & 1) * 32 + (lane & 3) * 8 + (4 * hi + ((lane & 15) >> 2)) * 64;
#pragma unroll
    for (int d0 = 0; d0 < 2; ++d0)
#pragma unroll
        for (int ks = 0; ks < 4; ++ks) {
            const s16x4 lo = vtr(vp + d0 * 4096 + ks * 1024), hh = vtr(vp + d0 * 4096 + ks * 1024 + 512);
            const bf16x8 vb = (bf16x8){lo[0], lo[1], lo[2], lo[3], hh[0], hh[1], hh[2], hh[3]};
            o[d0] = __builtin_amdgcn_mfma_f32_32x32x16_bf16(__builtin_bit_cast(bf16x8, pa[ks]), vb, o[d0], 0, 0, 0);
        }
}
__device__ __forceinline__ void pack_p(u32x4 (&pa)[4], const f32x16& p0, const f32x16& p1) {
#pragma unroll
    for (int s = 0; s < 2; ++s) {
        pa[s] = (u32x4){cvtpk(p0[8 * s + 0], p0[8 * s + 1]), cvtpk(p0[8 * s + 2], p0[8 * s + 3]), cvtpk(p0[8 * s + 4], p0[8 * s + 5]), cvtpk(p0[8 * s + 6], p0[8 * s + 7])};
        pa[2 + s] = (u32x4){cvtpk(p1[8 * s + 0], p1[8 * s + 1]), cvtpk(p1[8 * s + 2], p1[8 * s + 3]), cvtpk(p1[8 * s + 4], p1[8 * s + 5]), cvtpk(p1[8 * s + 6], p1[8 * s + 7])};
    }
}
__device__ __forceinline__ void store_headnorm(LAS unsigned char* lds, const f32x16 (&o)[2], const LAS float* qs  , const float* gh  , bf16* onrow0  , int wave, int lane) {
    const int r32 = lane & 31, hi = lane >> 5;
    LAS float* st = (LAS float*)(lds + L_OST + wave * OST_W);
#pragma unroll
    for (int r = 0; r < 16; ++r) {
        const int q = crow(r, hi); const float s = qs ? qs[q] : 1.f;
        st[q * 68 + r32] = o[0][r] * s; st[q * 68 + 32 + r32] = o[1][r] * s;
    }
    LDS_WAIT();
    const int q = lane >> 1, part = lane & 1;
    f32x4 x[8]; float ss = 0.f;
#pragma unroll
    for (int i = 0; i < 8; ++i) { x[i] = *(const LAS f32x4*)(st + q * 68 + part * 32 + i * 4); ss += x[i][0] * x[i][0] + x[i][1] * x[i][1] + x[i][2] * x[i][2] + x[i][3] * x[i][3]; }
    ss += __shfl_xor(ss, 1);
    const float rs = rsqrtf(ss * (1.f / 64.f) + EPS);
    bf16* dst = onrow0 + (size_t)q * D + part * 32;
#pragma unroll
    for (int i = 0; i < 4; ++i) {
        const f32x4 g0 = *(const f32x4*)(gh + part * 32 + i * 8), g1 = *(const f32x4*)(gh + part * 32 + i * 8 + 4);
        const f32x4 a = x[2 * i] * rs * g0, b = x[2 * i + 1] * rs * g1;
        *(u32x4*)(dst + i * 8) = (u32x4){cvtpk(a[0], a[1]), cvtpk(a[2], a[3]), cvtpk(b[0], b[1]), cvtpk(b[2], b[3])};
    }
    LDS_WAIT();
}

__device__ __forceinline__ void moba_unit(LAS unsigned char* lds, const bf16* PR, bf16* ON, const float* KMP, const float* gh, int b, int h, int qb, int wave_, int lane_) {
    int wave = wave_; asm volatile("" : "+s"(wave)); const int lane = lane_id_opaque();
    const int r32 = lane & 31, hi = lane >> 5, tid = wave * 64 + lane;
    const size_t rowbase = (size_t)b * SEQ;
    const bf16* Qw = PR + (rowbase + qb * 256 + wave * 32) * INC + C_QB + h * 64;
    const bf16* Kh = PR + rowbase * INC + C_KB + h * 64; const bf16* Vh = PR + rowbase * INC + C_VB + h * 64;
    LAS float* km = (LAS float*)(lds + L_KM);
    LAS float* wsf = (LAS float*)(lds + L_WSF) + wave * 128;
    __syncthreads();
    dma_tile(lds, Kh, Vh, 0, 0, wave, lane);
    { const size_t o = ((size_t)(b * 8 + h) * 8) * 64 + tid; km[tid] = KMP[o] + KMP[(size_t)BATCH * 8 * 8 * 64 + o]; }
    bf16x8 qr[4];
#pragma unroll
    for (int ks = 0; ks < 4; ++ks) qr[ks] = *(const bf16x8*)(Qw + (size_t)r32 * INC + ks * 16 + hi * 8);
    __syncthreads();
    unsigned selmask = 0;
    {
        float b1 = NEG_INF, b2 = NEG_INF, b3 = NEG_INF; int i1 = -1, i2 = -1, i3 = -1;
#pragma unroll 1
        for (int j = 0; j < qb; ++j) {
            float s = 0.f;
#pragma unroll
            for (int ks = 0; ks < 4; ++ks)
#pragma unroll
                for (int e = 0; e < 8; ++e) s += bf2f((bf16)qr[ks][e]) * km[j * 64 + ks * 16 + hi * 8 + e];
            s += __shfl_xor(s, 32);
            if (s > b1) { b3 = b2; i3 = i2; b2 = b1; i2 = i1; b1 = s; i1 = j; }
            else if (s > b2) { b3 = b2; i3 = i2; b2 = s; i2 = j; }
            else if (s > b3) { b3 = s; i3 = j; }
        }
        if (i1 >= 0) selmask |= 1u << i1;
        if (i2 >= 0) selmask |= 1u << i2;
        if (i3 >= 0) selmask |= 1u << i3;
    }
    unsigned wneed = 0;
#pragma unroll
    for (int j = 0; j < 8; ++j) if (__any((selmask >> j) & 1u)) wneed |= 1u << j;
    wneed = __builtin_amdgcn_readfirstlane(wneed);
    float m = -1e30f, l = 0.f; f32x16 o[2];
    o[0] = (f32x16){0.f, 0.f, 0.f, 0.f, 0.f, 0.f, 0.f, 0.f, 0.f, 0.f, 0.f, 0.f, 0.f, 0.f, 0.f, 0.f}; o[1] = o[0];
    const int NT = 4 * (qb + 1);
    const float SC = 0.125f * 1.4426950408889634f;
    for (int tt = 0; tt < NT; ++tt) {
        asm volatile("s_waitcnt vmcnt(0)" ::: "memory");
        __syncthreads();
        if (tt + 1 < NT) dma_tile(lds, Kh, Vh, 64 * (tt + 1), (tt + 1) & 1, wave, lane);
        const int blk = tt >> 2; const bool own = blk == qb;
        const bool act = own ? ((tt & 3) <= (wave >> 1)) : ((wneed >> blk) & 1u);
        if (act) {
            f32x16 p0, p1;
            qkt(p0, p1, lds + L_K + (tt & 1) * SLOTB, qr, r32, hi);
            const bool selme = (selmask >> blk) & 1u;
            const int qrel = 32 * wave + r32 - 64 * (tt & 3);
            float rm = NEG_INF;
#pragma unroll
            for (int r = 0; r < 16; ++r) {
                const int kk = crow(r, hi);
                const bool v0 = own ? (kk <= qrel) : selme, v1 = own ? (kk + 32 <= qrel) : selme;
                p0[r] = v0 ? p0[r] * SC : NEG_INF; p1[r] = v1 ? p1[r] * SC : NEG_INF;
                rm = fmaxf(rm, fmaxf(p0[r], p1[r]));
            }
            rm = fmaxf(rm, __shfl_xor(rm, 32));
            const float mn = fmaxf(m, rm), alpha = __builtin_amdgcn_exp2f(m - mn);
            m = mn;
            float rs = 0.f;
#pragma unroll
            for (int r = 0; r < 16; ++r) { p0[r] = __builtin_amdgcn_exp2f(p0[r] - mn); p1[r] = __builtin_amdgcn_exp2f(p1[r] - mn); rs += p0[r] + p1[r]; }
            rs += __shfl_xor(rs, 32);
            l = l * alpha + rs;
            if (__any(alpha != 1.f)) {
                if (hi == 0) wsf[r32] = alpha;
                LDS_WAIT();
#pragma unroll
                for (int r = 0; r < 16; ++r) { const float a = wsf[crow(r, hi)]; o[0][r] *= a; o[1][r] *= a; }
            }
            u32x4 pa[4]; pack_p(pa, p0, p1);
            pv(o, lds + L_V + (tt & 1) * SLOTB, pa, lane);
        }
    }
    if (hi == 0) wsf[32 + r32] = 1.f / l;
    LDS_WAIT();
    store_headnorm(lds, o, wsf + 32, gh, ON + (rowbase + qb * 256 + wave * 32) * D + 256 + h * 64, wave, lane);
}

__device__ __forceinline__ void sb_unit(LAS unsigned char* lds, const bf16* PR, bf16* ON, const float* gh, int b, int h, int qb, int wave_, int lane_) {
    int wave = wave_; asm volatile("" : "+s"(wave)); const int lane = lane_id_opaque();
    const int r32 = lane & 31, hi = lane >> 5;
    const size_t rowbase = (size_t)b * SEQ;
    const bf16* Qw = PR + (rowbase + qb * 256 + wave * 32) * INC + C_QA + h * 64;
    const bf16* Kh = PR + rowbase * INC + C_KA + h * 64; const bf16* Vh = PR + rowbase * INC + C_VA + h * 64;
    volatile LAS int* flag = (volatile LAS int*)(lds + L_FLAG);
    __syncthreads();
    const int jt0 = 4 * qb + 3, jtd = 4 * qb + (wave >> 1);
    dma_tile(lds, Kh, Vh, 64 * jt0, 0, wave, lane);
    bf16x8 qr[4];
#pragma unroll
    for (int ks = 0; ks < 4; ++ks) qr[ks] = *(const bf16x8*)(Qw + (size_t)r32 * INC + ks * 16 + hi * 8);
    float L = 0.f; f32x16 o[2];
    o[0] = (f32x16){0.f, 0.f, 0.f, 0.f, 0.f, 0.f, 0.f, 0.f, 0.f, 0.f, 0.f, 0.f, 0.f, 0.f, 0.f, 0.f}; o[1] = o[0];
    bool active = true;
    for (int step = 0;; ++step) {
        const int jt = jt0 - step;
        asm volatile("s_waitcnt vmcnt(0)" ::: "memory");
        __syncthreads();
        if (step > 0) { int any = 0;
#pragma unroll
            for (int w = 0; w < 8; ++w) any |= flag[((step - 1) & 1) * 8 + w];
            if (!any) break; }
        if (jt < 0) break;
        if (jt > 0) dma_tile(lds, Kh, Vh, 64 * (jt - 1), (step + 1) & 1, wave, lane);
        if (active && jt <= jtd) {
            f32x16 p0, p1;
            qkt(p0, p1, lds + L_K + (step & 1) * SLOTB, qr, r32, hi);
            const int trel = 256 * qb + 32 * wave + r32 - 64 * jt;
            float gs[8];
#pragma unroll
            for (int k = 0; k < 8; ++k) gs[k] = 0.f;
            f32x16 q0, q1;
#pragma unroll
            for (int r = 0; r < 16; ++r) {
                const int kk = crow(r, hi);
                { const float z = p0[r] * 0.125f, l1p = __logf(1.f + __expf(-fabsf(z))); const bool v = kk < trel;
                  q0[r] = v ? fminf(-z, 0.f) - l1p : 0.f; p0[r] = v ? fminf(z, 0.f) - l1p : NEG_INF; gs[r >> 2] += q0[r]; }
                { const float z = p1[r] * 0.125f, l1p = __logf(1.f + __expf(-fabsf(z))); const bool v = kk + 32 < trel;
                  q1[r] = v ? fminf(-z, 0.f) - l1p : 0.f; p1[r] = v ? fminf(z, 0.f) - l1p : NEG_INF; gs[4 + (r >> 2)] += q1[r]; }
            }
            float aft[8]; float run = 0.f;
#pragma unroll
            for (int k = 7; k >= 0; --k) { const float og = __shfl_xor(gs[k], 32); aft[k] = run + (hi == 0 ? og : 0.f); run += gs[k] + og; }
#pragma unroll
            for (int k = 0; k < 4; ++k) {
                float a = L + aft[k];
                p0[4 * k + 3] = __expf(p0[4 * k + 3] + a); a += q0[4 * k + 3];
                p0[4 * k + 2] = __expf(p0[4 * k + 2] + a); a += q0[4 * k + 2];
                p0[4 * k + 1] = __expf(p0[4 * k + 1] + a); a += q0[4 * k + 1];
                p0[4 * k + 0] = __expf(p0[4 * k + 0] + a);
                float c = L + aft[4 + k];
                p1[4 * k + 3] = __expf(p1[4 * k + 3] + c); c += q1[4 * k + 3];
                p1[4 * k + 2] = __expf(p1[4 * k + 2] + c); c += q1[4 * k + 2];
                p1[4 * k + 1] = __expf(p1[4 * k + 1] + c); c += q1[4 * k + 1];
                p1[4 * k + 0] = __expf(p1[4 * k + 0] + c);
            }
            L += run;
            u32x4 pa[4]; pack_p(pa, p0, p1);
            pv(o, lds + L_V + (step & 1) * SLOTB, pa, lane);
            if (__all(L < -88.f)) active = false;
        }
        if (lane == 0) flag[(step & 1) * 8 + wave] = (active && jt > 0) ? 1 : 0;
    }
    store_headnorm(lds, o, nullptr, gh, ON + (rowbase + qb * 256 + wave * 32) * D + h * 64, wave, lane);
}

__device__ __forceinline__ void gmlp_unit(LAS unsigned char* lds, const bf16* PR, bf16* ON, const float* gvn  , const float* wsp  , const float* bsp  , const float* gh  , int b, int c, int g, int wave_, int lane_) {
    int wave = wave_; asm volatile("" : "+s"(wave)); const int lane = lane_id_opaque();
    const int tid = wave * 64 + lane;
    const size_t row0 = (size_t)b * SEQ + c * 128;
    LAS bf16* vnT = (LAS bf16*)(lds + L_VNT);
    __syncthreads();
    {
        const int s = tid >> 2, part = tid & 3;
        const bf16* vr = PR + (row0 + s) * INC + C_VC + g * 64 + part * 16;
        const uint4 a = *(const uint4*)vr, bq = *(const uint4*)(vr + 8);
        float x[16] = {blo(a.x), bhi(a.x), blo(a.y), bhi(a.y), blo(a.z), bhi(a.z), blo(a.w), bhi(a.w), blo(bq.x), bhi(bq.x), blo(bq.y), bhi(bq.y), blo(bq.z), bhi(bq.z), blo(bq.w), bhi(bq.w)};
        float ss = 0.f;
#pragma unroll
        for (int i = 0; i < 16; ++i) ss += x[i] * x[i];
        ss += __shfl_xor(ss, 1); ss += __shfl_xor(ss, 2);
        const float rs = rsqrtf(ss * (1.f / 64.f) + EPS);
#pragma unroll
        for (int i = 0; i < 16; ++i) vnT[(part * 16 + i) * VNT_LD + s] = f2bf(x[i] * rs * gvn[part * 16 + i]);
    }
    __syncthreads();
    const int fr = lane & 15, fq = lane >> 4, t = 16 * wave + fr;
    f32x4 acc[4] = {{0.f, 0.f, 0.f, 0.f}, {0.f, 0.f, 0.f, 0.f}, {0.f, 0.f, 0.f, 0.f}, {0.f, 0.f, 0.f, 0.f}};
    const int nks = (wave >> 1) + 1;
    for (int ks = 0; ks < nks; ++ks) {
        const int s0 = 32 * ks + 8 * fq;
        const f32x4 w0 = *(const f32x4*)(wsp + (size_t)t * 128 + s0), w1 = *(const f32x4*)(wsp + (size_t)t * 128 + s0 + 4);
        float wv[8] = {w0[0], w0[1], w0[2], w0[3], w1[0], w1[1], w1[2], w1[3]};
#pragma unroll
        for (int j = 0; j < 8; ++j) if (s0 + j > t) wv[j] = 0.f;
        const u32x4 au = (u32x4){cvtpk(wv[0], wv[1]), cvtpk(wv[2], wv[3]), cvtpk(wv[4], wv[5]), cvtpk(wv[6], wv[7])};
#pragma unroll
        for (int n = 0; n < 4; ++n) {
            const bf16x8 bv = *(const LAS bf16x8*)(vnT + (16 * n + fr) * VNT_LD + s0);
            acc[n] = __builtin_amdgcn_mfma_f32_16x16x32_bf16(__builtin_bit_cast(bf16x8, au), bv, acc[n], 0, 0, 0);
        }
    }
    __syncthreads();
    LAS float* st = (LAS float*)(lds + L_OST + wave * OST_W);
#pragma unroll
    for (int reg = 0; reg < 4; ++reg) {
        const int tl = 4 * fq + reg, tt = 16 * wave + tl; const float bb = bsp[tt];
#pragma unroll
        for (int n = 0; n < 4; ++n) st[tl * 68 + 16 * n + fr] = acc[n][reg] + bb;
    }
    LDS_WAIT();
    {
        const int tl = lane >> 2, part = lane & 3, tt = 16 * wave + tl;
        const bf16* ur = PR + (row0 + tt) * INC + C_UC + g * 64 + part * 16;
        const uint4 ua = *(const uint4*)ur, ub = *(const uint4*)(ur + 8);
        const float u[16] = {blo(ua.x), bhi(ua.x), blo(ua.y), bhi(ua.y), blo(ua.z), bhi(ua.z), blo(ua.w), bhi(ua.w), blo(ub.x), bhi(ub.x), blo(ub.y), bhi(ub.y), blo(ub.z), bhi(ub.z), blo(ub.w), bhi(ub.w)};
        float v[16]; float ss = 0.f;
#pragma unroll
        for (int i = 0; i < 4; ++i) { const f32x4 m4 = *(const LAS f32x4*)(st + tl * 68 + part * 16 + i * 4);
#pragma unroll
            for (int j = 0; j < 4; ++j) { v[4 * i + j] = u[4 * i + j] * m4[j]; ss += v[4 * i + j] * v[4 * i + j]; } }
        ss += __shfl_xor(ss, 1); ss += __shfl_xor(ss, 2);
        const float rs = rsqrtf(ss * (1.f / 64.f) + EPS);
        bf16* dst = ON + (row0 + tt) * D + 768 + g * 64 + part * 16;
#pragma unroll
        for (int i = 0; i < 2; ++i) {
            const f32x4 g0 = *(const f32x4*)(gh + part * 16 + i * 8), g1 = *(const f32x4*)(gh + part * 16 + i * 8 + 4);
            *(u32x4*)(dst + i * 8) = (u32x4){cvtpk(v[8 * i + 0] * rs * g0[0], v[8 * i + 1] * rs * g0[1]), cvtpk(v[8 * i + 2] * rs * g0[2], v[8 * i + 3] * rs * g0[3]),
                                             cvtpk(v[8 * i + 4] * rs * g1[0], v[8 * i + 5] * rs * g1[1]), cvtpk(v[8 * i + 6] * rs * g1[2], v[8 * i + 7] * rs * g1[3])};
        }
    }
    LDS_WAIT();
}
}
__device__ __forceinline__ const void* lptr(LAS unsigned char* lds, int k) {
    const unsigned long long v = ((const LAS unsigned long long*)(lds + LDS_PTRS))[k];
    const unsigned lo = __builtin_amdgcn_readfirstlane((unsigned)v), hi = __builtin_amdgcn_readfirstlane((unsigned)(v >> 32));
    return (const void*)(((unsigned long long)hi << 32) | lo);
}
__device__ __forceinline__ P load_params(LAS unsigned char* lds, unsigned char* ws) {
    P q;
    q.x = (const float*)lptr(lds, 0); q.pos = (const int*)lptr(lds, 1); q.w_in = (const float*)lptr(lds, 2); q.w_out = (const float*)lptr(lds, 3);
    q.g_mix = (const float*)lptr(lds, 4); q.g_head = (const float*)lptr(lds, 5); q.g_vn = (const float*)lptr(lds, 6); q.w_sp = (const float*)lptr(lds, 7);
    q.b_sp = (const float*)lptr(lds, 8); q.g_ffn = (const float*)lptr(lds, 9); q.w_rg = (const float*)lptr(lds, 10); q.w_re = (const float*)lptr(lds, 11);
    q.w_g = (const float*)lptr(lds, 12); q.w_u = (const float*)lptr(lds, 13); q.w_d = (const float*)lptr(lds, 14); q.g_fin = (const float*)lptr(lds, 15);
    q.out = (float*)lptr(lds, 16); q.ws = ws;
    return q;
}
#ifndef REP_P
#define REP_P 1
#endif
#ifndef REP_A
#define REP_A 1
#endif
#ifndef REP_B
#define REP_B 1
#endif
#ifndef REP_E
#define REP_E 1
#endif
#ifndef REP_F
#define REP_F 1
#endif
#ifndef REP_D
#define REP_D 1
#endif
#ifndef REP_G
#define REP_G 1
#endif
#ifndef REP_C
#define REP_C 1
#endif
constexpr int NSTEPS = 1 + 7 * DEPTH;
__global__ void __launch_bounds__(NWAVES * 64, 2) mk(P p, int s_lo, int s_hi, int bar_region, int mix_mask) {
    extern __shared__ __attribute__((aligned(16))) unsigned char lds_raw[];
    LAS unsigned char* lds = (LAS unsigned char*)lds_raw;
    const int wave = __builtin_amdgcn_readfirstlane(threadIdx.x >> 6);
    const int G = gridDim.x, bx = blockIdx.x;
    const int vcu = (G % 8 == 0) ? (bx % 8) * (G / 8) + bx / 8 : bx;
    const int gw = vcu * NWAVES + wave, NGW = G * NWAVES;
    unsigned char* ws = p.ws;
    volatile LAS unsigned* misc = (volatile LAS unsigned*)(lds + LDS_MISC);
    if (threadIdx.x < 4) misc[threadIdx.x] = 0u;
    if (threadIdx.x == 0) {
        LAS unsigned long long* pp = (LAS unsigned long long*)(lds + LDS_PTRS);
        pp[0] = (unsigned long long)p.x; pp[1] = (unsigned long long)p.pos; pp[2] = (unsigned long long)p.w_in; pp[3] = (unsigned long long)p.w_out;
        pp[4] = (unsigned long long)p.g_mix; pp[5] = (unsigned long long)p.g_head; pp[6] = (unsigned long long)p.g_vn; pp[7] = (unsigned long long)p.w_sp;
        pp[8] = (unsigned long long)p.b_sp; pp[9] = (unsigned long long)p.g_ffn; pp[10] = (unsigned long long)p.w_rg; pp[11] = (unsigned long long)p.w_re;
        pp[12] = (unsigned long long)p.w_g; pp[13] = (unsigned long long)p.w_u; pp[14] = (unsigned long long)p.w_d; pp[15] = (unsigned long long)p.g_fin;
        pp[16] = (unsigned long long)p.out;
    }
    __syncthreads();
    XcdBarrier bar = xcd_barrier_post((unsigned*)(ws + WS_CTL) + CW_BAR + bar_region * XCD_BAR_WORDS, misc);
#define IN(k) (s_lo <= (k) && (k) < s_hi)
#define SEAM(k) do { if (IN(k) && IN((k) + 1)) xcd_barrier(bar, wave == 0 && lane_id_opaque() == 0); } while (0)

#define OPQ_WS(name) unsigned char* name = ws; asm volatile("" : "+s"(name))
#define OPQ_LDS(name) LAS unsigned char* name = lds; asm volatile("" : "+s"(name))
#define OPQ_LANE(name) const int name = lane_id_opaque()
    if (IN(0)) for (int rep = 0; rep < REP_P; ++rep) { OPQ_WS(w); OPQ_LDS(ld); OPQ_LANE(ln); const P q = load_params(ld, w); phase_prologue(q, ld, gw, NGW, wave, ln); __syncthreads(); }
    SEAM(0);
#pragma unroll 1
    for (int l = 0; l < DEPTH; ++l) {
        const int s0 = 1 + 7 * l;
        if (IN(s0 + 0)) for (int rep = 0; rep < REP_A; ++rep) {
            OPQ_WS(w); OPQ_LDS(ld);
            pg8::StaticOrder S; S.init(T, INC, G, bx, (const bf16*)(w + WS_WIN) + (size_t)l * INC * D);
            pg8::EpiInProj E{(bf16*)(w + WS_PROJ), (const float*)(w + WS_RSTD), (const float*)(w + WS_ROPE), (float*)(w + WS_KMEAN)};
            pg8::gemm_phase<pg8::EpiInProj, pg8::StaticOrder, true>(ld, (const bf16*)(w + WS_XB), D, S, E, wave);
        }
        SEAM(s0 + 0);
        if (IN(s0 + 1)) for (int rep = 0; rep < REP_B; ++rep) {
            OPQ_WS(w); OPQ_LDS(ld); OPQ_LANE(ln);
            int wv = wave; asm volatile("" : "+s"(wv));
            const bf16* PR = (const bf16*)(w + WS_PROJ); bf16* ON = (bf16*)(w + WS_ON);
            const float* ghead = (const float*)lptr(ld, 5) + (size_t)l * 16 * 64;
            if (mix_mask & 1) {
                for (int u = vcu; u < 256; u += G) {
                    const int bh = u >> 2, i = u & 3;
                    mix::moba_unit(ld, PR, ON, (const float*)(w + WS_KMEAN), ghead + (4 + (bh & 7)) * 64, bh >> 3, bh & 7, 7 - i, wv, ln);
                    mix::moba_unit(ld, PR, ON, (const float*)(w + WS_KMEAN), ghead + (4 + (bh & 7)) * 64, bh >> 3, bh & 7, i, wv, ln);
                }
            }
            if (mix_mask & 2) {
                for (int u = vcu; u < 256; u += G) mix::sb_unit(ld, PR, ON, ghead + ((u >> 3) & 3) * 64, u >> 5, (u >> 3) & 3, u & 7, wv, ln);
            }
            if (mix_mask & 4) {
                const float* gvn = (const float*)lptr(ld, 6) + (size_t)l * 4 * 64;
                const float* wsp = (const float*)lptr(ld, 7) + (size_t)l * 4 * 128 * 128;
                const float* bsp = (const float*)lptr(ld, 8) + (size_t)l * 4 * 128;
                for (int u = vcu; u < 512; u += G) {
                    const int g = u & 3, c = (u >> 2) & 15, b = u >> 6;
                    mix::gmlp_unit(ld, PR, ON, gvn + g * 64, wsp + (size_t)g * 128 * 128, bsp + g * 128, ghead + (12 + g) * 64, b, c, g, wv, ln);
                }
            }
            __syncthreads();
        }
        SEAM(s0 + 1);
        if (IN(s0 + 2)) for (int rep = 0; rep < REP_C; ++rep) {
            OPQ_WS(w); OPQ_LDS(ld);
            pg8::StaticOrder S; S.init(T, D, G, bx, (const bf16*)(w + WS_WOUT) + (size_t)l * D * D);
            pg8::EpiOutProj E{(float*)(w + WS_X), (bf16*)(w + WS_XB), rep + s_lo < REP_C - 1};
            pg8::gemm_phase<pg8::EpiOutProj, pg8::StaticOrder, false>(ld, (const bf16*)(w + WS_ON), D, S, E, wave);
        }
        SEAM(s0 + 2);
        if (IN(s0 + 3)) {
            OPQ_WS(w); OPQ_LDS(ld); OPQ_LANE(ln);
            int wv = wave; asm volatile("" : "+s"(wv));
            for (int rep = 0; rep < REP_D; ++rep) phase_router(w, ld, l, vcu, G, wv, ln, rep + s_lo < REP_D - 1);
        }
        SEAM(s0 + 3);
        if (IN(s0 + 4) || IN(s0 + 5)) {
            { OPQ_WS(w); OPQ_LDS(ld);
              LAS int* tbl = (LAS int*)(ld + LDS_TBL);
              __syncthreads();
              if (wave == 0 && lane_id_opaque() == 0) {
                  const u32* ecnt = (const u32*)(w + WS_CTL) + CW_ECNT + l * 32; int base = 0;
                  for (int e = 0; e < NE; ++e) { const int c = (int)__hip_atomic_load(ecnt + e, __ATOMIC_RELAXED, __HIP_MEMORY_SCOPE_AGENT); tbl[e] = base; tbl[33 + e] = c; base += (c + 255) >> 8; }
                  tbl[32] = base;
              }
              __syncthreads(); }
            if (IN(s0 + 4)) for (int rep = 0; rep < REP_E; ++rep) {
                OPQ_WS(w); OPQ_LDS(ld);
                pg8::MoeOrder<true, 4> S{(const LAS int*)(ld + LDS_TBL), (const int*)(w + WS_ELIST), (const bf16*)(w + WS_WGU) + (size_t)l * NE * 1024 * 1024, (size_t)1024 * 1024, G, bx};
                pg8::EpiMoe1 E{(bf16*)(w + WS_ABUF), (const float*)(w + WS_RSTD2), (const int*)(w + WS_ELIST)};
                pg8::gemm_phase<pg8::EpiMoe1, pg8::MoeOrder<true, 4>, true>(ld, (const bf16*)(w + WS_XB), D, S, E, wave);
            }
            SEAM(s0 + 4);
            if (IN(s0 + 5)) for (int rep = 0; rep < REP_F; ++rep) {
                OPQ_WS(w); OPQ_LDS(ld);
                pg8::MoeOrder<false, 4> S{(const LAS int*)(ld + LDS_TBL), (const int*)(w + WS_ELIST), (const bf16*)(w + WS_WD) + (size_t)l * NE * 1024 * 512, (size_t)1024 * 512, G, bx};
                pg8::EpiMoe2 E{(bf16*)(w + WS_YS), (const float*)(w + WS_SLOTW), (const int*)(w + WS_ELIST)};
                pg8::gemm_phase<pg8::EpiMoe2, pg8::MoeOrder<false, 4>, true>(ld, (const bf16*)(w + WS_ABUF), DE, S, E, wave);
            }
        }
        SEAM(s0 + 5);
        if (IN(s0 + 6)) { OPQ_WS(w); OPQ_LDS(ld); OPQ_LANE(ln); const P q = load_params(ld, w); for (int rep = 0; rep < REP_G; ++rep) phase_combine(q, l, gw, NGW, ln, rep + s_lo < REP_G - 1); }
        SEAM(s0 + 6);
    }
#undef IN
#undef SEAM
}

__global__ void k_kmean_naive(P p) {
    const int idx = blockIdx.x * blockDim.x + threadIdx.x;
    const int d = idx & 63, blk = (idx >> 6) & 7, h = (idx >> 9) & 7, b = idx >> 12;
    const bf16* PR = (const bf16*)(p.ws + WS_PROJ);
    float s = 0.f;
    for (int j = 0; j < 256; ++j) s += bf2f(PR[(size_t)(b * SEQ + blk * 256 + j) * INC + C_KB + h * 64 + d]);
    ((float*)(p.ws + WS_KMEAN + 262144))[idx] = s * (1.f / 256.f);
}
__global__ void __launch_bounds__(64) k_sb_naive(P p) {
    const int idx = blockIdx.x * 64 + threadIdx.x;
    const int t = idx % SEQ, h = (idx / SEQ) % 4, b = idx / (SEQ * 4);
    const bf16* PR = (const bf16*)(p.ws + WS_PROJ);
    const size_t row = (size_t)b * SEQ + t;
    uint4 q[8];
#pragma unroll
    for (int i = 0; i < 8; ++i) q[i] = *(const uint4*)(PR + row * INC + C_QA + h * 64 + i * 8);
    float acc[64];
#pragma unroll
    for (int i = 0; i < 64; ++i) acc[i] = 0.f;
    float L = 0.f;
    for (int s = t - 1; s >= 0; --s) {
        const bf16* kr = PR + ((size_t)b * SEQ + s) * INC + C_KA + h * 64;
        const bf16* vr = PR + ((size_t)b * SEQ + s) * INC + C_VA + h * 64;
        float z = 0.f;
#pragma unroll
        for (int i = 0; i < 8; ++i) z += dot8(q[i], *(const uint4*)(kr + i * 8));
        z *= 0.125f;
        const float l1p = log1pf(expf(-fabsf(z)));
        const float ls = fminf(z, 0.f) - l1p, lr = fminf(-z, 0.f) - l1p;
        const float w = expf(ls + L);
        L += lr;
#pragma unroll
        for (int i = 0; i < 8; ++i) {
            const uint4 vv = *(const uint4*)(vr + i * 8);
            acc[i * 8 + 0] += w * blo(vv.x); acc[i * 8 + 1] += w * bhi(vv.x); acc[i * 8 + 2] += w * blo(vv.y); acc[i * 8 + 3] += w * bhi(vv.y);
            acc[i * 8 + 4] += w * blo(vv.z); acc[i * 8 + 5] += w * bhi(vv.z); acc[i * 8 + 6] += w * blo(vv.w); acc[i * 8 + 7] += w * bhi(vv.w);
        }
    }
    float* O = (float*)(p.ws + WS_YS) + row * D + h * 64;
#pragma unroll
    for (int i = 0; i < 16; ++i) *(float4*)(O + i * 4) = make_float4(acc[i * 4], acc[i * 4 + 1], acc[i * 4 + 2], acc[i * 4 + 3]);
}
__global__ void __launch_bounds__(64) k_moba_naive(P p) {
    const int idx = blockIdx.x * 64 + threadIdx.x;
    const int t = idx % SEQ, h = (idx / SEQ) % 8, b = idx / (SEQ * 8);
    const bf16* PR = (const bf16*)(p.ws + WS_PROJ);
    const size_t row = (size_t)b * SEQ + t;
    const int own = t >> 8;
    uint4 q[8];
#pragma unroll
    for (int i = 0; i < 8; ++i) q[i] = *(const uint4*)(PR + row * INC + C_QB + h * 64 + i * 8);
    const float* KM = (const float*)(p.ws + WS_KMEAN + 262144) + ((size_t)(b * 8 + h) * 8) * 64;
    float g[8];
#pragma unroll
    for (int j = 0; j < 8; ++j) {
        float s = -1e30f;
        if (j < own) {
            s = 0.f;
#pragma unroll
            for (int i = 0; i < 8; ++i) {
                const float* km = KM + j * 64 + i * 8;
                s += blo(q[i].x) * km[0] + bhi(q[i].x) * km[1] + blo(q[i].y) * km[2] + bhi(q[i].y) * km[3] + blo(q[i].z) * km[4] + bhi(q[i].z) * km[5] + blo(q[i].w) * km[6] + bhi(q[i].w) * km[7];
            }
        }
        g[j] = s;
    }
    unsigned selmask = 0; const int nsel = own < 3 ? own : 3;
    for (int r = 0; r < nsel; ++r) {
        float best = -3e38f; int bi = 0;
#pragma unroll
        for (int j = 0; j < 8; ++j) { const bool ok = !((selmask >> j) & 1u) && g[j] > best; if (ok) { best = g[j]; bi = j; } }
        selmask |= 1u << bi;
    }
    float acc[64];
#pragma unroll
    for (int i = 0; i < 64; ++i) acc[i] = 0.f;
    float mx = -3e38f, lsum = 0.f;
    for (int blk = 0; blk <= own; ++blk) {
        if (blk < own && !((selmask >> blk) & 1u)) continue;
        const int s1 = blk == own ? t : blk * 256 + 255;
        for (int s = blk * 256; s <= s1; ++s) {
            const bf16* kr = PR + ((size_t)b * SEQ + s) * INC + C_KB + h * 64;
            const bf16* vr = PR + ((size_t)b * SEQ + s) * INC + C_VB + h * 64;
            float z = 0.f;
#pragma unroll
            for (int i = 0; i < 8; ++i) z += dot8(q[i], *(const uint4*)(kr + i * 8));
            z *= 0.125f;
            const float mn = fmaxf(mx, z), sc = expf(mx - mn), w = expf(z - mn);
            mx = mn; lsum = lsum * sc + w;
#pragma unroll
            for (int i = 0; i < 8; ++i) {
                const uint4 vv = *(const uint4*)(vr + i * 8);
                acc[i * 8 + 0] = acc[i * 8 + 0] * sc + w * blo(vv.x); acc[i * 8 + 1] = acc[i * 8 + 1] * sc + w * bhi(vv.x);
                acc[i * 8 + 2] = acc[i * 8 + 2] * sc + w * blo(vv.y); acc[i * 8 + 3] = acc[i * 8 + 3] * sc + w * bhi(vv.y);
                acc[i * 8 + 4] = acc[i * 8 + 4] * sc + w * blo(vv.z); acc[i * 8 + 5] = acc[i * 8 + 5] * sc + w * bhi(vv.z);
                acc[i * 8 + 6] = acc[i * 8 + 6] * sc + w * blo(vv.w); acc[i * 8 + 7] = acc[i * 8 + 7] * sc + w * bhi(vv.w);
            }
        }
    }
    const float il = 1.f / lsum;
    float* O = (float*)(p.ws + WS_YS) + row * D + 256 + h * 64;
#pragma unroll
    for (int i = 0; i < 16; ++i) *(float4*)(O + i * 4) = make_float4(acc[i * 4] * il, acc[i * 4 + 1] * il, acc[i * 4 + 2] * il, acc[i * 4 + 3] * il);
}
__global__ void k_gvn_naive(P p, int l) {
    const int idx = blockIdx.x * blockDim.x + threadIdx.x;
    const int g = idx & 3, t = idx >> 2;
    const bf16* v = (const bf16*)(p.ws + WS_PROJ) + (size_t)t * INC + C_VC + g * 64;
    float s = 0.f;
    for (int d = 0; d < 64; ++d) { const float x = bf2f(v[d]); s += x * x; }
    const float rs = rsqrtf(s * (1.f / 64.f) + EPS);
    float* o = (float*)(p.ws + WS_ABUF) + (size_t)t * 256 + g * 64;
    for (int d = 0; d < 64; ++d) o[d] = bf2f(v[d]) * rs * p.g_vn[(l * 4 + g) * 64 + d];
}
__global__ void k_gmlp_naive(P p, int l) {
    const int idx = blockIdx.x * blockDim.x + threadIdx.x;
    const int d = idx & 63, g = (idx >> 6) & 3, t = idx >> 8;
    const int tc = t & 127, t0 = t - tc;
    const float* VN = (const float*)(p.ws + WS_ABUF);
    const float* w = p.w_sp + ((size_t)(l * 4 + g) * 128 + tc) * 128;
    float s = 0.f;
    for (int j = 0; j <= tc; ++j) s += w[j] * VN[(size_t)(t0 + j) * 256 + g * 64 + d];
    s += p.b_sp[(l * 4 + g) * 128 + tc];
    const float u = bf2f(((const bf16*)(p.ws + WS_PROJ))[(size_t)t * INC + C_UC + g * 64 + d]);
    ((float*)(p.ws + WS_YS))[(size_t)t * D + 768 + g * 64 + d] = u * s;
}
__global__ void k_headnorm_naive(P p, int l) {
    const int idx = blockIdx.x * blockDim.x + threadIdx.x;
    const int h = idx & 15, t = idx >> 4;
    const float* o = (const float*)(p.ws + WS_YS) + (size_t)t * D + h * 64;
    float s = 0.f;
    for (int d = 0; d < 64; ++d) s += o[d] * o[d];
    const float rs = rsqrtf(s * (1.f / 64.f) + EPS);
    bf16* on = (bf16*)(p.ws + WS_ON) + (size_t)t * D + h * 64;
    for (int d = 0; d < 64; ++d) on[d] = f2bf(o[d] * rs * p.g_head[(l * 16 + h) * 64 + d]);
}

extern "C" void kernel_launch(void* const* d_in, const int* in_sizes, int n_in, void* d_out, int out_size, void* d_ws, size_t ws_size, hipStream_t stream) {
    static int grid = 0;
    if (grid == 0) {
        if (n_in != 16 || out_size != T * D || ws_size < WS_END) { fprintf(stderr, "kernel_launch: unexpected sizes (n_in %d out %d ws %zu)\n", n_in, out_size, ws_size); grid = -1; return; }
        int dev = 0, cus = 0, per_cu = 0;
        if (hipGetDevice(&dev) != hipSuccess || hipDeviceGetAttribute(&cus, hipDeviceAttributeMultiprocessorCount, dev) != hipSuccess) { grid = -1; return; }
        if (hipFuncSetAttribute((const void*)mk, hipFuncAttributeMaxDynamicSharedMemorySize, LDS_BYTES) != hipSuccess) { fprintf(stderr, "kernel_launch: hipFuncSetAttribute failed\n"); grid = -1; return; }
        if (hipOccupancyMaxActiveBlocksPerMultiprocessor(&per_cu, (const void*)mk, NWAVES * 64, LDS_BYTES) != hipSuccess || per_cu < 1) fprintf(stderr, "kernel_launch: occupancy query says %d\n", per_cu);
        (void)hipGetLastError();
        grid = cus;
    }
    if (grid < 0) return;
    P p{};
    p.x = (const float*)d_in[0]; p.pos = (const int*)d_in[1]; p.w_in = (const float*)d_in[2]; p.w_out = (const float*)d_in[3];
    p.g_mix = (const float*)d_in[4]; p.g_head = (const float*)d_in[5]; p.g_vn = (const float*)d_in[6]; p.w_sp = (const float*)d_in[7];
    p.b_sp = (const float*)d_in[8]; p.g_ffn = (const float*)d_in[9]; p.w_rg = (const float*)d_in[10]; p.w_re = (const float*)d_in[11];
    p.w_g = (const float*)d_in[12]; p.w_u = (const float*)d_in[13]; p.w_d = (const float*)d_in[14]; p.g_fin = (const float*)d_in[15];
    p.out = (float*)d_out; p.ws = (unsigned char*)d_ws;
    (void)hipMemsetAsync((char*)d_ws + WS_CTL, 0, CTL_BYTES, stream);
    int region = 0;
#ifndef NAIVE_MIX
#define NAIVE_MIX 0
#endif
#ifndef MIX_MASK
#define MIX_MASK 7
#endif
    auto launch = [&](int lo, int hi) { hipLaunchKernelGGL(mk, dim3(grid), dim3(NWAVES * 64), LDS_BYTES, stream, p, lo, hi, region, (int)MIX_MASK); ++region; };
#if NAIVE_MIX
    int lo = 0;
    for (int l = 0; l < DEPTH; ++l) {
        const int s0 = 1 + 7 * l;
        launch(lo, s0 + 1);
        k_kmean_naive<<<BATCH * 8 * 8 * 64 / 256, 256, 0, stream>>>(p);
        k_sb_naive<<<BATCH * 4 * SEQ / 64, 64, 0, stream>>>(p);
        k_moba_naive<<<BATCH * 8 * SEQ / 64, 64, 0, stream>>>(p);
        k_gvn_naive<<<T * 4 / 256, 256, 0, stream>>>(p, l);
        k_gmlp_naive<<<T * 256 / 256, 256, 0, stream>>>(p, l);
        k_headnorm_naive<<<T * 16 / 256, 256, 0, stream>>>(p, l);
        lo = s0 + 1;
    }
    launch(lo, NSTEPS);
#else
    launch(0, NSTEPS);
#endif
}
```

```cpp
#include <hip/hip_runtime.h>
#include <cstdint>
#include <cstdio>

constexpr int D = 1024, BATCH = 8, SEQ = 2048, T = BATCH * SEQ, DEPTH = 4;
constexpr int HD = 64;
constexpr int INC = 2816;
constexpr int C_QA = 0, C_KA = 256, C_VA = 512, C_QB = 768, C_KB = 1280, C_VB = 1792, C_UC = 2304, C_VC = 2560;
constexpr int NE = 32, EPG = 8, DE = 512;
constexpr int NSLOT = T * 2;
constexpr int MAXMT = 160;
constexpr float EPS = 1e-6f;

typedef unsigned short bf16;
typedef unsigned u32;
#define LAS __attribute__((address_space(3)))
#define GAS __attribute__((address_space(1)))

constexpr size_t MiB = 1u << 20;
constexpr size_t WS_CTL = 0, CTL_BYTES = 1 * MiB;
constexpr size_t WS_WR = 1 * MiB;
constexpr size_t WS_ROPE = 2 * MiB;
constexpr size_t WS_RSTD = 3 * MiB;
constexpr size_t WS_RSTD2 = WS_RSTD + 65536;
constexpr size_t WS_SLOTW = WS_RSTD2 + 65536;
constexpr size_t WS_KMEAN = WS_RSTD + 524288;
constexpr size_t WS_ELIST = 4 * MiB;
constexpr size_t WS_WIN = 8 * MiB;
constexpr size_t WS_WOUT = 30 * MiB;
constexpr size_t WS_WGU = 38 * MiB;
constexpr size_t WS_WD = 294 * MiB;
constexpr size_t WS_X = 422 * MiB;
constexpr size_t WS_XB = 486 * MiB;
constexpr size_t WS_PROJ = 518 * MiB;
constexpr size_t WS_ON = 606 * MiB;
constexpr size_t WS_ABUF = 638 * MiB;
constexpr size_t WS_YS = 678 * MiB;
constexpr size_t WS_END = 742 * MiB;
constexpr int CW_ECNT = 1024;
constexpr int CW_BAR = 4096;
constexpr int RING_BYTES = 131072;
constexpr int RT_LD = 2080;
constexpr int RT_IMG = 36 * RT_LD;
constexpr int LDS_CTL = 150528;
constexpr int LDS_TBL = LDS_CTL;
constexpr int LDS_MISC = LDS_CTL + 1024;
constexpr int LDS_PTRS = LDS_CTL + 2048;
constexpr int LDS_BYTES = 163840;
static_assert(2 * RT_IMG <= LDS_CTL && LDS_PTRS + 17 * 8 <= LDS_BYTES, "LDS map");
constexpr int NWAVES = 8;

struct P {
    const float* x; const int* pos; const float* w_in; const float* w_out; const float* g_mix; const float* g_head; const float* g_vn;
    const float* w_sp; const float* b_sp; const float* g_ffn; const float* w_rg; const float* w_re; const float* w_g; const float* w_u;
    const float* w_d; const float* g_fin; float* out; unsigned char* ws;
};

__device__ __forceinline__ bf16 f2bf(float f) { u32 u = __float_as_uint(f); return (bf16)((u + 0x7fffu + ((u >> 16) & 1u)) >> 16); }
__device__ __forceinline__ float bf2f(bf16 h) { return __uint_as_float((u32)h << 16); }
__device__ __forceinline__ u32 pk2(float lo, float hi) { return (u32)f2bf(lo) | ((u32)f2bf(hi) << 16); }
__device__ __forceinline__ float blo(u32 u) { return __uint_as_float(u << 16); }
__device__ __forceinline__ float bhi(u32 u) { return __uint_as_float(u & 0xffff0000u); }
__device__ __forceinline__ float wave_sum(float v) {
#pragma unroll
    for (int o = 1; o < 64; o <<= 1) v += __shfl_xor(v, o);
    return v;
}
__device__ __forceinline__ float dot8(uint4 a, uint4 b) {
    return blo(a.x) * blo(b.x) + bhi(a.x) * bhi(b.x) + blo(a.y) * blo(b.y) + bhi(a.y) * bhi(b.y) +
           blo(a.z) * blo(b.z) + bhi(a.z) * bhi(b.z) + blo(a.w) * blo(b.w) + bhi(a.w) * bhi(b.w);
}
__device__ __forceinline__ float gelu_tanh(float x) {
    const float u = 0.7978845608028654f * (x + 0.044715f * x * x * x);
    return x / (1.f + __expf(-2.f * u));
}
#define LDS_WAIT() asm volatile("s_waitcnt lgkmcnt(0)" ::: "memory")
__device__ __forceinline__ int lane_id_opaque() { int ln; asm volatile("v_mbcnt_lo_u32_b32 %0, -1, 0\n\tv_mbcnt_hi_u32_b32 %0, -1, %0" : "=v"(ln)); return ln; }

namespace pg8 {
typedef unsigned short bf16_t;
typedef short bf16x8 __attribute__((ext_vector_type(8)));
typedef float f32x4 __attribute__((ext_vector_type(4)));
typedef unsigned u32x4 __attribute__((ext_vector_type(4)));
typedef unsigned u32x2 __attribute__((ext_vector_type(2)));
constexpr int BM = 256, BK = 64, HALF = 128, HTB = HALF * BK * 2, STAGE_BYTES = 8 * HTB, NXCD = 8, WGM = 8;

__host__ __device__ __forceinline__ int lds_byte(int r, int c) { const int st = (r >> 4) * 2 + (c >> 5), rr = r & 15, cc = c & 31, ob = rr * 64 + cc * 2; return st * 1024 + (ob ^ (((ob >> 9) & 1) << 5)); }
__host__ __device__ __forceinline__ void stage_rc(int b, int& R, int& C) { const int st = b / 1024, sb = b % 1024, swz = sb ^ (((sb >> 9) & 1) << 5); R = (st >> 1) * 16 + swz / 64; C = (st & 1) * 32 + (swz % 64) / 2; }
__host__ __device__ __forceinline__ int perm32(int rho) { const int n = rho >> 4, i = rho & 15; return 8 * (i >> 2) + 4 * n + (i & 3); }

struct Unit { int pm, pn, e, r0, nvalid; };

struct StaticOrder {
    static constexpr bool GATHER = false;
    int nM, nN, nwg, G, c; const bf16_t* Bt;
    __device__ void init(int M, int N, int G_, int c_, const bf16_t* Bt_) { nM = M / BM; nN = N / BM; nwg = nM * nN; G = G_; c = c_; Bt = Bt_; }
    __device__ __forceinline__ bool next(int i, Unit& u) const {
        const long L = (long)i * G + c; if (L >= nwg) return false;
        int wgid = (int)L; { const int q = nwg / NXCD, r = nwg % NXCD, xcd = wgid % NXCD, off = wgid / NXCD; wgid = (xcd < r ? xcd * (q + 1) : r * (q + 1) + (xcd - r) * q) + off; }
        const int nig = WGM * nN, gid = wgid / nig, fm = gid * WGM, gsz = (nM - fm) < WGM ? (nM - fm) : WGM;
        u.pm = fm + ((wgid % nig) % gsz); u.pn = (wgid % nig) / gsz; u.e = 0; u.r0 = 0; u.nvalid = 256; return true;
    }
    __device__ __forceinline__ void a_offs(const Unit& u, int K, const int (&R)[2], const int (&C)[2], unsigned (&v)[2][2]) const {
#pragma unroll
        for (int h = 0; h < 2; ++h)
#pragma unroll
            for (int i = 0; i < 2; ++i) v[h][i] = (unsigned)((u.pm * BM + h * HALF + R[i]) * K + C[i]) * 2u;
    }
    __device__ __forceinline__ const char* b_ptr(const Unit& u, int K) const { return (const char*)(Bt + (size_t)u.pn * BM * K); }
};
template <bool GATHER_, int NN>
struct MoeOrder {
    static constexpr bool GATHER = GATHER_;
    const LAS int* tbl; const int* elist; const bf16_t* Bt; size_t estride; int G, c;
    __device__ __forceinline__ bool next(int i, Unit& u) const {
        const int L = i * G + c, nmt = tbl[32]; if (L >= nmt * NN) return false;
        const int mt = L / NN; u.pn = L % NN; u.pm = mt;
        int e = 0;
#pragma unroll 1
        while (tbl[e + 1] <= mt) ++e;
        u.e = e; u.r0 = (mt - tbl[e]) * 256; const int rem = tbl[33 + e] - u.r0; u.nvalid = rem < 256 ? rem : 256; return true;
    }
    __device__ __forceinline__ void a_offs(const Unit& u, int K, const int (&R)[2], const int (&C)[2], unsigned (&v)[2][2]) const {
#pragma unroll
        for (int h = 0; h < 2; ++h)
#pragma unroll
            for (int i = 0; i < 2; ++i) {
                const int r = h * HALF + R[i]; int row;
                if (GATHER) { row = 0; if (r < u.nvalid) row = elist[(size_t)u.e * NSLOT + u.r0 + r] >> 1; }
                else row = u.pm * BM + r;
                v[h][i] = (unsigned)(row * K + C[i]) * 2u;
            }
    }
    __device__ __forceinline__ const char* b_ptr(const Unit& u, int K) const { return (const char*)(Bt + (size_t)u.e * estride + (size_t)u.pn * BM * K); }
};

__device__ __forceinline__ unsigned cvt_pk_bf16(float lo, float hi) { unsigned r; asm volatile("v_cvt_pk_bf16_f32 %0, %1, %2" : "=v"(r) : "v"(lo), "v"(hi)); return r; }

struct EpiInProj {
    static constexpr bool PERM = true;
    bf16_t* O; const float* rstd; const float* rope; float* kmp;
    __device__ __forceinline__ void operator()(const f32x4 (&acc)[2][2][4][2], const Unit& u, int wr, int wc, int fr, int fq) const {
        const int mode = (u.pn >= 3 && u.pn <= 6) ? 1 : (u.pn >= 9 ? 2 : 0);
        const int row0 = u.pm * BM + wr * 64 + fr, col0 = u.pn * BM + wc * 32 + 8 * fq;
        const bool ropew = (mode == 1) && ((wc & 1) == 0);
        const bool ksum = (u.pn == 5 || u.pn == 6);
        float cs[2][8];
#pragma unroll
        for (int bj = 0; bj < 2; ++bj)
#pragma unroll
            for (int j = 0; j < 8; ++j) cs[bj][j] = 0.f;
#pragma unroll
        for (int ai = 0; ai < 2; ++ai)
#pragma unroll
            for (int m = 0; m < 4; ++m) {
                const int row = row0 + ai * HALF + m * 16; const float rs = rstd[row];
                bf16_t* rowp = O + (size_t)row * INC + col0;
#pragma unroll
                for (int bj = 0; bj < 2; ++bj) {
                    f32x4 v0 = acc[ai][bj][m][0] * rs, v1 = acc[ai][bj][m][1] * rs;
                    if (ropew) {
                        const f32x4* cs4 = (const f32x4*)(rope + (size_t)row * 16);
                        const f32x4 c0 = cs4[0], c1 = cs4[1], c2 = cs4[2], c3 = cs4[3];
                        f32x4 p0, p1;
#pragma unroll
                        for (int j = 0; j < 4; ++j) { p0[j] = __shfl_xor(v0[j], 16); p1[j] = __shfl_xor(v1[j], 16); }
                        const float sg = fq == 0 ? -1.f : 1.f;
                        if (fq < 2) {
                            v0[0] = v0[0] * c0[0] + sg * p0[0] * c0[1]; v0[1] = v0[1] * c0[2] + sg * p0[1] * c0[3];
                            v0[2] = v0[2] * c1[0] + sg * p0[2] * c1[1]; v0[3] = v0[3] * c1[2] + sg * p0[3] * c1[3];
                            v1[0] = v1[0] * c2[0] + sg * p1[0] * c2[1]; v1[1] = v1[1] * c2[2] + sg * p1[1] * c2[3];
                            v1[2] = v1[2] * c3[0] + sg * p1[2] * c3[1]; v1[3] = v1[3] * c3[2] + sg * p1[3] * c3[3];
                        }
                    }
                    if (ksum) {
#pragma unroll
                        for (int j = 0; j < 4; ++j) { cs[bj][j] += v0[j]; cs[bj][4 + j] += v1[j]; }
                    }
                    if (mode == 2) {
#pragma unroll
                        for (int j = 0; j < 4; ++j) { v0[j] = gelu_tanh(v0[j]); v1[j] = gelu_tanh(v1[j]); }
                    }
                    u32x4 w; w.x = cvt_pk_bf16(v0[0], v0[1]); w.y = cvt_pk_bf16(v0[2], v0[3]); w.z = cvt_pk_bf16(v1[0], v1[1]); w.w = cvt_pk_bf16(v1[2], v1[3]);
                    *(u32x4*)(rowp + bj * HALF) = w;
                }
                asm volatile("" ::: "memory");
            }
        if (ksum) {
#pragma unroll
            for (int bj = 0; bj < 2; ++bj)
#pragma unroll
                for (int j = 0; j < 8; ++j) { float v = cs[bj][j]; v += __shfl_xor(v, 1); v += __shfl_xor(v, 2); v += __shfl_xor(v, 4); v += __shfl_xor(v, 8); cs[bj][j] = v; }
            if (fr == 0) {
                const int bb = u.pm >> 3, blk = u.pm & 7;
#pragma unroll
                for (int bj = 0; bj < 2; ++bj) {
                    const int hh = (u.pn - 5) * 4 + bj * 2 + (wc >> 1), d0 = (wc & 1) * 32 + 8 * fq;
                    float* dst = kmp + (size_t)wr * (BATCH * 8 * 8 * 64) + ((size_t)((bb * 8 + hh) * 8 + blk)) * 64 + d0;
                    *(f32x4*)dst = (f32x4){cs[bj][0], cs[bj][1], cs[bj][2], cs[bj][3]}; *(f32x4*)(dst + 4) = (f32x4){cs[bj][4], cs[bj][5], cs[bj][6], cs[bj][7]};
                }
            }
        }
    }
};
struct EpiOutProj {
    static constexpr bool PERM = true;
    bf16_t* XB; bool dry;
    __device__ __forceinline__ void operator()(const f32x4 (&acc)[2][2][4][2], const Unit& u, int wr, int wc, int fr, int fq) const {
        const int row0 = u.pm * BM + wr * 64 + fr, col0 = u.pn * BM + wc * 32 + 8 * fq;
#pragma unroll
        for (int ai = 0; ai < 2; ++ai)
#pragma unroll
            for (int m = 0; m < 4; ++m) {
                bf16_t* rowp = XB + (size_t)(row0 + ai * HALF + m * 16) * D + col0;
#pragma unroll
                for (int bj = 0; bj < 2; ++bj) {
                    const u32x4 o = *(const u32x4*)(rowp + bj * HALF);
                    const f32x4 v0 = acc[ai][bj][m][0], v1 = acc[ai][bj][m][1];
                    u32x4 w;
                    w.x = cvt_pk_bf16(blo(o.x) + v0[0], bhi(o.x) + v0[1]); w.y = cvt_pk_bf16(blo(o.y) + v0[2], bhi(o.y) + v0[3]);
                    w.z = cvt_pk_bf16(blo(o.z) + v1[0], bhi(o.z) + v1[1]); w.w = cvt_pk_bf16(blo(o.w) + v1[2], bhi(o.w) + v1[3]);
                    if (!dry || w.x == 0x12345678u) *(u32x4*)(rowp + bj * HALF) = w;
                }
                asm volatile("" ::: "memory");
            }
    }
};
struct EpiMoe1 {
    static constexpr bool PERM = true;
    bf16_t* AB; const float* rstd2; const int* elist;
    __device__ __forceinline__ void operator()(const f32x4 (&acc)[2][2][4][2], const Unit& u, int wr, int wc, int fr, int fq) const {
        const int col0 = u.pn * HALF + wc * 32 + 8 * fq;
#pragma unroll
        for (int ai = 0; ai < 2; ++ai)
#pragma unroll
            for (int m = 0; m < 4; ++m) {
                const int r = ai * HALF + wr * 64 + m * 16 + fr;
                int tok = 0; if (r < u.nvalid) tok = elist[(size_t)u.e * NSLOT + u.r0 + r] >> 1;
                const float rs = rstd2[tok];
                float a[8];
#pragma unroll
                for (int n = 0; n < 2; ++n)
#pragma unroll
                    for (int j = 0; j < 4; ++j) { const float g = acc[ai][0][m][n][j] * rs, uu = acc[ai][1][m][n][j] * rs; a[n * 4 + j] = g / (1.f + __expf(-g)) * uu; }
                u32x4 w; w.x = cvt_pk_bf16(a[0], a[1]); w.y = cvt_pk_bf16(a[2], a[3]); w.z = cvt_pk_bf16(a[4], a[5]); w.w = cvt_pk_bf16(a[6], a[7]);
                *(u32x4*)(AB + (size_t)(u.pm * BM + r) * DE + col0) = w;
                asm volatile("" ::: "memory");
            }
    }
};
struct EpiMoe2 {
    static constexpr bool PERM = true;
    bf16_t* YS; const float* slotw; const int* elist;
    __device__ __forceinline__ void operator()(const f32x4 (&acc)[2][2][4][2], const Unit& u, int wr, int wc, int fr, int fq) const {
        const int col0 = u.pn * BM + wc * 32 + 8 * fq;
#pragma unroll
        for (int ai = 0; ai < 2; ++ai)
#pragma unroll
            for (int m = 0; m < 4; ++m) {
                const int r = ai * HALF + wr * 64 + m * 16 + fr;
                if (r < u.nvalid) {
                    const int slot = elist[(size_t)u.e * NSLOT + u.r0 + r]; const float w8 = slotw[slot];
#pragma unroll
                    for (int bj = 0; bj < 2; ++bj) {
                        const f32x4 v0 = acc[ai][bj][m][0] * w8, v1 = acc[ai][bj][m][1] * w8;
                        u32x4 w; w.x = cvt_pk_bf16(v0[0], v0[1]); w.y = cvt_pk_bf16(v0[2], v0[3]); w.z = cvt_pk_bf16(v1[0], v1[1]); w.w = cvt_pk_bf16(v1[2], v1[3]);
                        *(u32x4*)(YS + (size_t)slot * D + col0 + bj * HALF) = w;
                    }
                }
                asm volatile("" ::: "memory");
            }
    }
};

template <class Epi, class Sched, bool ALIGN_EPI>
__device__ __forceinline__ void gemm_phase(LAS unsigned char* lds, const bf16_t* Abase, const int K, const Sched& S, const Epi& E, const int wave) {
    int wid_ = wave; asm volatile("" : "+s"(wid_));
    const int lane = lane_id_opaque(), wid = wid_, tid = wid * 64 + lane, wr = wid >> 2, wc = wid & 3, fr = lane & 15, fq = lane >> 4;
    const int nt = K / BK;
    int Rr[2], Cc[2]; unsigned voffB[2];
#pragma unroll
    for (int i = 0; i < 2; ++i) { int R, C; stage_rc(tid * 16 + i * 8192, R, C); Rr[i] = R; Cc[i] = C; const int Rb = Epi::PERM ? ((R & ~31) + perm32(R & 31)) : R; voffB[i] = (unsigned)(Rb * K + C) * 2u; }
    const size_t kstep = (size_t)(BK * 2);
    const size_t hstep = (size_t)HALF * K * 2;
    const unsigned ldsw = (unsigned)wid * 1024u;
    const int aoff = lds_byte(wr * 64 + fr, fq * 8), boff = lds_byte(wc * 32 + fr, fq * 8);
#define PG8_SA(b, h) (((b) * 2 + (h)) * HTB)
#define PG8_SB(b, h) ((4 + (b) * 2 + (h)) * HTB)
#define PG8_STAGE(bufoff, gbase, voff) do { _Pragma("unroll") for (int _i = 0; _i < 2; ++_i) \
        __builtin_amdgcn_global_load_lds((const unsigned*)((const char*)(gbase) + (voff)[_i]), (LAS unsigned*)(lds + (bufoff) + ldsw + _i * 8192), 16, 0, 0); } while (0)
#define PG8_LDA(dst, b, h) do { _Pragma("unroll") for (int m = 0; m < 4; ++m) _Pragma("unroll") for (int k = 0; k < 2; ++k) dst[m][k] = *(const LAS bf16x8*)(lds + PG8_SA(b, h) + aoff + m * 2048 + k * 1024); } while (0)
#define PG8_LDB(dst, b, h) do { _Pragma("unroll") for (int n = 0; n < 2; ++n) _Pragma("unroll") for (int k = 0; k < 2; ++k) dst[n][k] = *(const LAS bf16x8*)(lds + PG8_SB(b, h) + boff + n * 2048 + k * 1024); } while (0)
#define PG8_MMA(ai, bj, At, Bt) do { __builtin_amdgcn_s_setprio(1); _Pragma("unroll") for (int m = 0; m < 4; ++m) _Pragma("unroll") for (int n = 0; n < 2; ++n) _Pragma("unroll") for (int k = 0; k < 2; ++k) \
        acc[ai][bj][m][n] = __builtin_amdgcn_mfma_f32_16x16x32_bf16(Bt[n][k], At[m][k], acc[ai][bj][m][n], 0, 0, 0); __builtin_amdgcn_s_setprio(0); } while (0)
#define PG8_WAIT_V(n) asm volatile("s_waitcnt vmcnt(" #n ")" ::: "memory")
#define PG8_WAIT_L(n) asm volatile("s_waitcnt lgkmcnt(" #n ")" ::: "memory")
#define PG8_BAR __builtin_amdgcn_s_barrier()
#define PG8_SCHED __builtin_amdgcn_sched_barrier(0)
    Unit cur, nxt; int ui = 0;
    if (!S.next(0, cur)) return;
    f32x4 acc[2][2][4][2];
#pragma unroll
    for (int a = 0; a < 2; ++a)
#pragma unroll
        for (int b = 0; b < 2; ++b)
#pragma unroll
            for (int m = 0; m < 4; ++m)
#pragma unroll
                for (int n = 0; n < 2; ++n) acc[a][b][m][n] = (f32x4){0.f, 0.f, 0.f, 0.f};
    bf16x8 At[4][2], B0[2][2], B1[2][2];
    unsigned vAc[2][2], vAn[2][2];
    unsigned voffA[2];
    const char* const A0 = (const char*)Abase; const char* cA = A0; const char* cB = S.b_ptr(cur, K);
    if constexpr (Sched::GATHER) S.a_offs(cur, K, Rr, Cc, vAc);
    else { voffA[0] = (unsigned)(Rr[0] * K + Cc[0]) * 2u; voffA[1] = (unsigned)(Rr[1] * K + Cc[1]) * 2u; cA = A0 + (size_t)cur.pm * 2 * hstep; }
#define PG8_STAGE_A(bufoff, koff, NEXT, h) do { if constexpr (Sched::GATHER) { unsigned _v[2] = {(NEXT) ? vAn[h][0] : vAc[h][0], (NEXT) ? vAn[h][1] : vAc[h][1]}; PG8_STAGE(bufoff, A0 + (koff), _v); } \
        else { PG8_STAGE(bufoff, ((NEXT) ? nA : cA) + (koff) + (h) * hstep, voffA); } } while (0)
    const char* nA = cA;
    PG8_STAGE(PG8_SB(0, 0), cB, voffB); PG8_STAGE(PG8_SB(0, 1), cB + hstep, voffB); PG8_STAGE_A(PG8_SA(0, 0), 0, false, 0); PG8_STAGE_A(PG8_SA(0, 1), 0, false, 1);
    if (wr == 1) PG8_BAR;
    PG8_WAIT_V(2); PG8_BAR;
    PG8_STAGE(PG8_SB(1, 0), cB + kstep, voffB); PG8_STAGE_A(PG8_SA(1, 0), kstep, false, 0); PG8_STAGE(PG8_SB(1, 1), cB + hstep + kstep, voffB);
    PG8_WAIT_V(6); PG8_BAR;
    for (;;) {
        const bool has_next = S.next(ui + 1, nxt);
        const char* nB = cB; nA = cA;
        if (has_next) {
            nB = S.b_ptr(nxt, K);
            if constexpr (Sched::GATHER) S.a_offs(nxt, K, Rr, Cc, vAn); else nA = A0 + (size_t)nxt.pm * 2 * hstep;
        } else if constexpr (Sched::GATHER) {
#pragma unroll
            for (int h = 0; h < 2; ++h)
#pragma unroll
                for (int i = 0; i < 2; ++i) vAn[h][i] = vAc[h][i];
        }
        for (int t = 0; t < nt; t += 2) {
            const bool last = (t == nt - 2);
            const size_t k1 = (size_t)(t + 1) * kstep, k2 = last ? 0 : (size_t)(t + 2) * kstep, k3 = k2 + kstep;
            const char* b2 = last ? nB : cB + (size_t)(t + 2) * kstep; const char* b3 = b2 + kstep;
            PG8_LDB(B0, 0, 0); PG8_LDB(B1, 0, 1); PG8_SCHED; PG8_LDA(At, 0, 0); PG8_STAGE_A(PG8_SA(1, 1), k1, false, 1);
            PG8_WAIT_V(8); PG8_WAIT_L(0); PG8_BAR; PG8_MMA(0, 0, At, B0); PG8_MMA(0, 1, At, B1); PG8_BAR; PG8_SCHED;
            PG8_LDA(At, 0, 1); PG8_STAGE(PG8_SB(0, 0), b2, voffB); PG8_STAGE(PG8_SB(0, 1), b2 + hstep, voffB); PG8_STAGE_A(PG8_SA(0, 0), k2, last, 0);
            PG8_WAIT_V(8); PG8_WAIT_L(0); PG8_BAR; PG8_MMA(1, 0, At, B0); PG8_MMA(1, 1, At, B1); PG8_BAR; PG8_SCHED;
            PG8_LDB(B0, 1, 0); PG8_LDB(B1, 1, 1); PG8_SCHED; PG8_LDA(At, 1, 0); PG8_STAGE_A(PG8_SA(0, 1), k2, last, 1);
            PG8_WAIT_V(8); PG8_WAIT_L(0); PG8_BAR; PG8_MMA(0, 0, At, B0); PG8_MMA(0, 1, At, B1); PG8_BAR; PG8_SCHED;
            PG8_LDA(At, 1, 1); PG8_STAGE(PG8_SB(1, 0), b3, voffB); PG8_STAGE(PG8_SB(1, 1), b3 + hstep, voffB); PG8_STAGE_A(PG8_SA(1, 0), k3, last, 0);
            PG8_WAIT_V(8); PG8_WAIT_L(0); PG8_BAR; PG8_MMA(1, 0, At, B0); PG8_MMA(1, 1, At, B1); PG8_BAR; PG8_SCHED;
        }
        if constexpr (ALIGN_EPI) { if (wr == 0) PG8_BAR; }
        E(acc, cur, wr, wc, fr, fq);
        if (!has_next) break;
#pragma unroll
        for (int a = 0; a < 2; ++a)
#pragma unroll
            for (int b = 0; b < 2; ++b)
#pragma unroll
                for (int m = 0; m < 4; ++m)
#pragma unroll
                    for (int n = 0; n < 2; ++n) acc[a][b][m][n] = (f32x4){0.f, 0.f, 0.f, 0.f};
        cur = nxt; cB = nB; cA = nA; ++ui;
        if constexpr (Sched::GATHER) {
#pragma unroll
            for (int h = 0; h < 2; ++h)
#pragma unroll
                for (int i = 0; i < 2; ++i) vAc[h][i] = vAn[h][i];
        }
        if constexpr (ALIGN_EPI) { if (wr == 1) PG8_BAR; }
    }
    PG8_WAIT_V(0);
    if constexpr (!ALIGN_EPI) { if (wr == 0) PG8_BAR; }
    PG8_BAR;
#undef PG8_SA
#undef PG8_SB
#undef PG8_STAGE
#undef PG8_STAGE_A
#undef PG8_LDA
#undef PG8_LDB
#undef PG8_MMA
#undef PG8_WAIT_V
#undef PG8_WAIT_L
#undef PG8_BAR
#undef PG8_SCHED
}
}

#define XB_TMO      128
#define XB_XCNT(j)  (256  + 64 * (j))
#define XB_XSUB(j)  (1280 + 64 * (j))
#define XB_XGEN(j)  (2304 + 64 * (j))
#define XB_TOP      3328
#define XB_TOPGEN   3392
#define XCD_BAR_WORDS 3456
#define XB_SPIN_CAP (1u << 18)
__device__ __forceinline__ unsigned xb_ld(unsigned* p)              { return __hip_atomic_load(p, __ATOMIC_RELAXED, __HIP_MEMORY_SCOPE_AGENT); }
__device__ __forceinline__ unsigned xb_add(unsigned* p, unsigned v) { return __hip_atomic_fetch_add(p, v, __ATOMIC_RELAXED, __HIP_MEMORY_SCOPE_AGENT); }
__device__ __forceinline__ unsigned xb_xcc_id() { return (unsigned)__builtin_amdgcn_s_getreg((3 << 11) | 20) & 0xFu; }
#define XB_SPIN(cond, bar) do { unsigned _sp = 0; while (cond) { __builtin_amdgcn_s_sleep(1); \
    if ((++_sp & 255u) == 0u) { if (xb_ld(&(bar)[XB_TMO])) break; if (_sp > XB_SPIN_CAP) { atomicAdd(&(bar)[XB_TMO], 1u); break; } } } } while (0)
struct XcdBarrier { unsigned* bar; unsigned x; volatile LAS unsigned* st; };
__device__ __forceinline__ XcdBarrier xcd_barrier_post(unsigned* bar, volatile LAS unsigned* st) {
    XcdBarrier b; b.bar = bar; b.x = xb_xcc_id(); b.st = st;
    if (threadIdx.x == 0) (void)xb_add(&bar[XB_XCNT(b.x)], 1u);
    return b;
}
__device__ __forceinline__ void xcd_barrier_complete(unsigned* bar, unsigned x, unsigned& nloc, unsigned& nx) {
    const unsigned G = gridDim.x * gridDim.y * gridDim.z;
    unsigned sum, cnt, mine, sp = 0u;
    for (;;) {
        sum = 0u; cnt = 0u; mine = 0u;
#pragma unroll
        for (unsigned j = 0; j < 16; ++j) { const unsigned c = xb_ld(&bar[XB_XCNT(j)]); sum += c; cnt += (c > 0u) ? 1u : 0u; mine = (j == x) ? c : mine; }
        if (sum == G) break;
        __builtin_amdgcn_s_sleep(1);
        if ((++sp & 255u) == 0u) { if (xb_ld(&bar[XB_TMO])) break; if (sp > XB_SPIN_CAP) { atomicAdd(&bar[XB_TMO], 1u); break; } }
    }
    nloc = mine > 0u ? mine : 1u; nx = cnt > 0u ? cnt : 1u;
}
__device__ __forceinline__ void xcd_barrier(const XcdBarrier& b, const bool t0  ) {
    asm volatile("s_waitcnt vmcnt(0)" ::: "memory");
    __syncthreads();
    if (t0) {
        unsigned* bar = b.bar;
        __builtin_amdgcn_s_waitcnt(0);
        unsigned nloc = b.st[0], nx = b.st[1];
        if (nloc == 0u) { xcd_barrier_complete(bar, b.x, nloc, nx); b.st[0] = nloc; b.st[1] = nx; }
        const unsigned old = xb_add(&bar[XB_XSUB(b.x)], 1u);
        const unsigned gen = old / nloc;
        if (old + 1u == (gen + 1u) * nloc) {
            __builtin_amdgcn_fence(__ATOMIC_RELEASE, "agent");
            asm volatile("s_waitcnt vmcnt(0)" ::: "memory");
            const unsigned og = xb_add(&bar[XB_TOP], 1u);
            const unsigned tg = og / nx;
            if (og + 1u == (tg + 1u) * nx) xb_add(&bar[XB_TOPGEN], 1u);
            else XB_SPIN(xb_ld(&bar[XB_TOPGEN]) == tg, bar);
            __builtin_amdgcn_fence(__ATOMIC_ACQUIRE, "agent");
            xb_add(&bar[XB_XGEN(b.x)], 1u);
            asm volatile("s_waitcnt vmcnt(0)" ::: "memory");
        } else {
            XB_SPIN(xb_ld(&bar[XB_XGEN(b.x)]) == gen, bar);
            __builtin_amdgcn_fence(__ATOMIC_ACQUIRE, "agent");
            asm volatile("s_waitcnt vmcnt(0)" ::: "memory");
        }
    }
    __syncthreads();
}

struct TrDesc { const float* W; bf16* WT; const float* scale; int K, N, mode, item; };
__device__ __forceinline__ void tr_load(const TrDesc& d, float4 (&v)[8], int lane) {
    const int nblk = d.N / 32, kb = d.item / nblk, nb = d.item % nblk, k0 = 64 * kb, n0 = 32 * nb;
    const float* src = d.W + (size_t)(k0 + (lane >> 3)) * d.N + n0 + (lane & 7) * 4;
#pragma unroll
    for (int i = 0; i < 8; ++i) v[i] = *(const float4*)(src + (size_t)(8 * i) * d.N);
}
__device__ __forceinline__ void tr_store(const TrDesc& d, const float4 (&v)[8], LAS float* scr, int lane) {
    const int nblk = d.N / 32, kb = d.item / nblk, nb = d.item % nblk, k0 = 64 * kb, n0 = 32 * nb;
    const int kr = lane >> 3, nq = lane & 7;
#pragma unroll
    for (int i = 0; i < 8; ++i) { LAS float* p = scr + (8 * i + kr) * 33 + 4 * nq; p[0] = v[i].x; p[1] = v[i].y; p[2] = v[i].z; p[3] = v[i].w; }
    LDS_WAIT();
    const int c = lane & 7;
    float sc[8];
#pragma unroll
    for (int e = 0; e < 8; ++e) sc[e] = d.scale ? d.scale[k0 + 8 * c + e] : 1.f;
#pragma unroll
    for (int j = 0; j < 4; ++j) {
        const int n = (lane >> 3) + 8 * j; const LAS float* s = scr + (8 * c) * 33 + n;
        uint4 o; o.x = pk2(s[0 * 33] * sc[0], s[1 * 33] * sc[1]); o.y = pk2(s[2 * 33] * sc[2], s[3 * 33] * sc[3]); o.z = pk2(s[4 * 33] * sc[4], s[5 * 33] * sc[5]); o.w = pk2(s[6 * 33] * sc[6], s[7 * 33] * sc[7]);
        const int ng = n0 + n;
        const int row = d.mode == 0 ? ng : ((ng >> 7) * 256 + (d.mode == 2 ? 128 : 0) + (ng & 127));
        *(uint4*)(d.WT + (size_t)row * d.K + k0 + 8 * c) = o;
    }
    LDS_WAIT();
}
constexpr int I_WIN = DEPTH * (D / 64) * (INC / 32);
constexpr int I_WOUT = DEPTH * (D / 64) * (D / 32);
constexpr int I_G = DEPTH * NE * (D / 64) * (DE / 32);
constexpr int I_D = DEPTH * NE * (DE / 64) * (D / 32);
constexpr int I_TOTAL = I_WIN + I_WOUT + 2 * I_G + I_D;

__device__ __forceinline__ void phase_prologue(const P& p, LAS unsigned char* lds, int gw, int NGW, int wave, int lane) {
    unsigned char* ws = p.ws;
    LAS float* scr = (LAS float*)(lds + wave * (64 * 33 * 4));
    auto desc = [&](int it) {
        TrDesc d; int r = it;
        if (r < I_WIN) { const int per = (D / 64) * (INC / 32), l = r / per; d = TrDesc{p.w_in + (size_t)l * D * INC, (bf16*)(ws + WS_WIN) + (size_t)l * INC * D, p.g_mix + l * D, D, INC, 0, r % per}; return d; }
        r -= I_WIN;
        if (r < I_WOUT) { const int per = (D / 64) * (D / 32), l = r / per; d = TrDesc{p.w_out + (size_t)l * D * D, (bf16*)(ws + WS_WOUT) + (size_t)l * D * D, nullptr, D, D, 0, r % per}; return d; }
        r -= I_WOUT;
        if (r < 2 * I_G) {
            const int up = r >= I_G; if (up) r -= I_G;
            const int per = (D / 64) * (DE / 32), le = r / per, l = le / NE;
            d = TrDesc{(up ? p.w_u : p.w_g) + (size_t)le * D * DE, (bf16*)(ws + WS_WGU) + (size_t)le * 1024 * 1024, p.g_ffn + l * D, D, DE, up ? 2 : 1, r % per}; return d;
        }
        r -= 2 * I_G;
        { const int per = (DE / 64) * (D / 32), le = r / per; d = TrDesc{p.w_d + (size_t)le * DE * D, (bf16*)(ws + WS_WD) + (size_t)le * 1024 * 512, nullptr, DE, D, 0, r % per}; return d; }
    };
    if (gw < I_TOTAL) {
        TrDesc dc = desc(gw); float4 vc[8]; tr_load(dc, vc, lane);
        for (int it = gw; it < I_TOTAL; it += NGW) {
            const int nx = it + NGW; TrDesc dn = dc; float4 vn[8];
            if (nx < I_TOTAL) { dn = desc(nx); tr_load(dn, vn, lane); }
            tr_store(dc, vc, scr, lane);
            dc = dn;
#pragma unroll
            for (int i = 0; i < 8; ++i) vc[i] = vn[i];
        }
    }
    for (int idx = gw * 64 + lane; idx < DEPTH * 36 * D; idx += NGW * 64) {
        const int k = idx % D, j = (idx / D) % 36, l = idx / (36 * D);
        const float v = (j < 4 ? p.w_rg[((size_t)l * D + k) * 4 + j] : p.w_re[((size_t)l * D + k) * NE + (j - 4)]) * p.g_ffn[l * D + k];
        const bf16 h = f2bf(v);
        ((bf16*)(ws + WS_WR))[idx] = h; ((bf16*)(ws + WS_WR))[DEPTH * 36 * D + idx] = f2bf(v - bf2f(h));
    }
    for (int idx = gw * 64 + lane; idx < T * 8; idx += NGW * 64) {
        const int i = idx & 7, t = idx >> 3;
        const float inv = exp2f(-(float)i * (18.931568569324174f / 8.f));
        const float ang = (float)p.pos[t] * inv;
        float sn, cs; sincosf(ang, &sn, &cs);
        float* r = (float*)(ws + WS_ROPE) + (size_t)idx * 2;
        r[0] = cs; r[1] = sn;
    }
    bf16* XB = (bf16*)(ws + WS_XB); float* RS = (float*)(ws + WS_RSTD);
    for (int m = gw; m < T; m += NGW) {
        const float4* xr = (const float4*)(p.x + (size_t)m * D) + lane; float4 v[4]; float s = 0.f;
#pragma unroll
        for (int j = 0; j < 4; ++j) { v[j] = xr[64 * j]; s += v[j].x * v[j].x + v[j].y * v[j].y + v[j].z * v[j].z + v[j].w * v[j].w; }
        s = wave_sum(s);
        if (lane == 0) RS[m] = rsqrtf(s * (1.f / D) + EPS);
#pragma unroll
        for (int j = 0; j < 4; ++j)
            ((uint2*)(XB + (size_t)m * D) + lane)[64 * j] = make_uint2(pk2(v[j].x, v[j].y), pk2(v[j].z, v[j].w));
    }
}

typedef float f32x4 __attribute__((ext_vector_type(4)));
__device__ __forceinline__ void phase_router(unsigned char* ws, LAS unsigned char* lds, int l, int vcu, int G, int wave, int lane, bool dry) {
    typedef short bf16x8 __attribute__((ext_vector_type(8)));
    typedef unsigned u32x4 __attribute__((ext_vector_type(4)));
    const int r = lane & 15, q = lane >> 4;
    for (int t4 = vcu; t4 < T / 64; t4 += G) {
        for (int pc = wave; pc < 144; pc += NWAVES) {
            const int img = pc >= 72, pp = pc - img * 72, row = pp >> 1, half = pp & 1;
            const bf16* src = (const bf16*)(ws + WS_WR) + (size_t)img * DEPTH * 36 * D + ((size_t)l * 36 + row) * D + half * 512 + lane * 8;
            __builtin_amdgcn_global_load_lds((const unsigned*)src, (LAS unsigned*)(lds + img * RT_IMG + row * RT_LD + half * 1024), 16, 0, 0);
        }
        asm volatile("s_waitcnt vmcnt(0)" ::: "memory");
        __syncthreads();
        const int tok0 = t4 * 64 + (wave & 3) * 16, kb = (wave >> 2) * 512;
        const bf16* X = (const bf16*)(ws + WS_XB) + (size_t)(tok0 + r) * D + kb + q * 8;
        f32x4 acc[3] = {{0.f, 0.f, 0.f, 0.f}, {0.f, 0.f, 0.f, 0.f}, {0.f, 0.f, 0.f, 0.f}};
        float ss = 0.f;
        int nrow[3] = {r, 16 + r, 32 + (r & 3)};
#pragma unroll 8
        for (int ks = 0; ks < 16; ++ks) {
            const u32x4 xh = *(const u32x4*)(X + ks * 32);
            ss += blo(xh[0]) * blo(xh[0]) + bhi(xh[0]) * bhi(xh[0]) + blo(xh[1]) * blo(xh[1]) + bhi(xh[1]) * bhi(xh[1]) + blo(xh[2]) * blo(xh[2]) + bhi(xh[2]) * bhi(xh[2]) + blo(xh[3]) * blo(xh[3]) + bhi(xh[3]) * bhi(xh[3]);
            const bf16x8 ah = __builtin_bit_cast(bf16x8, xh);
#pragma unroll
            for (int nt = 0; nt < 3; ++nt) {
                const LAS unsigned char* wp = lds + nrow[nt] * RT_LD + (kb + ks * 32 + q * 8) * 2;
                const bf16x8 bh = *(const LAS bf16x8*)wp, bl = *(const LAS bf16x8*)(wp + RT_IMG);
                acc[nt] = __builtin_amdgcn_mfma_f32_16x16x32_bf16(ah, bh, acc[nt], 0, 0, 0);
                acc[nt] = __builtin_amdgcn_mfma_f32_16x16x32_bf16(ah, bl, acc[nt], 0, 0, 0);
            }
        }
        ss += __shfl_xor(ss, 16); ss += __shfl_xor(ss, 32);
        __syncthreads();
        LAS float* lg = (LAS float*)lds + wave * (16 * 52);
#pragma unroll
        for (int nt = 0; nt < 3; ++nt)
#pragma unroll
            for (int reg = 0; reg < 4; ++reg) lg[(q * 4 + reg) * 52 + nt * 16 + r] = acc[nt][reg];
        if (q == 0) lg[r * 52 + 48] = ss;
        __syncthreads();
        if (wave < 4 && lane < 16 && !dry) {
            const int tok = tok0 + lane;
            const LAS float* L0 = (const LAS float*)lds + wave * (16 * 52) + lane * 52; const LAS float* L1 = L0 + 4 * (16 * 52);
            const float rs = rsqrtf((L0[48] + L1[48]) * (1.f / D) + EPS);
            ((float*)(ws + WS_RSTD2))[tok] = rs;
            float g0 = (L0[0] + L1[0]) * rs, g1 = (L0[1] + L1[1]) * rs, g2 = (L0[2] + L1[2]) * rs, g3 = (L0[3] + L1[3]) * rs;
            int gs = 0; float gm = g0;
            if (g1 > gm) { gm = g1; gs = 1; }
            if (g2 > gm) { gm = g2; gs = 2; }
            if (g3 > gm) { gm = g3; gs = 3; }
            const float pg = 1.f / (expf(g0 - gm) + expf(g1 - gm) + expf(g2 - gm) + expf(g3 - gm));
            float e[8];
#pragma unroll
            for (int j = 0; j < 8; ++j) e[j] = (L0[4 + gs * 8 + j] + L1[4 + gs * 8 + j]) * rs;
            int i1 = 0; float m1 = e[0];
#pragma unroll
            for (int j = 1; j < 8; ++j) if (e[j] > m1) { m1 = e[j]; i1 = j; }
            int i2 = -1; float m2 = -3e38f;
#pragma unroll
            for (int j = 0; j < 8; ++j) if (j != i1 && e[j] > m2) { m2 = e[j]; i2 = j; }
            const float p2 = expf(m2 - m1), inv = 1.f / (1.f + p2);
            const float w1 = pg * inv, w2 = pg * p2 * inv;
            const int e1 = gs * 8 + i1, e2 = gs * 8 + i2;
            u32* ecnt = (u32*)(ws + WS_CTL) + CW_ECNT + l * 32;
            int* elist = (int*)(ws + WS_ELIST);
            float* sw = (float*)(ws + WS_SLOTW);
            const u32 p1 = atomicAdd(ecnt + e1, 1u); elist[(size_t)e1 * NSLOT + p1] = tok * 2;
            const u32 p2i = atomicAdd(ecnt + e2, 1u); elist[(size_t)e2 * NSLOT + p2i] = tok * 2 + 1;
            sw[tok * 2] = w1; sw[tok * 2 + 1] = w2;
        }
        __syncthreads();
    }
}
__device__ __forceinline__ void phase_combine(const P& p, int l, int gw, int NGW, int lane, bool dry = false) {
    bf16* XB = (bf16*)(p.ws + WS_XB); float* RS = (float*)(p.ws + WS_RSTD);
    const bf16* YS = (const bf16*)(p.ws + WS_YS);
    for (int m = gw; m < T; m += NGW) {
        float4 v[4]; float s = 0.f;
#pragma unroll
        for (int j = 0; j < 4; ++j) {
            const uint2 x = ((const uint2*)(XB + (size_t)m * D) + lane)[64 * j];
            const uint2 a = ((const uint2*)(YS + (size_t)(2 * m) * D) + lane)[64 * j], b = ((const uint2*)(YS + (size_t)(2 * m + 1) * D) + lane)[64 * j];
            v[j].x = blo(x.x) + (blo(a.x) + blo(b.x)); v[j].y = bhi(x.x) + (bhi(a.x) + bhi(b.x)); v[j].z = blo(x.y) + (blo(a.y) + blo(b.y)); v[j].w = bhi(x.y) + (bhi(a.y) + bhi(b.y));
            s += v[j].x * v[j].x + v[j].y * v[j].y + v[j].z * v[j].z + v[j].w * v[j].w;
        }
        s = wave_sum(s);
        const float rs = rsqrtf(s * (1.f / D) + EPS);
        if (dry) { if (rs == 123.f) RS[m] = rs; }
        else if (l == DEPTH - 1) {
#pragma unroll
            for (int j = 0; j < 4; ++j) {
                const float4 g = ((const float4*)p.g_fin + lane)[64 * j];
                ((float4*)(p.out + (size_t)m * D) + lane)[64 * j] = make_float4(v[j].x * rs * g.x, v[j].y * rs * g.y, v[j].z * rs * g.z, v[j].w * rs * g.w);
            }
        } else {
            if (lane == 0) RS[m] = rs;
#pragma unroll
            for (int j = 0; j < 4; ++j) ((uint2*)(XB + (size_t)m * D) + lane)[64 * j] = make_uint2(pk2(v[j].x, v[j].y), pk2(v[j].z, v[j].w));
        }
    }
}

namespace mix {
typedef short bf16x8 __attribute__((ext_vector_type(8)));
typedef short s16x4 __attribute__((ext_vector_type(4)));
typedef float f32x16 __attribute__((ext_vector_type(16)));
typedef float f32x4 __attribute__((ext_vector_type(4)));
typedef unsigned u32x4 __attribute__((ext_vector_type(4)));
constexpr int L_K = 0, L_V = 16384, SLOTB = 8192;
constexpr int L_WSF = 32768;
constexpr int L_FLAG = 36864;
constexpr int L_KM = 37888;
constexpr int L_OST = 40960, OST_W = 32 * 68 * 4;
constexpr int L_VNT = 40960, VNT_LD = 136;
static_assert(L_OST + 8 * OST_W <= RING_BYTES, "mixer LDS map");
constexpr float NEG_INF = -__builtin_inff();

__device__ __forceinline__ int crow(int r, int hi) { return (r & 3) + 8 * (r >> 2) + 4 * hi; }
__device__ __forceinline__ unsigned cvtpk(float lo, float hi) { unsigned r; asm volatile("v_cvt_pk_bf16_f32 %0, %1, %2" : "=v"(r) : "v"(lo), "v"(hi)); return r; }
__device__ __forceinline__ s16x4 vtr(const LAS unsigned char* p) { typedef short v4i16_t __attribute__((ext_vector_type(4))); return __builtin_bit_cast(s16x4, __builtin_amdgcn_ds_read_tr16_b64_v4i16((LAS v4i16_t*)p)); }

__device__ __forceinline__ void dma_tile(LAS unsigned char* lds, const bf16* Kh, const bf16* Vh, int key0, int slot, int wave, int lane) {
    const bf16* ks = Kh + (size_t)(key0 + lane) * INC + wave * 8;
    const bf16* vs = Vh + (size_t)(key0 + 16 * (wave & 3) + (lane >> 2)) * INC + (wave >> 2) * 32 + (lane & 3) * 8;
    __builtin_amdgcn_global_load_lds((const unsigned*)ks, (LAS unsigned*)(lds + L_K + slot * SLOTB + wave * 1024), 16, 0, 0);
    __builtin_amdgcn_global_load_lds((const unsigned*)vs, (LAS unsigned*)(lds + L_V + slot * SLOTB + wave * 1024), 16, 0, 0);
}
__device__ __forceinline__ void qkt(f32x16& p0, f32x16& p1, const LAS unsigned char* kslot, const bf16x8 (&qr)[4], int r32, int hi) {
    const LAS unsigned char* kb = kslot + hi * 1024 + r32 * 16;
    p0 = (f32x16){0.f, 0.f, 0.f, 0.f, 0.f, 0.f, 0.f, 0.f, 0.f, 0.f, 0.f, 0.f, 0.f, 0.f, 0.f, 0.f}; p1 = p0;
#pragma unroll
    for (int d0 = 0; d0 < 4; ++d0) {
        const bf16x8 b0 = *(const LAS bf16x8*)(kb + d0 * 2048), b1 = *(const LAS bf16x8*)(kb + d0 * 2048 + 512);
        p0 = __builtin_amdgcn_mfma_f32_32x32x16_bf16(b0, qr[d0], p0, 0, 0, 0);
        p1 = __builtin_amdgcn_mfma_f32_32x32x16_bf16(b1, qr[d0], p1, 0, 0, 0);
    }
}
__device__ __forceinline__ void pv(f32x16 (&o)[2], const LAS unsigned char* vslot, const u32x4 (&pa)[4], int lane) {
    const int hi = lane >> 5;
    const LAS unsigned char* vp = vslot + ((lane >> 4) & 1) * 32 + (lane & 3) * 8 + (4 * hi + ((lane & 15) >> 2)) * 64;
#pragma unroll
    for (int d0 = 0; d0 < 2; ++d0)
#pragma unroll
        for (int ks = 0; ks < 4; ++ks) {
            const s16x4 lo = vtr(vp + d0 * 4096 + ks * 1024), hh = vtr(vp + d0 * 4096 + ks * 1024 + 512);
            const bf16x8 vb = (bf16x8){lo[0], lo[1], lo[2], lo[3], hh[0], hh[1], hh[2], hh[3]};
            o[d0] = __builtin_amdgcn_mfma_f32_32x32x16_bf16(__builtin_bit_cast(bf16x8, pa[ks]), vb, o[d0], 0, 0, 0);
        }
}
__device__ __forceinline__ void pack_p(u32x4 (&pa)[4], const f32x16& p0, const f32x16& p1) {
#pragma unroll
    for (int s = 0; s < 2; ++s) {
        pa[s] = (u32x4){cvtpk(p0[8 * s + 0], p0[8 * s + 1]), cvtpk(p0[8 * s + 2], p0[8 * s + 3]), cvtpk(p0[8 * s + 4], p0[8 * s + 5]), cvtpk(p0[8 * s + 6], p0[8 * s + 7])};
        pa[2 + s] = (u32x4){cvtpk(p1[8 * s + 0], p1[8 * s + 1]), cvtpk(p1[8 * s + 2], p1[8 * s + 3]), cvtpk(p1[8 * s + 4], p1[8 * s + 5]), cvtpk(p1[8 * s + 6], p1[8 * s + 7])};
    }
}
__device__ __forceinline__ void store_headnorm(LAS unsigned char* lds, const f32x16 (&o)[2], const LAS float* qs  , const float* gh  , bf16* onrow0  , int wave, int lane) {
    const int r32 = lane & 31, hi = lane >> 5;
    LAS float* st = (LAS float*)(lds + L_OST + wave * OST_W);
#pragma unroll
    for (int r = 0; r < 16; ++r) {
        const int q = crow(r, hi); const float s = qs ? qs[q] : 1.f;
        st[q * 68 + r32] = o[0][r] * s; st[q * 68 + 32 + r32] = o[1][r] * s;
    }
    LDS_WAIT();
    const int q = lane >> 1, part = lane & 1;
    f32x4 x[8]; float ss = 0.f;
#pragma unroll
    for (int i = 0; i < 8; ++i) { x[i] = *(const LAS f32x4*)(st + q * 68 + part * 32 + i * 4); ss += x[i][0] * x[i][0] + x[i][1] * x[i][1] + x[i][2] * x[i][2] + x[i][3] * x[i][3]; }
    ss += __shfl_xor(ss, 1);
    const float rs = rsqrtf(ss * (1.f / 64.f) + EPS);
    bf16* dst = onrow0 + (size_t)q * D + part * 32;
#pragma unroll
    for (int i = 0; i < 4; ++i) {
        const f32x4 g0 = *(const f32x4*)(gh + part * 32 + i * 8), g1 = *(const f32x4*)(gh + part * 32 + i * 8 + 4);
        const f32x4 a = x[2 * i] * rs * g0, b = x[2 * i + 1] * rs * g1;
        *(u32x4*)(dst + i * 8) = (u32x4){cvtpk(a[0], a[1]), cvtpk(a[2], a[3]), cvtpk(b[0], b[1]), cvtpk(b[2], b[3])};
    }
    LDS_WAIT();
}

__device__ __forceinline__ void moba_unit(LAS unsigned char* lds, const bf16* PR, bf16* ON, const float* KMP, const float* gh, int b, int h, int qb, int wave_, int lane_) {
    int wave = wave_; asm volatile("" : "+s"(wave)); const int lane = lane_id_opaque();
    const int r32 = lane & 31, hi = lane >> 5, tid = wave * 64 + lane;
    const size_t rowbase = (size_t)b * SEQ;
    const bf16* Qw = PR + (rowbase + qb * 256 + wave * 32) * INC + C_QB + h * 64;
    const bf16* Kh = PR + rowbase * INC + C_KB + h * 64; const bf16* Vh = PR + rowbase * INC + C_VB + h * 64;
    LAS float* km = (LAS float*)(lds + L_KM);
    LAS float* wsf = (LAS float*)(lds + L_WSF) + wave * 128;
    __syncthreads();
    dma_tile(lds, Kh, Vh, 0, 0, wave, lane);
    { const size_t o = ((size_t)(b * 8 + h) * 8) * 64 + tid; km[tid] = KMP[o] + KMP[(size_t)BATCH * 8 * 8 * 64 + o]; }
    bf16x8 qr[4];
#pragma unroll
    for (int ks = 0; ks < 4; ++ks) qr[ks] = *(const bf16x8*)(Qw + (size_t)r32 * INC + ks * 16 + hi * 8);
    __syncthreads();
    unsigned selmask = 0;
    {
        float b1 = NEG_INF, b2 = NEG_INF, b3 = NEG_INF; int i1 = -1, i2 = -1, i3 = -1;
#pragma unroll 1
        for (int j = 0; j < qb; ++j) {
            float s = 0.f;
#pragma unroll
            for (int ks = 0; ks < 4; ++ks)
#pragma unroll
                for (int e = 0; e < 8; ++e) s += bf2f((bf16)qr[ks][e]) * km[j * 64 + ks * 16 + hi * 8 + e];
            s += __shfl_xor(s, 32);
            if (s > b1) { b3 = b2; i3 = i2; b2 = b1; i2 = i1; b1 = s; i1 = j; }
            else if (s > b2) { b3 = b2; i3 = i2; b2 = s; i2 = j; }
            else if (s > b3) { b3 = s; i3 = j; }
        }
        if (i1 >= 0) selmask |= 1u << i1;
        if (i2 >= 0) selmask |= 1u << i2;
        if (i3 >= 0) selmask |= 1u << i3;
    }
    unsigned wneed = 0;
#pragma unroll
    for (int j = 0; j < 8; ++j) if (__any((selmask >> j) & 1u)) wneed |= 1u << j;
    wneed = __builtin_amdgcn_readfirstlane(wneed);
    float m = -1e30f, l = 0.f; f32x16 o[2];
    o[0] = (f32x16){0.f, 0.f, 0.f, 0.f, 0.f, 0.f, 0.f, 0.f, 0.f, 0.f, 0.f, 0.f, 0.f, 0.f, 0.f, 0.f}; o[1] = o[0];
    const int NT = 4 * (qb + 1);
    const float SC = 0.125f * 1.4426950408889634f;
    for (int tt = 0; tt < NT; ++tt) {
        asm volatile("s_waitcnt vmcnt(0)" ::: "memory");
        __syncthreads();
        if (tt + 1 < NT) dma_tile(lds, Kh, Vh, 64 * (tt + 1), (tt + 1) & 1, wave, lane);
        const int blk = tt >> 2; const bool own = blk == qb;
        const bool act = own ? ((tt & 3) <= (wave >> 1)) : ((wneed >> blk) & 1u);
        if (act) {
            f32x16 p0, p1;
            qkt(p0, p1, lds + L_K + (tt & 1) * SLOTB, qr, r32, hi);
            const bool selme = (selmask >> blk) & 1u;
            const int qrel = 32 * wave + r32 - 64 * (tt & 3);
            float rm = NEG_INF;
#pragma unroll
            for (int r = 0; r < 16; ++r) {
                const int kk = crow(r, hi);
                const bool v0 = own ? (kk <= qrel) : selme, v1 = own ? (kk + 32 <= qrel) : selme;
                p0[r] = v0 ? p0[r] * SC : NEG_INF; p1[r] = v1 ? p1[r] * SC : NEG_INF;
                rm = fmaxf(rm, fmaxf(p0[r], p1[r]));
            }
            rm = fmaxf(rm, __shfl_xor(rm, 32));
            const float mn = fmaxf(m, rm), alpha = __builtin_amdgcn_exp2f(m - mn);
            m = mn;
            float rs = 0.f;
#pragma unroll
            for (int r = 0; r < 16; ++r) { p0[r] = __builtin_amdgcn_exp2f(p0[r] - mn); p1[r] = __builtin_amdgcn_exp2f(p1[r] - mn); rs += p0[r] + p1[r]; }
            rs += __shfl_xor(rs, 32);
            l = l * alpha + rs;
            if (__any(alpha != 1.f)) {
                if (hi == 0) wsf[r32] = alpha;
                LDS_WAIT();
#pragma unroll
                for (int r = 0; r < 16; ++r) { const float a = wsf[crow(r, hi)]; o[0][r] *= a; o[1][r] *= a; }
            }
            u32x4 pa[4]; pack_p(pa, p0, p1);
            pv(o, lds + L_V + (tt & 1) * SLOTB, pa, lane);
        }
    }
    if (hi == 0) wsf[32 + r32] = 1.f / l;
    LDS_WAIT();
    store_headnorm(lds, o, wsf + 32, gh, ON + (rowbase + qb * 256 + wave * 32) * D + 256 + h * 64, wave, lane);
}

__device__ __forceinline__ void sb_unit(LAS unsigned char* lds, const bf16* PR, bf16* ON, const float* gh, int b, int h, int qb, int wave_, int lane_) {
    int wave = wave_; asm volatile("" : "+s"(wave)); const int lane = lane_id_opaque();
    const int r32 = lane & 31, hi = lane >> 5;
    const size_t rowbase = (size_t)b * SEQ;
    const bf16* Qw = PR + (rowbase + qb * 256 + wave * 32) * INC + C_QA + h * 64;
    const bf16* Kh = PR + rowbase * INC + C_KA + h * 64; const bf16* Vh = PR + rowbase * INC + C_VA + h * 64;
    volatile LAS int* flag = (volatile LAS int*)(lds + L_FLAG);
    __syncthreads();
    const int jt0 = 4 * qb + 3, jtd = 4 * qb + (wave >> 1);
    dma_tile(lds, Kh, Vh, 64 * jt0, 0, wave, lane);
    bf16x8 qr[4];
#pragma unroll
    for (int ks = 0; ks < 4; ++ks) qr[ks] = *(const bf16x8*)(Qw + (size_t)r32 * INC + ks * 16 + hi * 8);
    float L = 0.f; f32x16 o[2];
    o[0] = (f32x16){0.f, 0.f, 0.f, 0.f, 0.f, 0.f, 0.f, 0.f, 0.f, 0.f, 0.f, 0.f, 0.f, 0.f, 0.f, 0.f}; o[1] = o[0];
    bool active = true;
    for (int step = 0;; ++step) {
        const int jt = jt0 - step;
        asm volatile("s_waitcnt vmcnt(0)" ::: "memory");
        __syncthreads();
        if (step > 0) { int any = 0;
#pragma unroll
            for (int w = 0; w < 8; ++w) any |= flag[((step - 1) & 1) * 8 + w];
            if (!any) break; }
        if (jt < 0) break;
        if (jt > 0) dma_tile(lds, Kh, Vh, 64 * (jt - 1), (step + 1) & 1, wave, lane);
        if (active && jt <= jtd) {
            f32x16 p0, p1;
            qkt(p0, p1, lds + L_K + (step & 1) * SLOTB, qr, r32, hi);
            const int trel = 256 * qb + 32 * wave + r32 - 64 * jt;
            float gs[8];
#pragma unroll
            for (int k = 0; k < 8; ++k) gs[k] = 0.f;
            f32x16 q0, q1;
#pragma unroll
            for (int r = 0; r < 16; ++r) {
                const int kk = crow(r, hi);
                { const float z = p0[r] * 0.125f, l1p = __logf(1.f + __expf(-fabsf(z))); const bool v = kk < trel;
                  q0[r] = v ? fminf(-z, 0.f) - l1p : 0.f; p0[r] = v ? fminf(z, 0.f) - l1p : NEG_INF; gs[r >> 2] += q0[r]; }
                { const float z = p1[r] * 0.125f, l1p = __logf(1.f + __expf(-fabsf(z))); const bool v = kk + 32 < trel;
                  q1[r] = v ? fminf(-z, 0.f) - l1p : 0.f; p1[r] = v ? fminf(z, 0.f) - l1p : NEG_INF; gs[4 + (r >> 2)] += q1[r]; }
            }
            float aft[8]; float run = 0.f;
#pragma unroll
            for (int k = 7; k >= 0; --k) { const float og = __shfl_xor(gs[k], 32); aft[k] = run + (hi == 0 ? og : 0.f); run += gs[k] + og; }
#pragma unroll
            for (int k = 0; k < 4; ++k) {
                float a = L + aft[k];
                p0[4 * k + 3] = __expf(p0[4 * k + 3] + a); a += q0[4 * k + 3];
                p0[4 * k + 2] = __expf(p0[4 * k + 2] + a); a += q0[4 * k + 2];
                p0[4 * k + 1] = __expf(p0[4 * k + 1] + a); a += q0[4 * k + 1];
                p0[4 * k + 0] = __expf(p0[4 * k + 0] + a);
                float c = L + aft[4 + k];
                p1[4 * k + 3] = __expf(p1[4 * k + 3] + c); c += q1[4 * k + 3];
                p1[4 * k + 2] = __expf(p1[4 * k + 2] + c); c += q1[4 * k + 2];
                p1[4 * k + 1] = __expf(p1[4 * k + 1] + c); c += q1[4 * k + 1];
                p1[4 * k + 0] = __expf(p1[4 * k + 0] + c);
            }
            L += run;
            u32x4 pa[4]; pack_p(pa, p0, p1);
            pv(o, lds + L_V + (step & 1) * SLOTB, pa, lane);
            if (__all(L < -88.f)) active = false;
        }
        if (lane == 0) flag[(step & 1) * 8 + wave] = (active && jt > 0) ? 1 : 0;
    }
    store_headnorm(lds, o, nullptr, gh, ON + (rowbase + qb * 256 + wave * 32) * D + h * 64, wave, lane);
}

__device__ __forceinline__ void gmlp_unit(LAS unsigned char* lds, const bf16* PR, bf16* ON, const float* gvn  , const float* wsp  , const float* bsp  , const float* gh  , int b, int c, int g, int wave_, int lane_) {
    int wave = wave_; asm volatile("" : "+s"(wave)); const int lane = lane_id_opaque();
    const int tid = wave * 64 + lane;
    const size_t row0 = (size_t)b * SEQ + c * 128;
    LAS bf16* vnT = (LAS bf16*)(lds + L_VNT);
    __syncthreads();
    {
        const int s = tid >> 2, part = tid & 3;
        const bf16* vr = PR + (row0 + s) * INC + C_VC + g * 64 + part * 16;
        const uint4 a = *(const uint4*)vr, bq = *(const uint4*)(vr + 8);
        float x[16] = {blo(a.x), bhi(a.x), blo(a.y), bhi(a.y), blo(a.z), bhi(a.z), blo(a.w), bhi(a.w), blo(bq.x), bhi(bq.x), blo(bq.y), bhi(bq.y), blo(bq.z), bhi(bq.z), blo(bq.w), bhi(bq.w)};
        float ss = 0.f;
#pragma unroll
        for (int i = 0; i < 16; ++i) ss += x[i] * x[i];
        ss += __shfl_xor(ss, 1); ss += __shfl_xor(ss, 2);
        const float rs = rsqrtf(ss * (1.f / 64.f) + EPS);
#pragma unroll
        for (int i = 0; i < 16; ++i) vnT[(part * 16 + i) * VNT_LD + s] = f2bf(x[i] * rs * gvn[part * 16 + i]);
    }
    __syncthreads();
    const int fr = lane & 15, fq = lane >> 4, t = 16 * wave + fr;
    f32x4 acc[4] = {{0.f, 0.f, 0.f, 0.f}, {0.f, 0.f, 0.f, 0.f}, {0.f, 0.f, 0.f, 0.f}, {0.f, 0.f, 0.f, 0.f}};
    const int nks = (wave >> 1) + 1;
    for (int ks = 0; ks < nks; ++ks) {
        const int s0 = 32 * ks + 8 * fq;
        const f32x4 w0 = *(const f32x4*)(wsp + (size_t)t * 128 + s0), w1 = *(const f32x4*)(wsp + (size_t)t * 128 + s0 + 4);
        float wv[8] = {w0[0], w0[1], w0[2], w0[3], w1[0], w1[1], w1[2], w1[3]};
#pragma unroll
        for (int j = 0; j < 8; ++j) if (s0 + j > t) wv[j] = 0.f;
        const u32x4 au = (u32x4){cvtpk(wv[0], wv[1]), cvtpk(wv[2], wv[3]), cvtpk(wv[4], wv[5]), cvtpk(wv[6], wv[7])};
#pragma unroll
        for (int n = 0; n < 4; ++n) {
            const bf16x8 bv = *(const LAS bf16x8*)(vnT + (16 * n + fr) * VNT_LD + s0);
            acc[n] = __builtin_amdgcn_mfma_f32_16x16x32_bf16(__builtin_bit_cast(bf16x8, au), bv, acc[n], 0, 0, 0);
        }
    }
    __syncthreads();
    LAS float* st = (LAS float*)(lds + L_OST + wave * OST_W);
#pragma unroll
    for (int reg = 0; reg < 4; ++reg) {
        const int tl = 4 * fq + reg, tt = 16 * wave + tl; const float bb = bsp[tt];
#pragma unroll
        for (int n = 0; n < 4; ++n) st[tl * 68 + 16 * n + fr] = acc[n][reg] + bb;
    }
    LDS_WAIT();
    {
        const int tl = lane >> 2, part = lane & 3, tt = 16 * wave + tl;
        const bf16* ur = PR + (row0 + tt) * INC + C_UC + g * 64 + part * 16;
        const uint4 ua = *(const uint4*)ur, ub = *(const uint4*)(ur + 8);
        const float u[16] = {blo(ua.x), bhi(ua.x), blo(ua.y), bhi(ua.y), blo(ua.z), bhi(ua.z), blo(ua.w), bhi(ua.w), blo(ub.x), bhi(ub.x), blo(ub.y), bhi(ub.y), blo(ub.z), bhi(ub.z), blo(ub.w), bhi(ub.w)};
        float v[16]; float ss = 0.f;
#pragma unroll
        for (int i = 0; i < 4; ++i) { const f32x4 m4 = *(const LAS f32x4*)(st + tl * 68 + part * 16 + i * 4);
#pragma unroll
            for (int j = 0; j < 4; ++j) { v[4 * i + j] = u[4 * i + j] * m4[j]; ss += v[4 * i + j] * v[4 * i + j]; } }
        ss += __shfl_xor(ss, 1); ss += __shfl_xor(ss, 2);
        const float rs = rsqrtf(ss * (1.f / 64.f) + EPS);
        bf16* dst = ON + (row0 + tt) * D + 768 + g * 64 + part * 16;
#pragma unroll
        for (int i = 0; i < 2; ++i) {
            const f32x4 g0 = *(const f32x4*)(gh + part * 16 + i * 8), g1 = *(const f32x4*)(gh + part * 16 + i * 8 + 4);
            *(u32x4*)(dst + i * 8) = (u32x4){cvtpk(v[8 * i + 0] * rs * g0[0], v[8 * i + 1] * rs * g0[1]), cvtpk(v[8 * i + 2] * rs * g0[2], v[8 * i + 3] * rs * g0[3]),
                                             cvtpk(v[8 * i + 4] * rs * g1[0], v[8 * i + 5] * rs * g1[1]), cvtpk(v[8 * i + 6] * rs * g1[2], v[8 * i + 7] * rs * g1[3])};
        }
    }
    LDS_WAIT();
}
}
__device__ __forceinline__ const void* lptr(LAS unsigned char* lds, int k) {
    const unsigned long long v = ((const LAS unsigned long long*)(lds + LDS_PTRS))[k];
    const unsigned lo = __builtin_amdgcn_readfirstlane((unsigned)v), hi = __builtin_amdgcn_readfirstlane((unsigned)(v >> 32));
    return (const void*)(((unsigned long long)hi << 32) | lo);
}
__device__ __forceinline__ P load_params(LAS unsigned char* lds, unsigned char* ws) {
    P q;
    q.x = (const float*)lptr(lds, 0); q.pos = (const int*)lptr(lds, 1); q.w_in = (const float*)lptr(lds, 2); q.w_out = (const float*)lptr(lds, 3);
    q.g_mix = (const float*)lptr(lds, 4); q.g_head = (const float*)lptr(lds, 5); q.g_vn = (const float*)lptr(lds, 6); q.w_sp = (const float*)lptr(lds, 7);
    q.b_sp = (const float*)lptr(lds, 8); q.g_ffn = (const float*)lptr(lds, 9); q.w_rg = (const float*)lptr(lds, 10); q.w_re = (const float*)lptr(lds, 11);
    q.w_g = (const float*)lptr(lds, 12); q.w_u = (const float*)lptr(lds, 13); q.w_d = (const float*)lptr(lds, 14); q.g_fin = (const float*)lptr(lds, 15);
    q.out = (float*)lptr(lds, 16); q.ws = ws;
    return q;
}
#ifndef REP_P
#define REP_P 1
#endif
#ifndef REP_A
#define REP_A 1
#endif
#ifndef REP_B
#define REP_B 1
#endif
#ifndef REP_E
#define REP_E 1
#endif
#ifndef REP_F
#define REP_F 1
#endif
#ifndef REP_D
#define REP_D 1
#endif
#ifndef REP_G
#define REP_G 1
#endif
#ifndef REP_C
#define REP_C 1
#endif
constexpr int NSTEPS = 1 + 7 * DEPTH;
__global__ void __launch_bounds__(NWAVES * 64, 2) mk(P p, int s_lo, int s_hi, int bar_region, int mix_mask) {
    extern __shared__ __attribute__((aligned(16))) unsigned char lds_raw[];
    LAS unsigned char* lds = (LAS unsigned char*)lds_raw;
    const int wave = __builtin_amdgcn_readfirstlane(threadIdx.x >> 6);
    const int G = gridDim.x, bx = blockIdx.x;
    const int vcu = (G % 8 == 0) ? (bx % 8) * (G / 8) + bx / 8 : bx;
    const int gw = vcu * NWAVES + wave, NGW = G * NWAVES;
    unsigned char* ws = p.ws;
    volatile LAS unsigned* misc = (volatile LAS unsigned*)(lds + LDS_MISC);
    if (threadIdx.x < 4) misc[threadIdx.x] = 0u;
    if (threadIdx.x == 0) {
        LAS unsigned long long* pp = (LAS unsigned long long*)(lds + LDS_PTRS);
        pp[0] = (unsigned long long)p.x; pp[1] = (unsigned long long)p.pos; pp[2] = (unsigned long long)p.w_in; pp[3] = (unsigned long long)p.w_out;
        pp[4] = (unsigned long long)p.g_mix; pp[5] = (unsigned long long)p.g_head; pp[6] = (unsigned long long)p.g_vn; pp[7] = (unsigned long long)p.w_sp;
        pp[8] = (unsigned long long)p.b_sp; pp[9] = (unsigned long long)p.g_ffn; pp[10] = (unsigned long long)p.w_rg; pp[11] = (unsigned long long)p.w_re;
        pp[12] = (unsigned long long)p.w_g; pp[13] = (unsigned long long)p.w_u; pp[14] = (unsigned long long)p.w_d; pp[15] = (unsigned long long)p.g_fin;
        pp[16] = (unsigned long long)p.out;
    }
    __syncthreads();
    XcdBarrier bar = xcd_barrier_post((unsigned*)(ws + WS_CTL) + CW_BAR + bar_region * XCD_BAR_WORDS, misc);
#define IN(k) (s_lo <= (k) && (k) < s_hi)
#define SEAM(k) do { if (IN(k) && IN((k) + 1)) xcd_barrier(bar, wave == 0 && lane_id_opaque() == 0); } while (0)

#define OPQ_WS(name) unsigned char* name = ws; asm volatile("" : "+s"(name))
#define OPQ_LDS(name) LAS unsigned char* name = lds; asm volatile("" : "+s"(name))
#define OPQ_LANE(name) const int name = lane_id_opaque()
    if (IN(0)) for (int rep = 0; rep < REP_P; ++rep) { OPQ_WS(w); OPQ_LDS(ld); OPQ_LANE(ln); const P q = load_params(ld, w); phase_prologue(q, ld, gw, NGW, wave, ln); __syncthreads(); }
    SEAM(0);
#pragma unroll 1
    for (int l = 0; l < DEPTH; ++l) {
        const int s0 = 1 + 7 * l;
        if (IN(s0 + 0)) for (int rep = 0; rep < REP_A; ++rep) {
            OPQ_WS(w); OPQ_LDS(ld);
            pg8::StaticOrder S; S.init(T, INC, G, bx, (const bf16*)(w + WS_WIN) + (size_t)l * INC * D);
            pg8::EpiInProj E{(bf16*)(w + WS_PROJ), (const float*)(w + WS_RSTD), (const float*)(w + WS_ROPE), (float*)(w + WS_KMEAN)};
            pg8::gemm_phase<pg8::EpiInProj, pg8::StaticOrder, true>(ld, (const bf16*)(w + WS_XB), D, S, E, wave);
        }
        SEAM(s0 + 0);
        if (IN(s0 + 1)) for (int rep = 0; rep < REP_B; ++rep) {
            OPQ_WS(w); OPQ_LDS(ld); OPQ_LANE(ln);
            int wv = wave; asm volatile("" : "+s"(wv));
            const bf16* PR = (const bf16*)(w + WS_PROJ); bf16* ON = (bf16*)(w + WS_ON);
            const float* ghead = (const float*)lptr(ld, 5) + (size_t)l * 16 * 64;
            if (mix_mask & 1) {
                for (int u = vcu; u < 256; u += G) {
                    const int bh = u >> 2, i = u & 3;
                    mix::moba_unit(ld, PR, ON, (const float*)(w + WS_KMEAN), ghead + (4 + (bh & 7)) * 64, bh >> 3, bh & 7, 7 - i, wv, ln);
                    mix::moba_unit(ld, PR, ON, (const float*)(w + WS_KMEAN), ghead + (4 + (bh & 7)) * 64, bh >> 3, bh & 7, i, wv, ln);
                }
            }
            if (mix_mask & 2) {
                for (int u = vcu; u < 256; u += G) mix::sb_unit(ld, PR, ON, ghead + ((u >> 3) & 3) * 64, u >> 5, (u >> 3) & 3, u & 7, wv, ln);
            }
            if (mix_mask & 4) {
                const float* gvn = (const float*)lptr(ld, 6) + (size_t)l * 4 * 64;
                const float* wsp = (const float*)lptr(ld, 7) + (size_t)l * 4 * 128 * 128;
                const float* bsp = (const float*)lptr(ld, 8) + (size_t)l * 4 * 128;
                for (int u = vcu; u < 512; u += G) {
                    const int g = u & 3, c = (u >> 2) & 15, b = u >> 6;
                    mix::gmlp_unit(ld, PR, ON, gvn + g * 64, wsp + (size_t)g * 128 * 128, bsp + g * 128, ghead + (12 + g) * 64, b, c, g, wv, ln);
                }
            }
            __syncthreads();
        }
        SEAM(s0 + 1);
        if (IN(s0 + 2)) for (int rep = 0; rep < REP_C; ++rep) {
            OPQ_WS(w); OPQ_LDS(ld);
            pg8::StaticOrder S; S.init(T, D, G, bx, (const bf16*)(w + WS_WOUT) + (size_t)l * D * D);
            pg8::EpiOutProj E{(bf16*)(w + WS_XB), rep + s_lo < REP_C - 1};
            pg8::gemm_phase<pg8::EpiOutProj, pg8::StaticOrder, false>(ld, (const bf16*)(w + WS_ON), D, S, E, wave);
        }
        SEAM(s0 + 2);
        if (IN(s0 + 3)) {
            OPQ_WS(w); OPQ_LDS(ld); OPQ_LANE(ln);
            int wv = wave; asm volatile("" : "+s"(wv));
            for (int rep = 0; rep < REP_D; ++rep) phase_router(w, ld, l, vcu, G, wv, ln, rep + s_lo < REP_D - 1);
        }
        SEAM(s0 + 3);
        if (IN(s0 + 4) || IN(s0 + 5)) {
            { OPQ_WS(w); OPQ_LDS(ld);
              LAS int* tbl = (LAS int*)(ld + LDS_TBL);
              __syncthreads();
              if (wave == 0 && lane_id_opaque() == 0) {
                  const u32* ecnt = (const u32*)(w + WS_CTL) + CW_ECNT + l * 32; int base = 0;
                  for (int e = 0; e < NE; ++e) { const int c = (int)__hip_atomic_load(ecnt + e, __ATOMIC_RELAXED, __HIP_MEMORY_SCOPE_AGENT); tbl[e] = base; tbl[33 + e] = c; base += (c + 255) >> 8; }
                  tbl[32] = base;
              }
              __syncthreads(); }
            if (IN(s0 + 4)) for (int rep = 0; rep < REP_E; ++rep) {
                OPQ_WS(w); OPQ_LDS(ld);
                pg8::MoeOrder<true, 4> S{(const LAS int*)(ld + LDS_TBL), (const int*)(w + WS_ELIST), (const bf16*)(w + WS_WGU) + (size_t)l * NE * 1024 * 1024, (size_t)1024 * 1024, G, bx};
                pg8::EpiMoe1 E{(bf16*)(w + WS_ABUF), (const float*)(w + WS_RSTD2), (const int*)(w + WS_ELIST)};
                pg8::gemm_phase<pg8::EpiMoe1, pg8::MoeOrder<true, 4>, true>(ld, (const bf16*)(w + WS_XB), D, S, E, wave);
            }
            SEAM(s0 + 4);
            if (IN(s0 + 5)) for (int rep = 0; rep < REP_F; ++rep) {
                OPQ_WS(w); OPQ_LDS(ld);
                pg8::MoeOrder<false, 4> S{(const LAS int*)(ld + LDS_TBL), (const int*)(w + WS_ELIST), (const bf16*)(w + WS_WD) + (size_t)l * NE * 1024 * 512, (size_t)1024 * 512, G, bx};
                pg8::EpiMoe2 E{(bf16*)(w + WS_YS), (const float*)(w + WS_SLOTW), (const int*)(w + WS_ELIST)};
                pg8::gemm_phase<pg8::EpiMoe2, pg8::MoeOrder<false, 4>, true>(ld, (const bf16*)(w + WS_ABUF), DE, S, E, wave);
            }
        }
        SEAM(s0 + 5);
        if (IN(s0 + 6)) { OPQ_WS(w); OPQ_LDS(ld); OPQ_LANE(ln); const P q = load_params(ld, w); for (int rep = 0; rep < REP_G; ++rep) phase_combine(q, l, gw, NGW, ln, rep + s_lo < REP_G - 1); }
        SEAM(s0 + 6);
    }
#undef IN
#undef SEAM
}

__global__ void k_kmean_naive(P p) {
    const int idx = blockIdx.x * blockDim.x + threadIdx.x;
    const int d = idx & 63, blk = (idx >> 6) & 7, h = (idx >> 9) & 7, b = idx >> 12;
    const bf16* PR = (const bf16*)(p.ws + WS_PROJ);
    float s = 0.f;
    for (int j = 0; j < 256; ++j) s += bf2f(PR[(size_t)(b * SEQ + blk * 256 + j) * INC + C_KB + h * 64 + d]);
    ((float*)(p.ws + WS_KMEAN + 262144))[idx] = s * (1.f / 256.f);
}
__global__ void __launch_bounds__(64) k_sb_naive(P p) {
    const int idx = blockIdx.x * 64 + threadIdx.x;
    const int t = idx % SEQ, h = (idx / SEQ) % 4, b = idx / (SEQ * 4);
    const bf16* PR = (const bf16*)(p.ws + WS_PROJ);
    const size_t row = (size_t)b * SEQ + t;
    uint4 q[8];
#pragma unroll
    for (int i = 0; i < 8; ++i) q[i] = *(const uint4*)(PR + row * INC + C_QA + h * 64 + i * 8);
    float acc[64];
#pragma unroll
    for (int i = 0; i < 64; ++i) acc[i] = 0.f;
    float L = 0.f;
    for (int s = t - 1; s >= 0; --s) {
        const bf16* kr = PR + ((size_t)b * SEQ + s) * INC + C_KA + h * 64;
        const bf16* vr = PR + ((size_t)b * SEQ + s) * INC + C_VA + h * 64;
        float z = 0.f;
#pragma unroll
        for (int i = 0; i < 8; ++i) z += dot8(q[i], *(const uint4*)(kr + i * 8));
        z *= 0.125f;
        const float l1p = log1pf(expf(-fabsf(z)));
        const float ls = fminf(z, 0.f) - l1p, lr = fminf(-z, 0.f) - l1p;
        const float w = expf(ls + L);
        L += lr;
#pragma unroll
        for (int i = 0; i < 8; ++i) {
            const uint4 vv = *(const uint4*)(vr + i * 8);
            acc[i * 8 + 0] += w * blo(vv.x); acc[i * 8 + 1] += w * bhi(vv.x); acc[i * 8 + 2] += w * blo(vv.y); acc[i * 8 + 3] += w * bhi(vv.y);
            acc[i * 8 + 4] += w * blo(vv.z); acc[i * 8 + 5] += w * bhi(vv.z); acc[i * 8 + 6] += w * blo(vv.w); acc[i * 8 + 7] += w * bhi(vv.w);
        }
    }
    float* O = (float*)(p.ws + WS_YS) + row * D + h * 64;
#pragma unroll
    for (int i = 0; i < 16; ++i) *(float4*)(O + i * 4) = make_float4(acc[i * 4], acc[i * 4 + 1], acc[i * 4 + 2], acc[i * 4 + 3]);
}
__global__ void __launch_bounds__(64) k_moba_naive(P p) {
    const int idx = blockIdx.x * 64 + threadIdx.x;
    const int t = idx % SEQ, h = (idx / SEQ) % 8, b = idx / (SEQ * 8);
    const bf16* PR = (const bf16*)(p.ws + WS_PROJ);
    const size_t row = (size_t)b * SEQ + t;
    const int own = t >> 8;
    uint4 q[8];
#pragma unroll
    for (int i = 0; i < 8; ++i) q[i] = *(const uint4*)(PR + row * INC + C_QB + h * 64 + i * 8);
    const float* KM = (const float*)(p.ws + WS_KMEAN + 262144) + ((size_t)(b * 8 + h) * 8) * 64;
    float g[8];
#pragma unroll
    for (int j = 0; j < 8; ++j) {
        float s = -1e30f;
        if (j < own) {
            s = 0.f;
#pragma unroll
            for (int i = 0; i < 8; ++i) {
                const float* km = KM + j * 64 + i * 8;
                s += blo(q[i].x) * km[0] + bhi(q[i].x) * km[1] + blo(q[i].y) * km[2] + bhi(q[i].y) * km[3] + blo(q[i].z) * km[4] + bhi(q[i].z) * km[5] + blo(q[i].w) * km[6] + bhi(q[i].w) * km[7];
            }
        }
        g[j] = s;
    }
    unsigned selmask = 0; const int nsel = own < 3 ? own : 3;
    for (int r = 0; r < nsel; ++r) {
        float best = -3e38f; int bi = 0;
#pragma unroll
        for (int j = 0; j < 8; ++j) { const bool ok = !((selmask >> j) & 1u) && g[j] > best; if (ok) { best = g[j]; bi = j; } }
        selmask |= 1u << bi;
    }
    float acc[64];
#pragma unroll
    for (int i = 0; i < 64; ++i) acc[i] = 0.f;
    float mx = -3e38f, lsum = 0.f;
    for (int blk = 0; blk <= own; ++blk) {
        if (blk < own && !((selmask >> blk) & 1u)) continue;
        const int s1 = blk == own ? t : blk * 256 + 255;
        for (int s = blk * 256; s <= s1; ++s) {
            const bf16* kr = PR + ((size_t)b * SEQ + s) * INC + C_KB + h * 64;
            const bf16* vr = PR + ((size_t)b * SEQ + s) * INC + C_VB + h * 64;
            float z = 0.f;
#pragma unroll
            for (int i = 0; i < 8; ++i) z += dot8(q[i], *(const uint4*)(kr + i * 8));
            z *= 0.125f;
            const float mn = fmaxf(mx, z), sc = expf(mx - mn), w = expf(z - mn);
            mx = mn; lsum = lsum * sc + w;
#pragma unroll
            for (int i = 0; i < 8; ++i) {
                const uint4 vv = *(const uint4*)(vr + i * 8);
                acc[i * 8 + 0] = acc[i * 8 + 0] * sc + w * blo(vv.x); acc[i * 8 + 1] = acc[i * 8 + 1] * sc + w * bhi(vv.x);
                acc[i * 8 + 2] = acc[i * 8 + 2] * sc + w * blo(vv.y); acc[i * 8 + 3] = acc[i * 8 + 3] * sc + w * bhi(vv.y);
                acc[i * 8 + 4] = acc[i * 8 + 4] * sc + w * blo(vv.z); acc[i * 8 + 5] = acc[i * 8 + 5] * sc + w * bhi(vv.z);
                acc[i * 8 + 6] = acc[i * 8 + 6] * sc + w * blo(vv.w); acc[i * 8 + 7] = acc[i * 8 + 7] * sc + w * bhi(vv.w);
            }
        }
    }
    const float il = 1.f / lsum;
    float* O = (float*)(p.ws + WS_YS) + row * D + 256 + h * 64;
#pragma unroll
    for (int i = 0; i < 16; ++i) *(float4*)(O + i * 4) = make_float4(acc[i * 4] * il, acc[i * 4 + 1] * il, acc[i * 4 + 2] * il, acc[i * 4 + 3] * il);
}
__global__ void k_gvn_naive(P p, int l) {
    const int idx = blockIdx.x * blockDim.x + threadIdx.x;
    const int g = idx & 3, t = idx >> 2;
    const bf16* v = (const bf16*)(p.ws + WS_PROJ) + (size_t)t * INC + C_VC + g * 64;
    float s = 0.f;
    for (int d = 0; d < 64; ++d) { const float x = bf2f(v[d]); s += x * x; }
    const float rs = rsqrtf(s * (1.f / 64.f) + EPS);
    float* o = (float*)(p.ws + WS_ABUF) + (size_t)t * 256 + g * 64;
    for (int d = 0; d < 64; ++d) o[d] = bf2f(v[d]) * rs * p.g_vn[(l * 4 + g) * 64 + d];
}
__global__ void k_gmlp_naive(P p, int l) {
    const int idx = blockIdx.x * blockDim.x + threadIdx.x;
    const int d = idx & 63, g = (idx >> 6) & 3, t = idx >> 8;
    const int tc = t & 127, t0 = t - tc;
    const float* VN = (const float*)(p.ws + WS_ABUF);
    const float* w = p.w_sp + ((size_t)(l * 4 + g) * 128 + tc) * 128;
    float s = 0.f;
    for (int j = 0; j <= tc; ++j) s += w[j] * VN[(size_t)(t0 + j) * 256 + g * 64 + d];
    s += p.b_sp[(l * 4 + g) * 128 + tc];
    const float u = bf2f(((const bf16*)(p.ws + WS_PROJ))[(size_t)t * INC + C_UC + g * 64 + d]);
    ((float*)(p.ws + WS_YS))[(size_t)t * D + 768 + g * 64 + d] = u * s;
}
__global__ void k_headnorm_naive(P p, int l) {
    const int idx = blockIdx.x * blockDim.x + threadIdx.x;
    const int h = idx & 15, t = idx >> 4;
    const float* o = (const float*)(p.ws + WS_YS) + (size_t)t * D + h * 64;
    float s = 0.f;
    for (int d = 0; d < 64; ++d) s += o[d] * o[d];
    const float rs = rsqrtf(s * (1.f / 64.f) + EPS);
    bf16* on = (bf16*)(p.ws + WS_ON) + (size_t)t * D + h * 64;
    for (int d = 0; d < 64; ++d) on[d] = f2bf(o[d] * rs * p.g_head[(l * 16 + h) * 64 + d]);
}

extern "C" void kernel_launch(void* const* d_in, const int* in_sizes, int n_in, void* d_out, int out_size, void* d_ws, size_t ws_size, hipStream_t stream) {
    static int grid = 0;
    if (grid == 0) {
        if (n_in != 16 || out_size != T * D || ws_size < WS_END) { fprintf(stderr, "kernel_launch: unexpected sizes (n_in %d out %d ws %zu)\n", n_in, out_size, ws_size); grid = -1; return; }
        int dev = 0, cus = 0, per_cu = 0;
        if (hipGetDevice(&dev) != hipSuccess || hipDeviceGetAttribute(&cus, hipDeviceAttributeMultiprocessorCount, dev) != hipSuccess) { grid = -1; return; }
        if (hipFuncSetAttribute((const void*)mk, hipFuncAttributeMaxDynamicSharedMemorySize, LDS_BYTES) != hipSuccess) { fprintf(stderr, "kernel_launch: hipFuncSetAttribute failed\n"); grid = -1; return; }
        if (hipOccupancyMaxActiveBlocksPerMultiprocessor(&per_cu, (const void*)mk, NWAVES * 64, LDS_BYTES) != hipSuccess || per_cu < 1) fprintf(stderr, "kernel_launch: occupancy query says %d\n", per_cu);
        (void)hipGetLastError();
        grid = cus;
    }
    if (grid < 0) return;
    P p{};
    p.x = (const float*)d_in[0]; p.pos = (const int*)d_in[1]; p.w_in = (const float*)d_in[2]; p.w_out = (const float*)d_in[3];
    p.g_mix = (const float*)d_in[4]; p.g_head = (const float*)d_in[5]; p.g_vn = (const float*)d_in[6]; p.w_sp = (const float*)d_in[7];
    p.b_sp = (const float*)d_in[8]; p.g_ffn = (const float*)d_in[9]; p.w_rg = (const float*)d_in[10]; p.w_re = (const float*)d_in[11];
    p.w_g = (const float*)d_in[12]; p.w_u = (const float*)d_in[13]; p.w_d = (const float*)d_in[14]; p.g_fin = (const float*)d_in[15];
    p.out = (float*)d_out; p.ws = (unsigned char*)d_ws;
    (void)hipMemsetAsync((char*)d_ws + WS_CTL, 0, CTL_BYTES, stream);
    int region = 0;
#ifndef NAIVE_MIX
#define NAIVE_MIX 0
#endif
#ifndef MIX_MASK
#define MIX_MASK 7
#endif
    auto launch = [&](int lo, int hi) { hipLaunchKernelGGL(mk, dim3(grid), dim3(NWAVES * 64), LDS_BYTES, stream, p, lo, hi, region, (int)MIX_MASK); ++region; };
#if NAIVE_MIX
    int lo = 0;
    for (int l = 0; l < DEPTH; ++l) {
        const int s0 = 1 + 7 * l;
        launch(lo, s0 + 1);
        k_kmean_naive<<<BATCH * 8 * 8 * 64 / 256, 256, 0, stream>>>(p);
        k_sb_naive<<<BATCH * 4 * SEQ / 64, 64, 0, stream>>>(p);
        k_moba_naive<<<BATCH * 8 * SEQ / 64, 64, 0, stream>>>(p);
        k_gvn_naive<<<T * 4 / 256, 256, 0, stream>>>(p, l);
        k_gmlp_naive<<<T * 256 / 256, 256, 0, stream>>>(p, l);
        k_headnorm_naive<<<T * 16 / 256, 256, 0, stream>>>(p, l);
        lo = s0 + 1;
    }
    launch(lo, NSTEPS);
#else
    launch(0, NSTEPS);
#endif
}
```

```cpp
#include <hip/hip_runtime.h>
#include <cstdint>
#include <cstdio>

constexpr int D = 1024, BATCH = 8, SEQ = 2048, T = BATCH * SEQ, DEPTH = 4;
constexpr int HD = 64;
constexpr int INC = 2816;
constexpr int C_QA = 0, C_KA = 256, C_VA = 512, C_QB = 768, C_KB = 1280, C_VB = 1792, C_UC = 2304, C_VC = 2560;
constexpr int NE = 32, EPG = 8, DE = 512;
constexpr int NSLOT = T * 2;
constexpr int MAXMT = 160;
constexpr float EPS = 1e-6f;

typedef unsigned short bf16;
typedef unsigned u32;
#define LAS __attribute__((address_space(3)))
#define GAS __attribute__((address_space(1)))

constexpr size_t MiB = 1u << 20;
constexpr size_t WS_CTL = 0, CTL_BYTES = 1 * MiB;
constexpr size_t WS_WR = 1 * MiB;
constexpr size_t WS_ROPE = 2 * MiB;
constexpr size_t WS_RSTD = 3 * MiB;
constexpr size_t WS_RSTD2 = WS_RSTD + 65536;
constexpr size_t WS_SLOTW = WS_RSTD2 + 65536;
constexpr size_t WS_KMEAN = WS_RSTD + 524288;
constexpr size_t WS_ELIST = 4 * MiB;
constexpr size_t WS_WIN = 8 * MiB;
constexpr size_t WS_WOUT = 30 * MiB;
constexpr size_t WS_WGU = 38 * MiB;
constexpr size_t WS_WD = 294 * MiB;
constexpr size_t WS_X = 422 * MiB;
constexpr size_t WS_XB = 486 * MiB;
constexpr size_t WS_PROJ = 518 * MiB;
constexpr size_t WS_ON = 606 * MiB;
constexpr size_t WS_ABUF = 638 * MiB;
constexpr size_t WS_YS = 678 * MiB;
constexpr size_t WS_END = 742 * MiB;
constexpr int CW_ECNT = 1024;
constexpr int CW_BAR = 4096;
constexpr int RING_BYTES = 131072;
constexpr int RT_LD = 2080;
constexpr int RT_IMG = 36 * RT_LD;
constexpr int LDS_CTL = 150528;
constexpr int LDS_TBL = LDS_CTL;
constexpr int LDS_MISC = LDS_CTL + 1024;
constexpr int LDS_PTRS = LDS_CTL + 2048;
constexpr int LDS_BYTES = 163840;
static_assert(2 * RT_IMG <= LDS_CTL && LDS_PTRS + 17 * 8 <= LDS_BYTES, "LDS map");
constexpr int NWAVES = 8;

struct P {
    const float* x; const int* pos; const float* w_in; const float* w_out; const float* g_mix; const float* g_head; const float* g_vn;
    const float* w_sp; const float* b_sp; const float* g_ffn; const float* w_rg; const float* w_re; const float* w_g; const float* w_u;
    const float* w_d; const float* g_fin; float* out; unsigned char* ws;
};

__device__ __forceinline__ bf16 f2bf(float f) { u32 u = __float_as_uint(f); return (bf16)((u + 0x7fffu + ((u >> 16) & 1u)) >> 16); }
__device__ __forceinline__ float bf2f(bf16 h) { return __uint_as_float((u32)h << 16); }
__device__ __forceinline__ u32 pk2(float lo, float hi) { return (u32)f2bf(lo) | ((u32)f2bf(hi) << 16); }
__device__ __forceinline__ float blo(u32 u) { return __uint_as_float(u << 16); }
__device__ __forceinline__ float bhi(u32 u) { return __uint_as_float(u & 0xffff0000u); }
__device__ __forceinline__ float wave_sum(float v) {
#pragma unroll
    for (int o = 1; o < 64; o <<= 1) v += __shfl_xor(v, o);
    return v;
}
__device__ __forceinline__ float dot8(uint4 a, uint4 b) {
    return blo(a.x) * blo(b.x) + bhi(a.x) * bhi(b.x) + blo(a.y) * blo(b.y) + bhi(a.y) * bhi(b.y) +
           blo(a.z) * blo(b.z) + bhi(a.z) * bhi(b.z) + blo(a.w) * blo(b.w) + bhi(a.w) * bhi(b.w);
}
__device__ __forceinline__ float gelu_tanh(float x) {
    const float u = 0.7978845608028654f * (x + 0.044715f * x * x * x);
    return x / (1.f + __expf(-2.f * u));
}
#define LDS_WAIT() asm volatile("s_waitcnt lgkmcnt(0)" ::: "memory")
__device__ __forceinline__ int lane_id_opaque() { int ln; asm volatile("v_mbcnt_lo_u32_b32 %0, -1, 0\n\tv_mbcnt_hi_u32_b32 %0, -1, %0" : "=v"(ln)); return ln; }

namespace pg8 {
typedef unsigned short bf16_t;
typedef short bf16x8 __attribute__((ext_vector_type(8)));
typedef float f32x4 __attribute__((ext_vector_type(4)));
typedef unsigned u32x4 __attribute__((ext_vector_type(4)));
typedef unsigned u32x2 __attribute__((ext_vector_type(2)));
constexpr int BM = 256, BK = 64, HALF = 128, HTB = HALF * BK * 2, STAGE_BYTES = 8 * HTB, NXCD = 8, WGM = 8;

__host__ __device__ __forceinline__ int lds_byte(int r, int c) { const int st = (r >> 4) * 2 + (c >> 5), rr = r & 15, cc = c & 31, ob = rr * 64 + cc * 2; return st * 1024 + (ob ^ (((ob >> 9) & 1) << 5)); }
__host__ __device__ __forceinline__ void stage_rc(int b, int& R, int& C) { const int st = b / 1024, sb = b % 1024, swz = sb ^ (((sb >> 9) & 1) << 5); R = (st >> 1) * 16 + swz / 64; C = (st & 1) * 32 + (swz % 64) / 2; }
__host__ __device__ __forceinline__ int perm32(int rho) { const int n = rho >> 4, i = rho & 15; return 8 * (i >> 2) + 4 * n + (i & 3); }

struct Unit { int pm, pn, e, r0, nvalid; };

struct StaticOrder {
    static constexpr bool GATHER = false;
    int nM, nN, nwg, G, c; const bf16_t* Bt;
    __device__ void init(int M, int N, int G_, int c_, const bf16_t* Bt_) { nM = M / BM; nN = N / BM; nwg = nM * nN; G = G_; c = c_; Bt = Bt_; }
    __device__ __forceinline__ bool next(int i, Unit& u) const {
        const long L = (long)i * G + c; if (L >= nwg) return false;
        int wgid = (int)L; { const int q = nwg / NXCD, r = nwg % NXCD, xcd = wgid % NXCD, off = wgid / NXCD; wgid = (xcd < r ? xcd * (q + 1) : r * (q + 1) + (xcd - r) * q) + off; }
        const int nig = WGM * nN, gid = wgid / nig, fm = gid * WGM, gsz = (nM - fm) < WGM ? (nM - fm) : WGM;
        u.pm = fm + ((wgid % nig) % gsz); u.pn = (wgid % nig) / gsz; u.e = 0; u.r0 = 0; u.nvalid = 256; return true;
    }
    __device__ __forceinline__ void a_offs(const Unit& u, int K, const int (&R)[2], const int (&C)[2], unsigned (&v)[2][2]) const {
#pragma unroll
        for (int h = 0; h < 2; ++h)
#pragma unroll
            for (int i = 0; i < 2; ++i) v[h][i] = (unsigned)((u.pm * BM + h * HALF + R[i]) * K + C[i]) * 2u;
    }
    __device__ __forceinline__ const char* b_ptr(const Unit& u, int K) const { return (const char*)(Bt + (size_t)u.pn * BM * K); }
};
template <bool GATHER_, int NN>
struct MoeOrder {
    static constexpr bool GATHER = GATHER_;
    const LAS int* tbl; const int* elist; const bf16_t* Bt; size_t estride; int G, c;
    __device__ __forceinline__ bool next(int i, Unit& u) const {
        const int L = i * G + c, nmt = tbl[32]; if (L >= nmt * NN) return false;
        const int mt = L / NN; u.pn = L % NN; u.pm = mt;
        int e = 0;
#pragma unroll 1
        while (tbl[e + 1] <= mt) ++e;
        u.e = e; u.r0 = (mt - tbl[e]) * 256; const int rem = tbl[33 + e] - u.r0; u.nvalid = rem < 256 ? rem : 256; return true;
    }
    __device__ __forceinline__ void a_offs(const Unit& u, int K, const int (&R)[2], const int (&C)[2], unsigned (&v)[2][2]) const {
#pragma unroll
        for (int h = 0; h < 2; ++h)
#pragma unroll
            for (int i = 0; i < 2; ++i) {
                const int r = h * HALF + R[i]; int row;
                if (GATHER) { row = 0; if (r < u.nvalid) row = elist[(size_t)u.e * NSLOT + u.r0 + r] >> 1; }
                else row = u.pm * BM + r;
                v[h][i] = (unsigned)(row * K + C[i]) * 2u;
            }
    }
    __device__ __forceinline__ const char* b_ptr(const Unit& u, int K) const { return (const char*)(Bt + (size_t)u.e * estride + (size_t)u.pn * BM * K); }
};

__device__ __forceinline__ unsigned cvt_pk_bf16(float lo, float hi) { unsigned r; asm volatile("v_cvt_pk_bf16_f32 %0, %1, %2" : "=v"(r) : "v"(lo), "v"(hi)); return r; }

struct EpiInProj {
    static constexpr bool PERM = true;
    bf16_t* O; const float* rstd; const float* rope; float* kmp;
    __device__ __forceinline__ void operator()(const f32x4 (&acc)[2][2][4][2], const Unit& u, int wr, int wc, int fr, int fq) const {
        const int mode = (u.pn >= 3 && u.pn <= 6) ? 1 : (u.pn >= 9 ? 2 : 0);
        const int row0 = u.pm * BM + wr * 64 + fr, col0 = u.pn * BM + wc * 32 + 8 * fq;
        const bool ropew = (mode == 1) && ((wc & 1) == 0);
        const bool ksum = (u.pn == 5 || u.pn == 6);
        float cs[2][8];
#pragma unroll
        for (int bj = 0; bj < 2; ++bj)
#pragma unroll
            for (int j = 0; j < 8; ++j) cs[bj][j] = 0.f;
#pragma unroll
        for (int ai = 0; ai < 2; ++ai)
#pragma unroll
            for (int m = 0; m < 4; ++m) {
                const int row = row0 + ai * HALF + m * 16; const float rs = rstd[row];
                bf16_t* rowp = O + (size_t)row * INC + col0;
#pragma unroll
                for (int bj = 0; bj < 2; ++bj) {
                    f32x4 v0 = acc[ai][bj][m][0] * rs, v1 = acc[ai][bj][m][1] * rs;
                    if (ropew) {
                        const f32x4* cs4 = (const f32x4*)(rope + (size_t)row * 16);
                        const f32x4 c0 = cs4[0], c1 = cs4[1], c2 = cs4[2], c3 = cs4[3];
                        f32x4 p0, p1;
#pragma unroll
                        for (int j = 0; j < 4; ++j) { p0[j] = __shfl_xor(v0[j], 16); p1[j] = __shfl_xor(v1[j], 16); }
                        const float sg = fq == 0 ? -1.f : 1.f;
                        if (fq < 2) {
                            v0[0] = v0[0] * c0[0] + sg * p0[0] * c0[1]; v0[1] = v0[1] * c0[2] + sg * p0[1] * c0[3];
                            v0[2] = v0[2] * c1[0] + sg * p0[2] * c1[1]; v0[3] = v0[3] * c1[2] + sg * p0[3] * c1[3];
                            v1[0] = v1[0] * c2[0] + sg * p1[0] * c2[1]; v1[1] = v1[1] * c2[2] + sg * p1[1] * c2[3];
                            v1[2] = v1[2] * c3[0] + sg * p1[2] * c3[1]; v1[3] = v1[3] * c3[2] + sg * p1[3] * c3[3];
                        }
                    }
                    if (ksum) {
#pragma unroll
                        for (int j = 0; j < 4; ++j) { cs[bj][j] += v0[j]; cs[bj][4 + j] += v1[j]; }
                    }
                    if (mode == 2) {
#pragma unroll
                        for (int j = 0; j < 4; ++j) { v0[j] = gelu_tanh(v0[j]); v1[j] = gelu_tanh(v1[j]); }
                    }
                    u32x4 w; w.x = cvt_pk_bf16(v0[0], v0[1]); w.y = cvt_pk_bf16(v0[2], v0[3]); w.z = cvt_pk_bf16(v1[0], v1[1]); w.w = cvt_pk_bf16(v1[2], v1[3]);
                    *(u32x4*)(rowp + bj * HALF) = w;
                }
                asm volatile("" ::: "memory");
            }
        if (ksum) {
#pragma unroll
            for (int bj = 0; bj < 2; ++bj)
#pragma unroll
                for (int j = 0; j < 8; ++j) { float v = cs[bj][j]; v += __shfl_xor(v, 1); v += __shfl_xor(v, 2); v += __shfl_xor(v, 4); v += __shfl_xor(v, 8); cs[bj][j] = v; }
            if (fr == 0) {
                const int bb = u.pm >> 3, blk = u.pm & 7;
#pragma unroll
                for (int bj = 0; bj < 2; ++bj) {
                    const int hh = (u.pn - 5) * 4 + bj * 2 + (wc >> 1), d0 = (wc & 1) * 32 + 8 * fq;
                    float* dst = kmp + (size_t)wr * (BATCH * 8 * 8 * 64) + ((size_t)((bb * 8 + hh) * 8 + blk)) * 64 + d0;
                    *(f32x4*)dst = (f32x4){cs[bj][0], cs[bj][1], cs[bj][2], cs[bj][3]}; *(f32x4*)(dst + 4) = (f32x4){cs[bj][4], cs[bj][5], cs[bj][6], cs[bj][7]};
                }
            }
        }
    }
};
struct EpiOutProj {
    static constexpr bool PERM = true;
    bf16_t* XB; bool dry;
    __device__ __forceinline__ void operator()(const f32x4 (&acc)[2][2][4][2], const Unit& u, int wr, int wc, int fr, int fq) const {
        const int row0 = u.pm * BM + wr * 64 + fr, col0 = u.pn * BM + wc * 32 + 8 * fq;
#pragma unroll
        for (int ai = 0; ai < 2; ++ai)
#pragma unroll
            for (int m = 0; m < 4; ++m) {
                bf16_t* rowp = XB + (size_t)(row0 + ai * HALF + m * 16) * D + col0;
#pragma unroll
                for (int bj = 0; bj < 2; ++bj) {
                    const u32x4 o = *(const u32x4*)(rowp + bj * HALF);
                    const f32x4 v0 = acc[ai][bj][m][0], v1 = acc[ai][bj][m][1];
                    u32x4 w;
                    w.x = cvt_pk_bf16(blo(o.x) + v0[0], bhi(o.x) + v0[1]); w.y = cvt_pk_bf16(blo(o.y) + v0[2], bhi(o.y) + v0[3]);
                    w.z = cvt_pk_bf16(blo(o.z) + v1[0], bhi(o.z) + v1[1]); w.w = cvt_pk_bf16(blo(o.w) + v1[2], bhi(o.w) + v1[3]);
                    if (!dry || w.x == 0x12345678u) *(u32x4*)(rowp + bj * HALF) = w;
                }
                asm volatile("" ::: "memory");
            }
    }
};
struct EpiMoe1 {
    static constexpr bool PERM = true;
    bf16_t* AB; const float* rstd2; const int* elist;
    __device__ __forceinline__ void operator()(const f32x4 (&acc)[2][2][4][2], const Unit& u, int wr, int wc, int fr, int fq) const {
        const int col0 = u.pn * HALF + wc * 32 + 8 * fq;
#pragma unroll
        for (int ai = 0; ai < 2; ++ai)
#pragma unroll
            for (int m = 0; m < 4; ++m) {
                const int r = ai * HALF + wr * 64 + m * 16 + fr;
                int tok = 0; if (r < u.nvalid) tok = elist[(size_t)u.e * NSLOT + u.r0 + r] >> 1;
                const float rs = rstd2[tok];
                float a[8];
#pragma unroll
                for (int n = 0; n < 2; ++n)
#pragma unroll
                    for (int j = 0; j < 4; ++j) { const float g = acc[ai][0][m][n][j] * rs, uu = acc[ai][1][m][n][j] * rs; a[n * 4 + j] = g / (1.f + __expf(-g)) * uu; }
                u32x4 w; w.x = cvt_pk_bf16(a[0], a[1]); w.y = cvt_pk_bf16(a[2], a[3]); w.z = cvt_pk_bf16(a[4], a[5]); w.w = cvt_pk_bf16(a[6], a[7]);
                *(u32x4*)(AB + (size_t)(u.pm * BM + r) * DE + col0) = w;
                asm volatile("" ::: "memory");
            }
    }
};
struct EpiMoe2 {
    static constexpr bool PERM = true;
    bf16_t* YS; const float* slotw; const int* elist;
    __device__ __forceinline__ void operator()(const f32x4 (&acc)[2][2][4][2], const Unit& u, int wr, int wc, int fr, int fq) const {
        const int col0 = u.pn * BM + wc * 32 + 8 * fq;
#pragma unroll
        for (int ai = 0; ai < 2; ++ai)
#pragma unroll
            for (int m = 0; m < 4; ++m) {
                const int r = ai * HALF + wr * 64 + m * 16 + fr;
                if (r < u.nvalid) {
                    const int slot = elist[(size_t)u.e * NSLOT + u.r0 + r]; const float w8 = slotw[slot];
#pragma unroll
                    for (int bj = 0; bj < 2; ++bj) {
                        const f32x4 v0 = acc[ai][bj][m][0] * w8, v1 = acc[ai][bj][m][1] * w8;
                        u32x4 w; w.x = cvt_pk_bf16(v0[0], v0[1]); w.y = cvt_pk_bf16(v0[2], v0[3]); w.z = cvt_pk_bf16(v1[0], v1[1]); w.w = cvt_pk_bf16(v1[2], v1[3]);
                        *(u32x4*)(YS + (size_t)slot * D + col0 + bj * HALF) = w;
                    }
                }
                asm volatile("" ::: "memory");
            }
    }
};

template <class Epi, class Sched, bool ALIGN_EPI>
__device__ __forceinline__ void gemm_phase(LAS unsigned char* lds, const bf16_t* Abase, const int K, const Sched& S, const Epi& E, const int wave) {
    int wid_ = wave; asm volatile("" : "+s"(wid_));
    const int lane = lane_id_opaque(), wid = wid_, tid = wid * 64 + lane, wr = wid >> 2, wc = wid & 3, fr = lane & 15, fq = lane >> 4;
    const int nt = K / BK;
    int Rr[2], Cc[2]; unsigned voffB[2];
#pragma unroll
    for (int i = 0; i < 2; ++i) { int R, C; stage_rc(tid * 16 + i * 8192, R, C); Rr[i] = R; Cc[i] = C; const int Rb = Epi::PERM ? ((R & ~31) + perm32(R & 31)) : R; voffB[i] = (unsigned)(Rb * K + C) * 2u; }
    const size_t kstep = (size_t)(BK * 2);
    const size_t hstep = (size_t)HALF * K * 2;
    const unsigned ldsw = (unsigned)wid * 1024u;
    const int aoff = lds_byte(wr * 64 + fr, fq * 8), boff = lds_byte(wc * 32 + fr, fq * 8);
#define PG8_SA(b, h) (((b) * 2 + (h)) * HTB)
#define PG8_SB(b, h) ((4 + (b) * 2 + (h)) * HTB)
#define PG8_STAGE(bufoff, gbase, voff) do { _Pragma("unroll") for (int _i = 0; _i < 2; ++_i) \
        __builtin_amdgcn_global_load_lds((const unsigned*)((const char*)(gbase) + (voff)[_i]), (LAS unsigned*)(lds + (bufoff) + ldsw + _i * 8192), 16, 0, 0); } while (0)
#define PG8_LDA(dst, b, h) do { _Pragma("unroll") for (int m = 0; m < 4; ++m) _Pragma("unroll") for (int k = 0; k < 2; ++k) dst[m][k] = *(const LAS bf16x8*)(lds + PG8_SA(b, h) + aoff + m * 2048 + k * 1024); } while (0)
#define PG8_LDB(dst, b, h) do { _Pragma("unroll") for (int n = 0; n < 2; ++n) _Pragma("unroll") for (int k = 0; k < 2; ++k) dst[n][k] = *(const LAS bf16x8*)(lds + PG8_SB(b, h) + boff + n * 2048 + k * 1024); } while (0)
#define PG8_MMA(ai, bj, At, Bt) do { __builtin_amdgcn_s_setprio(1); _Pragma("unroll") for (int m = 0; m < 4; ++m) _Pragma("unroll") for (int n = 0; n < 2; ++n) _Pragma("unroll") for (int k = 0; k < 2; ++k) \
        acc[ai][bj][m][n] = __builtin_amdgcn_mfma_f32_16x16x32_bf16(Bt[n][k], At[m][k], acc[ai][bj][m][n], 0, 0, 0); __builtin_amdgcn_s_setprio(0); } while (0)
#define PG8_WAIT_V(n) asm volatile("s_waitcnt vmcnt(" #n ")" ::: "memory")
#define PG8_WAIT_L(n) asm volatile("s_waitcnt lgkmcnt(" #n ")" ::: "memory")
#define PG8_BAR __builtin_amdgcn_s_barrier()
#define PG8_SCHED __builtin_amdgcn_sched_barrier(0)
    Unit cur, nxt; int ui = 0;
    if (!S.next(0, cur)) return;
    f32x4 acc[2][2][4][2];
#pragma unroll
    for (int a = 0; a < 2; ++a)
#pragma unroll
        for (int b = 0; b < 2; ++b)
#pragma unroll
            for (int m = 0; m < 4; ++m)
#pragma unroll
                for (int n = 0; n < 2; ++n) acc[a][b][m][n] = (f32x4){0.f, 0.f, 0.f, 0.f};
    bf16x8 At[4][2], B0[2][2], B1[2][2];
    unsigned vAc[2][2], vAn[2][2];
    unsigned voffA[2];
    const char* const A0 = (const char*)Abase; const char* cA = A0; const char* cB = S.b_ptr(cur, K);
    if constexpr (Sched::GATHER) S.a_offs(cur, K, Rr, Cc, vAc);
    else { voffA[0] = (unsigned)(Rr[0] * K + Cc[0]) * 2u; voffA[1] = (unsigned)(Rr[1] * K + Cc[1]) * 2u; cA = A0 + (size_t)cur.pm * 2 * hstep; }
#define PG8_STAGE_A(bufoff, koff, NEXT, h) do { if constexpr (Sched::GATHER) { unsigned _v[2] = {(NEXT) ? vAn[h][0] : vAc[h][0], (NEXT) ? vAn[h][1] : vAc[h][1]}; PG8_STAGE(bufoff, A0 + (koff), _v); } \
        else { PG8_STAGE(bufoff, ((NEXT) ? nA : cA) + (koff) + (h) * hstep, voffA); } } while (0)
    const char* nA = cA;
    PG8_STAGE(PG8_SB(0, 0), cB, voffB); PG8_STAGE(PG8_SB(0, 1), cB + hstep, voffB); PG8_STAGE_A(PG8_SA(0, 0), 0, false, 0); PG8_STAGE_A(PG8_SA(0, 1), 0, false, 1);
    if (wr == 1) PG8_BAR;
    PG8_WAIT_V(2); PG8_BAR;
    PG8_STAGE(PG8_SB(1, 0), cB + kstep, voffB); PG8_STAGE_A(PG8_SA(1, 0), kstep, false, 0); PG8_STAGE(PG8_SB(1, 1), cB + hstep + kstep, voffB);
    PG8_WAIT_V(6); PG8_BAR;
    for (;;) {
        const bool has_next = S.next(ui + 1, nxt);
        const char* nB = cB; nA = cA;
        if (has_next) {
            nB = S.b_ptr(nxt, K);
            if constexpr (Sched::GATHER) S.a_offs(nxt, K, Rr, Cc, vAn); else nA = A0 + (size_t)nxt.pm * 2 * hstep;
        } else if constexpr (Sched::GATHER) {
#pragma unroll
            for (int h = 0; h < 2; ++h)
#pragma unroll
                for (int i = 0; i < 2; ++i) vAn[h][i] = vAc[h][i];
        }
        for (int t = 0; t < nt; t += 2) {
            const bool last = (t == nt - 2);
            const size_t k1 = (size_t)(t + 1) * kstep, k2 = last ? 0 : (size_t)(t + 2) * kstep, k3 = k2 + kstep;
            const char* b2 = last ? nB : cB + (size_t)(t + 2) * kstep; const char* b3 = b2 + kstep;
            PG8_LDB(B0, 0, 0); PG8_LDB(B1, 0, 1); PG8_SCHED; PG8_LDA(At, 0, 0); PG8_STAGE_A(PG8_SA(1, 1), k1, false, 1);
            PG8_WAIT_V(8); PG8_WAIT_L(0); PG8_BAR; PG8_MMA(0, 0, At, B0); PG8_MMA(0, 1, At, B1); PG8_BAR; PG8_SCHED;
            PG8_LDA(At, 0, 1); PG8_STAGE(PG8_SB(0, 0), b2, voffB); PG8_STAGE(PG8_SB(0, 1), b2 + hstep, voffB); PG8_STAGE_A(PG8_SA(0, 0), k2, last, 0);
            PG8_WAIT_V(8); PG8_WAIT_L(0); PG8_BAR; PG8_MMA(1, 0, At, B0); PG8_MMA(1, 1, At, B1); PG8_BAR; PG8_SCHED;
            PG8_LDB(B0, 1, 0); PG8_LDB(B1, 1, 1); PG8_SCHED; PG8_LDA(At, 1, 0); PG8_STAGE_A(PG8_SA(0, 1), k2, last, 1);
            PG8_WAIT_V(8); PG8_WAIT_L(0); PG8_BAR; PG8_MMA(0, 0, At, B0); PG8_MMA(0, 1, At, B1); PG8_BAR; PG8_SCHED;
            PG8_LDA(At, 1, 1); PG8_STAGE(PG8_SB(1, 0), b3, voffB); PG8_STAGE(PG8_SB(1, 1), b3 + hstep, voffB); PG8_STAGE_A(PG8_SA(1, 0), k3, last, 0);
            PG8_WAIT_V(8); PG8_WAIT_L(0); PG8_BAR; PG8_MMA(1, 0, At, B0); PG8_MMA(1, 1, At, B1); PG8_BAR; PG8_SCHED;
        }
        if constexpr (ALIGN_EPI) { if (wr == 0) PG8_BAR; }
        E(acc, cur, wr, wc, fr, fq);
        if (!has_next) break;
#pragma unroll
        for (int a = 0; a < 2; ++a)
#pragma unroll
            for (int b = 0; b < 2; ++b)
#pragma unroll
                for (int m = 0; m < 4; ++m)
#pragma unroll
                    for (int n = 0; n < 2; ++n) acc[a][b][m][n] = (f32x4){0.f, 0.f, 0.f, 0.f};
        cur = nxt; cB = nB; cA = nA; ++ui;
        if constexpr (Sched::GATHER) {
#pragma unroll
            for (int h = 0; h < 2; ++h)
#pragma unroll
                for (int i = 0; i < 2; ++i) vAc[h][i] = vAn[h][i];
        }
        if constexpr (ALIGN_EPI) { if (wr == 1) PG8_BAR; }
    }
    PG8_WAIT_V(0);
    if constexpr (!ALIGN_EPI) { if (wr == 0) PG8_BAR; }
    PG8_BAR;
#undef PG8_SA
#undef PG8_SB
#undef PG8_STAGE
#undef PG8_STAGE_A
#undef PG8_LDA
#undef PG8_LDB
#undef PG8_MMA
#undef PG8_WAIT_V
#undef PG8_WAIT_L
#undef PG8_BAR
#undef PG8_SCHED
}
}

#define XB_TMO      128
#define XB_XCNT(j)  (256  + 64 * (j))
#define XB_XSUB(j)  (1280 + 64 * (j))
#define XB_XGEN(j)  (2304 + 64 * (j))
#define XB_TOP      3328
#define XB_TOPGEN   3392
#define XCD_BAR_WORDS 3456
#define XB_SPIN_CAP (1u << 18)
__device__ __forceinline__ unsigned xb_ld(unsigned* p)              { return __hip_atomic_load(p, __ATOMIC_RELAXED, __HIP_MEMORY_SCOPE_AGENT); }
__device__ __forceinline__ unsigned xb_add(unsigned* p, unsigned v) { return __hip_atomic_fetch_add(p, v, __ATOMIC_RELAXED, __HIP_MEMORY_SCOPE_AGENT); }
__device__ __forceinline__ unsigned xb_xcc_id() { return (unsigned)__builtin_amdgcn_s_getreg((3 << 11) | 20) & 0xFu; }
#define XB_SPIN(cond, bar) do { unsigned _sp = 0; while (cond) { __builtin_amdgcn_s_sleep(1); \
    if ((++_sp & 255u) == 0u) { if (xb_ld(&(bar)[XB_TMO])) break; if (_sp > XB_SPIN_CAP) { atomicAdd(&(bar)[XB_TMO], 1u); break; } } } } while (0)
struct XcdBarrier { unsigned* bar; unsigned x; volatile LAS unsigned* st; };
__device__ __forceinline__ XcdBarrier xcd_barrier_post(unsigned* bar, volatile LAS unsigned* st) {
    XcdBarrier b; b.bar = bar; b.x = xb_xcc_id(); b.st = st;
    if (threadIdx.x == 0) (void)xb_add(&bar[XB_XCNT(b.x)], 1u);
    return b;
}
__device__ __forceinline__ void xcd_barrier_complete(unsigned* bar, unsigned x, unsigned& nloc, unsigned& nx) {
    const unsigned G = gridDim.x * gridDim.y * gridDim.z;
    unsigned sum, cnt, mine, sp = 0u;
    for (;;) {
        sum = 0u; cnt = 0u; mine = 0u;
#pragma unroll
        for (unsigned j = 0; j < 16; ++j) { const unsigned c = xb_ld(&bar[XB_XCNT(j)]); sum += c; cnt += (c > 0u) ? 1u : 0u; mine = (j == x) ? c : mine; }
        if (sum == G) break;
        __builtin_amdgcn_s_sleep(1);
        if ((++sp & 255u) == 0u) { if (xb_ld(&bar[XB_TMO])) break; if (sp > XB_SPIN_CAP) { atomicAdd(&bar[XB_TMO], 1u); break; } }
    }
    nloc = mine > 0u ? mine : 1u; nx = cnt > 0u ? cnt : 1u;
}
__device__ __forceinline__ void xcd_barrier(const XcdBarrier& b, const bool t0  ) {
    asm volatile("s_waitcnt vmcnt(0)" ::: "memory");
    __syncthreads();
    if (t0) {
        unsigned* bar = b.bar;
        __builtin_amdgcn_s_waitcnt(0);
        unsigned nloc = b.st[0], nx = b.st[1];
        if (nloc == 0u) { xcd_barrier_complete(bar, b.x, nloc, nx); b.st[0] = nloc; b.st[1] = nx; }
        const unsigned old = xb_add(&bar[XB_XSUB(b.x)], 1u);
        const unsigned gen = old / nloc;
        if (old + 1u == (gen + 1u) * nloc) {
            __builtin_amdgcn_fence(__ATOMIC_RELEASE, "agent");
            asm volatile("s_waitcnt vmcnt(0)" ::: "memory");
            const unsigned og = xb_add(&bar[XB_TOP], 1u);
            const unsigned tg = og / nx;
            if (og + 1u == (tg + 1u) * nx) xb_add(&bar[XB_TOPGEN], 1u);
            else XB_SPIN(xb_ld(&bar[XB_TOPGEN]) == tg, bar);
            __builtin_amdgcn_fence(__ATOMIC_ACQUIRE, "agent");
            xb_add(&bar[XB_XGEN(b.x)], 1u);
            asm volatile("s_waitcnt vmcnt(0)" ::: "memory");
        } else {
            XB_SPIN(xb_ld(&bar[XB_XGEN(b.x)]) == gen, bar);
            __builtin_amdgcn_fence(__ATOMIC_ACQUIRE, "agent");
            asm volatile("s_waitcnt vmcnt(0)" ::: "memory");
        }
    }
    __syncthreads();
}

struct TrDesc { const float* W; bf16* WT; const float* scale; int K, N, mode, item; };
__device__ __forceinline__ void tr_load(const TrDesc& d, float4 (&v)[8], int lane) {
    const int nblk = d.N / 32, kb = d.item / nblk, nb = d.item % nblk, k0 = 64 * kb, n0 = 32 * nb;
    const float* src = d.W + (size_t)(k0 + (lane >> 3)) * d.N + n0 + (lane & 7) * 4;
#pragma unroll
    for (int i = 0; i < 8; ++i) v[i] = *(const float4*)(src + (size_t)(8 * i) * d.N);
}
__device__ __forceinline__ void tr_store(const TrDesc& d, const float4 (&v)[8], LAS float* scr, int lane) {
    const int nblk = d.N / 32, kb = d.item / nblk, nb = d.item % nblk, k0 = 64 * kb, n0 = 32 * nb;
    const int kr = lane >> 3, nq = lane & 7;
#pragma unroll
    for (int i = 0; i < 8; ++i) { LAS float* p = scr + (8 * i + kr) * 33 + 4 * nq; p[0] = v[i].x; p[1] = v[i].y; p[2] = v[i].z; p[3] = v[i].w; }
    LDS_WAIT();
    const int c = lane & 7;
    float sc[8];
#pragma unroll
    for (int e = 0; e < 8; ++e) sc[e] = d.scale ? d.scale[k0 + 8 * c + e] : 1.f;
#pragma unroll
    for (int j = 0; j < 4; ++j) {
        const int n = (lane >> 3) + 8 * j; const LAS float* s = scr + (8 * c) * 33 + n;
        uint4 o; o.x = pk2(s[0 * 33] * sc[0], s[1 * 33] * sc[1]); o.y = pk2(s[2 * 33] * sc[2], s[3 * 33] * sc[3]); o.z = pk2(s[4 * 33] * sc[4], s[5 * 33] * sc[5]); o.w = pk2(s[6 * 33] * sc[6], s[7 * 33] * sc[7]);
        const int ng = n0 + n;
        const int row = d.mode == 0 ? ng : ((ng >> 7) * 256 + (d.mode == 2 ? 128 : 0) + (ng & 127));
        *(uint4*)(d.WT + (size_t)row * d.K + k0 + 8 * c) = o;
    }
    LDS_WAIT();
}
constexpr int I_WIN = DEPTH * (D / 64) * (INC / 32);
constexpr int I_WOUT = DEPTH * (D / 64) * (D / 32);
constexpr int I_G = DEPTH * NE * (D / 64) * (DE / 32);
constexpr int I_D = DEPTH * NE * (DE / 64) * (D / 32);
constexpr int I_TOTAL = I_WIN + I_WOUT + 2 * I_G + I_D;

__device__ __forceinline__ void phase_prologue(const P& p, LAS unsigned char* lds, int gw, int NGW, int wave, int lane) {
    unsigned char* ws = p.ws;
    LAS float* scr = (LAS float*)(lds + wave * (64 * 33 * 4));
    auto desc = [&](int it) {
        TrDesc d; int r = it;
        if (r < I_WIN) { const int per = (D / 64) * (INC / 32), l = r / per; d = TrDesc{p.w_in + (size_t)l * D * INC, (bf16*)(ws + WS_WIN) + (size_t)l * INC * D, p.g_mix + l * D, D, INC, 0, r % per}; return d; }
        r -= I_WIN;
        if (r < I_WOUT) { const int per = (D / 64) * (D / 32), l = r / per; d = TrDesc{p.w_out + (size_t)l * D * D, (bf16*)(ws + WS_WOUT) + (size_t)l * D * D, nullptr, D, D, 0, r % per}; return d; }
        r -= I_WOUT;
        if (r < 2 * I_G) {
            const int up = r >= I_G; if (up) r -= I_G;
            const int per = (D / 64) * (DE / 32), le = r / per, l = le / NE;
            d = TrDesc{(up ? p.w_u : p.w_g) + (size_t)le * D * DE, (bf16*)(ws + WS_WGU) + (size_t)le * 1024 * 1024, p.g_ffn + l * D, D, DE, up ? 2 : 1, r % per}; return d;
        }
        r -= 2 * I_G;
        { const int per = (DE / 64) * (D / 32), le = r / per; d = TrDesc{p.w_d + (size_t)le * DE * D, (bf16*)(ws + WS_WD) + (size_t)le * 1024 * 512, nullptr, DE, D, 0, r % per}; return d; }
    };
    if (gw < I_TOTAL) {
        TrDesc dc = desc(gw); float4 vc[8]; tr_load(dc, vc, lane);
        for (int it = gw; it < I_TOTAL; it += NGW) {
            const int nx = it + NGW; TrDesc dn = dc; float4 vn[8];
            if (nx < I_TOTAL) { dn = desc(nx); tr_load(dn, vn, lane); }
            tr_store(dc, vc, scr, lane);
            dc = dn;
#pragma unroll
            for (int i = 0; i < 8; ++i) vc[i] = vn[i];
        }
    }
    for (int idx = gw * 64 + lane; idx < DEPTH * 36 * D; idx += NGW * 64) {
        const int k = idx % D, j = (idx / D) % 36, l = idx / (36 * D);
        const float v = (j < 4 ? p.w_rg[((size_t)l * D + k) * 4 + j] : p.w_re[((size_t)l * D + k) * NE + (j - 4)]) * p.g_ffn[l * D + k];
        const bf16 h = f2bf(v);
        ((bf16*)(ws + WS_WR))[idx] = h; ((bf16*)(ws + WS_WR))[DEPTH * 36 * D + idx] = f2bf(v - bf2f(h));
    }
    for (int idx = gw * 64 + lane; idx < T * 8; idx += NGW * 64) {
        const int i = idx & 7, t = idx >> 3;
        const float inv = exp2f(-(float)i * (18.931568569324174f / 8.f));
        const float ang = (float)p.pos[t] * inv;
        float sn, cs; sincosf(ang, &sn, &cs);
        float* r = (float*)(ws + WS_ROPE) + (size_t)idx * 2;
        r[0] = cs; r[1] = sn;
    }
    bf16* XB = (bf16*)(ws + WS_XB); float* RS = (float*)(ws + WS_RSTD);
    for (int m = gw; m < T; m += NGW) {
        const float4* xr = (const float4*)(p.x + (size_t)m * D) + lane; float4 v[4]; float s = 0.f;
#pragma unroll
        for (int j = 0; j < 4; ++j) { v[j] = xr[64 * j]; s += v[j].x * v[j].x + v[j].y * v[j].y + v[j].z * v[j].z + v[j].w * v[j].w; }
        s = wave_sum(s);
        if (lane == 0) RS[m] = rsqrtf(s * (1.f / D) + EPS);
#pragma unroll
        for (int j = 0; j < 4; ++j)
            ((uint2*)(XB + (size_t)m * D) + lane)[64 * j] = make_uint2(pk2(v[j].x, v[j].y), pk2(v[j].z, v[j].w));
    }
}

typedef float f32x4 __attribute__((ext_vector_type(4)));
__device__ __forceinline__ void phase_router(unsigned char* ws, LAS unsigned char* lds, int l, int vcu, int G, int wave, int lane, bool dry) {
    typedef short bf16x8 __attribute__((ext_vector_type(8)));
    typedef unsigned u32x4 __attribute__((ext_vector_type(4)));
    const int r = lane & 15, q = lane >> 4;
    for (int t4 = vcu; t4 < T / 64; t4 += G) {
        for (int pc = wave; pc < 144; pc += NWAVES) {
            const int img = pc >= 72, pp = pc - img * 72, row = pp >> 1, half = pp & 1;
            const bf16* src = (const bf16*)(ws + WS_WR) + (size_t)img * DEPTH * 36 * D + ((size_t)l * 36 + row) * D + half * 512 + lane * 8;
            __builtin_amdgcn_global_load_lds((const unsigned*)src, (LAS unsigned*)(lds + img * RT_IMG + row * RT_LD + half * 1024), 16, 0, 0);
        }
        asm volatile("s_waitcnt vmcnt(0)" ::: "memory");
        __syncthreads();
        const int tok0 = t4 * 64 + (wave & 3) * 16, kb = (wave >> 2) * 512;
        const bf16* X = (const bf16*)(ws + WS_XB) + (size_t)(tok0 + r) * D + kb + q * 8;
        f32x4 acc[3] = {{0.f, 0.f, 0.f, 0.f}, {0.f, 0.f, 0.f, 0.f}, {0.f, 0.f, 0.f, 0.f}};
        float ss = 0.f;
        int nrow[3] = {r, 16 + r, 32 + (r & 3)};
#pragma unroll 8
        for (int ks = 0; ks < 16; ++ks) {
            const u32x4 xh = *(const u32x4*)(X + ks * 32);
            ss += blo(xh[0]) * blo(xh[0]) + bhi(xh[0]) * bhi(xh[0]) + blo(xh[1]) * blo(xh[1]) + bhi(xh[1]) * bhi(xh[1]) + blo(xh[2]) * blo(xh[2]) + bhi(xh[2]) * bhi(xh[2]) + blo(xh[3]) * blo(xh[3]) + bhi(xh[3]) * bhi(xh[3]);
            const bf16x8 ah = __builtin_bit_cast(bf16x8, xh);
#pragma unroll
            for (int nt = 0; nt < 3; ++nt) {
                const LAS unsigned char* wp = lds + nrow[nt] * RT_LD + (kb + ks * 32 + q * 8) * 2;
                const bf16x8 bh = *(const LAS bf16x8*)wp, bl = *(const LAS bf16x8*)(wp + RT_IMG);
                acc[nt] = __builtin_amdgcn_mfma_f32_16x16x32_bf16(ah, bh, acc[nt], 0, 0, 0);
                acc[nt] = __builtin_amdgcn_mfma_f32_16x16x32_bf16(ah, bl, acc[nt], 0, 0, 0);
            }
        }
        ss += __shfl_xor(ss, 16); ss += __shfl_xor(ss, 32);
        __syncthreads();
        LAS float* lg = (LAS float*)lds + wave * (16 * 52);
#pragma unroll
        for (int nt = 0; nt < 3; ++nt)
#pragma unroll
            for (int reg = 0; reg < 4; ++reg) lg[(q * 4 + reg) * 52 + nt * 16 + r] = acc[nt][reg];
        if (q == 0) lg[r * 52 + 48] = ss;
        __syncthreads();
        if (wave < 4 && lane < 16 && !dry) {
            const int tok = tok0 + lane;
            const LAS float* L0 = (const LAS float*)lds + wave * (16 * 52) + lane * 52; const LAS float* L1 = L0 + 4 * (16 * 52);
            const float rs = rsqrtf((L0[48] + L1[48]) * (1.f / D) + EPS);
            ((float*)(ws + WS_RSTD2))[tok] = rs;
            float g0 = (L0[0] + L1[0]) * rs, g1 = (L0[1] + L1[1]) * rs, g2 = (L0[2] + L1[2]) * rs, g3 = (L0[3] + L1[3]) * rs;
            int gs = 0; float gm = g0;
            if (g1 > gm) { gm = g1; gs = 1; }
            if (g2 > gm) { gm = g2; gs = 2; }
            if (g3 > gm) { gm = g3; gs = 3; }
            const float pg = 1.f / (expf(g0 - gm) + expf(g1 - gm) + expf(g2 - gm) + expf(g3 - gm));
            float e[8];
#pragma unroll
            for (int j = 0; j < 8; ++j) e[j] = (L0[4 + gs * 8 + j] + L1[4 + gs * 8 + j]) * rs;
            int i1 = 0; float m1 = e[0];
#pragma unroll
            for (int j = 1; j < 8; ++j) if (e[j] > m1) { m1 = e[j]; i1 = j; }
            int i2 = -1; float m2 = -3e38f;
#pragma unroll
            for (int j = 0; j < 8; ++j) if (j != i1 && e[j] > m2) { m2 = e[j]; i2 = j; }
            const float p2 = expf(m2 - m1), inv = 1.f / (1.f + p2);
            const float w1 = pg * inv, w2 = pg * p2 * inv;
            const int e1 = gs * 8 + i1, e2 = gs * 8 + i2;
            u32* ecnt = (u32*)(ws + WS_CTL) + CW_ECNT + l * 32;
            int* elist = (int*)(ws + WS_ELIST);
            float* sw = (float*)(ws + WS_SLOTW);
            const u32 p1 = atomicAdd(ecnt + e1, 1u); elist[(size_t)e1 * NSLOT + p1] = tok * 2;
            const u32 p2i = atomicAdd(ecnt + e2, 1u); elist[(size_t)e2 * NSLOT + p2i] = tok * 2 + 1;
            sw[tok * 2] = w1; sw[tok * 2 + 1] = w2;
        }
        __syncthreads();
    }
}
__device__ __forceinline__ void phase_combine(const P& p, int l, int gw, int NGW, int lane, bool dry = false) {
    bf16* XB = (bf16*)(p.ws + WS_XB); float* RS = (float*)(p.ws + WS_RSTD);
    const bf16* YS = (const bf16*)(p.ws + WS_YS);
    for (int m = gw; m < T; m += NGW) {
        float4 v[4]; float s = 0.f;
#pragma unroll
        for (int j = 0; j < 4; ++j) {
            const uint2 x = ((const uint2*)(XB + (size_t)m * D) + lane)[64 * j];
            const uint2 a = ((const uint2*)(YS + (size_t)(2 * m) * D) + lane)[64 * j], b = ((const uint2*)(YS + (size_t)(2 * m + 1) * D) + lane)[64 * j];
            v[j].x = blo(x.x) + (blo(a.x) + blo(b.x)); v[j].y = bhi(x.x) + (bhi(a.x) + bhi(b.x)); v[j].z = blo(x.y) + (blo(a.y) + blo(b.y)); v[j].w = bhi(x.y) + (bhi(a.y) + bhi(b.y));
            s += v[j].x * v[j].x + v[j].y * v[j].y + v[j].z * v[j].z + v[j].w * v[j].w;
        }
        s = wave_sum(s);
        const float rs = rsqrtf(s * (1.f / D) + EPS);
        if (dry) { if (rs == 123.f) RS[m] = rs; }
        else if (l == DEPTH - 1) {
#pragma unroll
            for (int j = 0; j < 4; ++j) {
                const float4 g = ((const float4*)p.g_fin + lane)[64 * j];
                ((float4*)(p.out + (size_t)m * D) + lane)[64 * j] = make_float4(v[j].x * rs * g.x, v[j].y * rs * g.y, v[j].z * rs * g.z, v[j].w * rs * g.w);
            }
        } else {
            if (lane == 0) RS[m] = rs;
#pragma unroll
            for (int j = 0; j < 4; ++j) ((uint2*)(XB + (size_t)m * D) + lane)[64 * j] = make_uint2(pk2(v[j].x, v[j].y), pk2(v[j].z, v[j].w));
        }
    }
}

namespace mix {
typedef short bf16x8 __attribute__((ext_vector_type(8)));
typedef short s16x4 __attribute__((ext_vector_type(4)));
typedef float f32x16 __attribute__((ext_vector_type(16)));
typedef float f32x4 __attribute__((ext_vector_type(4)));
typedef unsigned u32x4 __attribute__((ext_vector_type(4)));
constexpr int L_K = 0, L_V = 16384, SLOTB = 8192;
constexpr int L_WSF = 32768;
constexpr int L_FLAG = 36864;
constexpr int L_KM = 37888;
constexpr int L_OST = 40960, OST_W = 32 * 68 * 4;
constexpr int L_VNT = 40960, VNT_LD = 136;
static_assert(L_OST + 8 * OST_W <= RING_BYTES, "mixer LDS map");
constexpr float NEG_INF = -__builtin_inff();

__device__ __forceinline__ int crow(int r, int hi) { return (r & 3) + 8 * (r >> 2) + 4 * hi; }
__device__ __forceinline__ unsigned cvtpk(float lo, float hi) { unsigned r; asm volatile("v_cvt_pk_bf16_f32 %0, %1, %2" : "=v"(r) : "v"(lo), "v"(hi)); return r; }
__device__ __forceinline__ s16x4 vtr(const LAS unsigned char* p) { typedef short v4i16_t __attribute__((ext_vector_type(4))); return __builtin_bit_cast(s16x4, __builtin_amdgcn_ds_read_tr16_b64_v4i16((LAS v4i16_t*)p)); }

__device__ __forceinline__ void dma_tile(LAS unsigned char* lds, const bf16* Kh, const bf16* Vh, int key0, int slot, int wave, int lane) {
    const bf16* ks = Kh + (size_t)(key0 + lane) * INC + wave * 8;
    const bf16* vs = Vh + (size_t)(key0 + 16 * (wave & 3) + (lane >> 2)) * INC + (wave >> 2) * 32 + (lane & 3) * 8;
    __builtin_amdgcn_global_load_lds((const unsigned*)ks, (LAS unsigned*)(lds + L_K + slot * SLOTB + wave * 1024), 16, 0, 0);
    __builtin_amdgcn_global_load_lds((const unsigned*)vs, (LAS unsigned*)(lds + L_V + slot * SLOTB + wave * 1024), 16, 0, 0);
}
__device__ __forceinline__ void qkt(f32x16& p0, f32x16& p1, const LAS unsigned char* kslot, const bf16x8 (&qr)[4], int r32, int hi) {
    const LAS unsigned char* kb = kslot + hi * 1024 + r32 * 16;
    bf16x8 k0[4], k1[4];
#pragma unroll
    for (int d0 = 0; d0 < 4; ++d0) { k0[d0] = *(const LAS bf16x8*)(kb + d0 * 2048); k1[d0] = *(const LAS bf16x8*)(kb + d0 * 2048 + 512); }
    p0 = (f32x16){0.f, 0.f, 0.f, 0.f, 0.f, 0.f, 0.f, 0.f, 0.f, 0.f, 0.f, 0.f, 0.f, 0.f, 0.f, 0.f}; p1 = p0;
#pragma unroll
    for (int d0 = 0; d0 < 4; ++d0) {
        p0 = __builtin_amdgcn_mfma_f32_32x32x16_bf16(k0[d0], qr[d0], p0, 0, 0, 0);
        p1 = __builtin_amdgcn_mfma_f32_32x32x16_bf16(k1[d0], qr[d0], p1, 0, 0, 0);
    }
}
__device__ __forceinline__ void pv(f32x16 (&o)[2], const LAS unsigned char* vslot, const u32x4 (&pa)[4], int lane) {
    const int hi = lane >> 5;
    const LAS unsigned char* vp = vslot + ((lane >> 4) & 1) * 32 + (lane & 3) * 8 + (4 * hi + ((lane & 15) >> 2)) * 64;
    s16x4 lo[2][4], hh[2][4];
#pragma unroll
    for (int d0 = 0; d0 < 2; ++d0)
#pragma unroll
        for (int ks = 0; ks < 4; ++ks) { lo[d0][ks] = vtr(vp + d0 * 4096 + ks * 1024); hh[d0][ks] = vtr(vp + d0 * 4096 + ks * 1024 + 512); }
#pragma unroll
    for (int ks = 0; ks < 4; ++ks)
#pragma unroll
        for (int d0 = 0; d0 < 2; ++d0) {
            const bf16x8 vb = (bf16x8){lo[d0][ks][0], lo[d0][ks][1], lo[d0][ks][2], lo[d0][ks][3], hh[d0][ks][0], hh[d0][ks][1], hh[d0][ks][2], hh[d0][ks][3]};
            o[d0] = __builtin_amdgcn_mfma_f32_32x32x16_bf16(__builtin_bit_cast(bf16x8, pa[ks]), vb, o[d0], 0, 0, 0);
        }
}
__device__ __forceinline__ void pack_p(u32x4 (&pa)[4], const f32x16& p0, const f32x16& p1) {
#pragma unroll
    for (int s = 0; s < 2; ++s) {
        pa[s] = (u32x4){cvtpk(p0[8 * s + 0], p0[8 * s + 1]), cvtpk(p0[8 * s + 2], p0[8 * s + 3]), cvtpk(p0[8 * s + 4], p0[8 * s + 5]), cvtpk(p0[8 * s + 6], p0[8 * s + 7])};
        pa[2 + s] = (u32x4){cvtpk(p1[8 * s + 0], p1[8 * s + 1]), cvtpk(p1[8 * s + 2], p1[8 * s + 3]), cvtpk(p1[8 * s + 4], p1[8 * s + 5]), cvtpk(p1[8 * s + 6], p1[8 * s + 7])};
    }
}
__device__ __forceinline__ void store_headnorm(LAS unsigned char* lds, const f32x16 (&o)[2], const LAS float* qs  , const float* gh  , bf16* onrow0  , int wave, int lane) {
    const int r32 = lane & 31, hi = lane >> 5;
    LAS float* st = (LAS float*)(lds + L_OST + wave * OST_W);
#pragma unroll
    for (int r = 0; r < 16; ++r) {
        const int q = crow(r, hi); const float s = qs ? qs[q] : 1.f;
        st[q * 68 + r32] = o[0][r] * s; st[q * 68 + 32 + r32] = o[1][r] * s;
    }
    LDS_WAIT();
    const int q = lane >> 1, part = lane & 1;
    f32x4 x[8]; float ss = 0.f;
#pragma unroll
    for (int i = 0; i < 8; ++i) { x[i] = *(const LAS f32x4*)(st + q * 68 + part * 32 + i * 4); ss += x[i][0] * x[i][0] + x[i][1] * x[i][1] + x[i][2] * x[i][2] + x[i][3] * x[i][3]; }
    ss += __shfl_xor(ss, 1);
    const float rs = rsqrtf(ss * (1.f / 64.f) + EPS);
    bf16* dst = onrow0 + (size_t)q * D + part * 32;
#pragma unroll
    for (int i = 0; i < 4; ++i) {
        const f32x4 g0 = *(const f32x4*)(gh + part * 32 + i * 8), g1 = *(const f32x4*)(gh + part * 32 + i * 8 + 4);
        const f32x4 a = x[2 * i] * rs * g0, b = x[2 * i + 1] * rs * g1;
        *(u32x4*)(dst + i * 8) = (u32x4){cvtpk(a[0], a[1]), cvtpk(a[2], a[3]), cvtpk(b[0], b[1]), cvtpk(b[2], b[3])};
    }
    LDS_WAIT();
}

__device__ __forceinline__ void moba_unit(LAS unsigned char* lds, const bf16* PR, bf16* ON, const float* KMP, const float* gh, int b, int h, int qb, int wave_, int lane_) {
    int wave = wave_; asm volatile("" : "+s"(wave)); const int lane = lane_id_opaque();
    const int r32 = lane & 31, hi = lane >> 5, tid = wave * 64 + lane;
    const size_t rowbase = (size_t)b * SEQ;
    const bf16* Qw = PR + (rowbase + qb * 256 + wave * 32) * INC + C_QB + h * 64;
    const bf16* Kh = PR + rowbase * INC + C_KB + h * 64; const bf16* Vh = PR + rowbase * INC + C_VB + h * 64;
    LAS float* km = (LAS float*)(lds + L_KM);
    LAS float* wsf = (LAS float*)(lds + L_WSF) + wave * 128;
    __syncthreads();
    dma_tile(lds, Kh, Vh, 0, 0, wave, lane);
    { const size_t o = ((size_t)(b * 8 + h) * 8) * 64 + tid; km[tid] = KMP[o] + KMP[(size_t)BATCH * 8 * 8 * 64 + o]; }
    bf16x8 qr[4];
#pragma unroll
    for (int ks = 0; ks < 4; ++ks) qr[ks] = *(const bf16x8*)(Qw + (size_t)r32 * INC + ks * 16 + hi * 8);
    __syncthreads();
    unsigned selmask = 0;
    {
        float b1 = NEG_INF, b2 = NEG_INF, b3 = NEG_INF; int i1 = -1, i2 = -1, i3 = -1;
#pragma unroll 1
        for (int j = 0; j < qb; ++j) {
            float s = 0.f;
#pragma unroll
            for (int ks = 0; ks < 4; ++ks)
#pragma unroll
                for (int e = 0; e < 8; ++e) s += bf2f((bf16)qr[ks][e]) * km[j * 64 + ks * 16 + hi * 8 + e];
            s += __shfl_xor(s, 32);
            if (s > b1) { b3 = b2; i3 = i2; b2 = b1; i2 = i1; b1 = s; i1 = j; }
            else if (s > b2) { b3 = b2; i3 = i2; b2 = s; i2 = j; }
            else if (s > b3) { b3 = s; i3 = j; }
        }
        if (i1 >= 0) selmask |= 1u << i1;
        if (i2 >= 0) selmask |= 1u << i2;
        if (i3 >= 0) selmask |= 1u << i3;
    }
    unsigned wneed = 0;
#pragma unroll
    for (int j = 0; j < 8; ++j) if (__any((selmask >> j) & 1u)) wneed |= 1u << j;
    wneed = __builtin_amdgcn_readfirstlane(wneed);
    float m = -1e30f, l = 0.f; f32x16 o[2];
    o[0] = (f32x16){0.f, 0.f, 0.f, 0.f, 0.f, 0.f, 0.f, 0.f, 0.f, 0.f, 0.f, 0.f, 0.f, 0.f, 0.f, 0.f}; o[1] = o[0];
    const int NT = 4 * (qb + 1);
    const float SC = 0.125f * 1.4426950408889634f;
    for (int tt = 0; tt < NT; ++tt) {
        asm volatile("s_waitcnt vmcnt(0)" ::: "memory");
        __syncthreads();
        if (tt + 1 < NT) dma_tile(lds, Kh, Vh, 64 * (tt + 1), (tt + 1) & 1, wave, lane);
        const int blk = tt >> 2; const bool own = blk == qb;
        const bool act = own ? ((tt & 3) <= (wave >> 1)) : ((wneed >> blk) & 1u);
        if (act) {
            f32x16 p0, p1;
            qkt(p0, p1, lds + L_K + (tt & 1) * SLOTB, qr, r32, hi);
            const bool diag = own && ((tt & 3) == (wave >> 1));
            float bias = (own || ((selmask >> blk) & 1u)) ? 0.f : NEG_INF;
            float rm;
            if (diag) {
                const int qrel = 32 * (wave & 1) + r32;
                rm = NEG_INF;
#pragma unroll
                for (int r = 0; r < 16; ++r) {
                    const int kk = crow(r, hi);
                    p0[r] = kk <= qrel ? p0[r] : NEG_INF; p1[r] = kk + 32 <= qrel ? p1[r] : NEG_INF;
                    rm = fmaxf(rm, fmaxf(p0[r], p1[r]));
                }
            } else {
                float a0 = fmaxf(fmaxf(p0[0], p0[1]), p1[0]), a1 = fmaxf(fmaxf(p0[2], p0[3]), p1[1]);
                a0 = fmaxf(fmaxf(a0, p1[2]), p1[3]);
#pragma unroll
                for (int r = 4; r < 16; r += 4) { a0 = fmaxf(fmaxf(a0, p0[r]), p0[r + 1]); a1 = fmaxf(fmaxf(a1, p0[r + 2]), p0[r + 3]); a0 = fmaxf(fmaxf(a0, p1[r]), p1[r + 1]); a1 = fmaxf(fmaxf(a1, p1[r + 2]), p1[r + 3]); }
                rm = fmaxf(a0, a1);
            }
            rm = rm * SC + bias;
            { const auto rr = __builtin_amdgcn_permlane32_swap(__float_as_uint(rm), __float_as_uint(rm), false, false); rm = fmaxf(__uint_as_float(rr[0]), __uint_as_float(rr[1])); }
            if (__any(rm > m + 8.f)) {
                const float mn = rm > m + 8.f ? rm : m, alpha = __builtin_amdgcn_exp2f(m - mn);
                m = mn; l *= alpha;
                if (hi == 0) wsf[r32] = alpha;
                LDS_WAIT();
#pragma unroll
                for (int r = 0; r < 16; ++r) { const float a = wsf[crow(r, hi)]; o[0][r] *= a; o[1][r] *= a; }
            }
            const float nb = bias - m;
            float rs0 = 0.f, rs1 = 0.f;
#pragma unroll
            for (int r = 0; r < 16; ++r) { p0[r] = __builtin_amdgcn_exp2f(p0[r] * SC + nb); p1[r] = __builtin_amdgcn_exp2f(p1[r] * SC + nb); rs0 += p0[r]; rs1 += p1[r]; }
            l += rs0 + rs1;
            u32x4 pa[4]; pack_p(pa, p0, p1);
            pv(o, lds + L_V + (tt & 1) * SLOTB, pa, lane);
        }
    }
    { const auto rr = __builtin_amdgcn_permlane32_swap(__float_as_uint(l), __float_as_uint(l), false, false); l = __uint_as_float(rr[0]) + __uint_as_float(rr[1]); }
    if (hi == 0) wsf[32 + r32] = 1.f / l;
    LDS_WAIT();
    store_headnorm(lds, o, wsf + 32, gh, ON + (rowbase + qb * 256 + wave * 32) * D + 256 + h * 64, wave, lane);
}

__device__ __forceinline__ void sb_unit(LAS unsigned char* lds, const bf16* PR, bf16* ON, const float* gh, int b, int h, int qb, int wave_, int lane_) {
    int wave = wave_; asm volatile("" : "+s"(wave)); const int lane = lane_id_opaque();
    const int r32 = lane & 31, hi = lane >> 5;
    const size_t rowbase = (size_t)b * SEQ;
    const bf16* Qw = PR + (rowbase + qb * 256 + wave * 32) * INC + C_QA + h * 64;
    const bf16* Kh = PR + rowbase * INC + C_KA + h * 64; const bf16* Vh = PR + rowbase * INC + C_VA + h * 64;
    volatile LAS int* flag = (volatile LAS int*)(lds + L_FLAG);
    __syncthreads();
    const int jt0 = 4 * qb + 3, jtd = 4 * qb + (wave >> 1);
    dma_tile(lds, Kh, Vh, 64 * jt0, 0, wave, lane);
    bf16x8 qr[4];
#pragma unroll
    for (int ks = 0; ks < 4; ++ks) qr[ks] = *(const bf16x8*)(Qw + (size_t)r32 * INC + ks * 16 + hi * 8);
    float L = 0.f; f32x16 o[2];
    o[0] = (f32x16){0.f, 0.f, 0.f, 0.f, 0.f, 0.f, 0.f, 0.f, 0.f, 0.f, 0.f, 0.f, 0.f, 0.f, 0.f, 0.f}; o[1] = o[0];
    bool active = true;
    for (int step = 0;; ++step) {
        const int jt = jt0 - step;
        asm volatile("s_waitcnt vmcnt(0)" ::: "memory");
        __syncthreads();
        if (step > 0) { int any = 0;
#pragma unroll
            for (int w = 0; w < 8; ++w) any |= flag[((step - 1) & 1) * 8 + w];
            if (!any) break; }
        if (jt < 0) break;
        if (jt > 0) dma_tile(lds, Kh, Vh, 64 * (jt - 1), (step + 1) & 1, wave, lane);
        if (active && jt <= jtd) {
            f32x16 p0, p1;
            qkt(p0, p1, lds + L_K + (step & 1) * SLOTB, qr, r32, hi);
            const int trel = 256 * qb + 32 * wave + r32 - 64 * jt;
            float gs[8];
#pragma unroll
            for (int k = 0; k < 8; ++k) gs[k] = 0.f;
            f32x16 q0, q1;
#pragma unroll
            for (int r = 0; r < 16; ++r) {
                const int kk = crow(r, hi);
                { const float z = p0[r] * 0.125f, l1p = __logf(1.f + __expf(-fabsf(z))); const bool v = kk < trel;
                  q0[r] = v ? fminf(-z, 0.f) - l1p : 0.f; p0[r] = v ? fminf(z, 0.f) - l1p : NEG_INF; gs[r >> 2] += q0[r]; }
                { const float z = p1[r] * 0.125f, l1p = __logf(1.f + __expf(-fabsf(z))); const bool v = kk + 32 < trel;
                  q1[r] = v ? fminf(-z, 0.f) - l1p : 0.f; p1[r] = v ? fminf(z, 0.f) - l1p : NEG_INF; gs[4 + (r >> 2)] += q1[r]; }
            }
            float aft[8]; float run = 0.f;
#pragma unroll
            for (int k = 7; k >= 0; --k) { const float og = __shfl_xor(gs[k], 32); aft[k] = run + (hi == 0 ? og : 0.f); run += gs[k] + og; }
#pragma unroll
            for (int k = 0; k < 4; ++k) {
                float a = L + aft[k];
                p0[4 * k + 3] = __expf(p0[4 * k + 3] + a); a += q0[4 * k + 3];
                p0[4 * k + 2] = __expf(p0[4 * k + 2] + a); a += q0[4 * k + 2];
                p0[4 * k + 1] = __expf(p0[4 * k + 1] + a); a += q0[4 * k + 1];
                p0[4 * k + 0] = __expf(p0[4 * k + 0] + a);
                float c = L + aft[4 + k];
                p1[4 * k + 3] = __expf(p1[4 * k + 3] + c); c += q1[4 * k + 3];
                p1[4 * k + 2] = __expf(p1[4 * k + 2] + c); c += q1[4 * k + 2];
                p1[4 * k + 1] = __expf(p1[4 * k + 1] + c); c += q1[4 * k + 1];
                p1[4 * k + 0] = __expf(p1[4 * k + 0] + c);
            }
            L += run;
            u32x4 pa[4]; pack_p(pa, p0, p1);
            pv(o, lds + L_V + (step & 1) * SLOTB, pa, lane);
            if (__all(L < -88.f)) active = false;
        }
        if (lane == 0) flag[(step & 1) * 8 + wave] = (active && jt > 0) ? 1 : 0;
    }
    store_headnorm(lds, o, nullptr, gh, ON + (rowbase + qb * 256 + wave * 32) * D + h * 64, wave, lane);
}

__device__ __forceinline__ void gmlp_unit(LAS unsigned char* lds, const bf16* PR, bf16* ON, const float* gvn  , const float* wsp  , const float* bsp  , const float* gh  , int b, int c, int g, int wave_, int lane_) {
    int wave = wave_; asm volatile("" : "+s"(wave)); const int lane = lane_id_opaque();
    const int tid = wave * 64 + lane;
    const size_t row0 = (size_t)b * SEQ + c * 128;
    LAS bf16* vnT = (LAS bf16*)(lds + L_VNT);
    __syncthreads();
    {
        const int s = tid >> 2, part = tid & 3;
        const bf16* vr = PR + (row0 + s) * INC + C_VC + g * 64 + part * 16;
        const uint4 a = *(const uint4*)vr, bq = *(const uint4*)(vr + 8);
        float x[16] = {blo(a.x), bhi(a.x), blo(a.y), bhi(a.y), blo(a.z), bhi(a.z), blo(a.w), bhi(a.w), blo(bq.x), bhi(bq.x), blo(bq.y), bhi(bq.y), blo(bq.z), bhi(bq.z), blo(bq.w), bhi(bq.w)};
        float ss = 0.f;
#pragma unroll
        for (int i = 0; i < 16; ++i) ss += x[i] * x[i];
        ss += __shfl_xor(ss, 1); ss += __shfl_xor(ss, 2);
        const float rs = rsqrtf(ss * (1.f / 64.f) + EPS);
#pragma unroll
        for (int i = 0; i < 16; ++i) vnT[(part * 16 + i) * VNT_LD + s] = f2bf(x[i] * rs * gvn[part * 16 + i]);
    }
    __syncthreads();
    const int fr = lane & 15, fq = lane >> 4, t = 16 * wave + fr;
    f32x4 acc[4] = {{0.f, 0.f, 0.f, 0.f}, {0.f, 0.f, 0.f, 0.f}, {0.f, 0.f, 0.f, 0.f}, {0.f, 0.f, 0.f, 0.f}};
    const int nks = (wave >> 1) + 1;
    for (int ks = 0; ks < nks; ++ks) {
        const int s0 = 32 * ks + 8 * fq;
        const f32x4 w0 = *(const f32x4*)(wsp + (size_t)t * 128 + s0), w1 = *(const f32x4*)(wsp + (size_t)t * 128 + s0 + 4);
        float wv[8] = {w0[0], w0[1], w0[2], w0[3], w1[0], w1[1], w1[2], w1[3]};
#pragma unroll
        for (int j = 0; j < 8; ++j) if (s0 + j > t) wv[j] = 0.f;
        const u32x4 au = (u32x4){cvtpk(wv[0], wv[1]), cvtpk(wv[2], wv[3]), cvtpk(wv[4], wv[5]), cvtpk(wv[6], wv[7])};
#pragma unroll
        for (int n = 0; n < 4; ++n) {
            const bf16x8 bv = *(const LAS bf16x8*)(vnT + (16 * n + fr) * VNT_LD + s0);
            acc[n] = __builtin_amdgcn_mfma_f32_16x16x32_bf16(__builtin_bit_cast(bf16x8, au), bv, acc[n], 0, 0, 0);
        }
    }
    __syncthreads();
    LAS float* st = (LAS float*)(lds + L_OST + wave * OST_W);
#pragma unroll
    for (int reg = 0; reg < 4; ++reg) {
        const int tl = 4 * fq + reg, tt = 16 * wave + tl; const float bb = bsp[tt];
#pragma unroll
        for (int n = 0; n < 4; ++n) st[tl * 68 + 16 * n + fr] = acc[n][reg] + bb;
    }
    LDS_WAIT();
    {
        const int tl = lane >> 2, part = lane & 3, tt = 16 * wave + tl;
        const bf16* ur = PR + (row0 + tt) * INC + C_UC + g * 64 + part * 16;
        const uint4 ua = *(const uint4*)ur, ub = *(const uint4*)(ur + 8);
        const float u[16] = {blo(ua.x), bhi(ua.x), blo(ua.y), bhi(ua.y), blo(ua.z), bhi(ua.z), blo(ua.w), bhi(ua.w), blo(ub.x), bhi(ub.x), blo(ub.y), bhi(ub.y), blo(ub.z), bhi(ub.z), blo(ub.w), bhi(ub.w)};
        float v[16]; float ss = 0.f;
#pragma unroll
        for (int i = 0; i < 4; ++i) { const f32x4 m4 = *(const LAS f32x4*)(st + tl * 68 + part * 16 + i * 4);
#pragma unroll
            for (int j = 0; j < 4; ++j) { v[4 * i + j] = u[4 * i + j] * m4[j]; ss += v[4 * i + j] * v[4 * i + j]; } }
        ss += __shfl_xor(ss, 1); ss += __shfl_xor(ss, 2);
        const float rs = rsqrtf(ss * (1.f / 64.f) + EPS);
        bf16* dst = ON + (row0 + tt) * D + 768 + g * 64 + part * 16;
#pragma unroll
        for (int i = 0; i < 2; ++i) {
            const f32x4 g0 = *(const f32x4*)(gh + part * 16 + i * 8), g1 = *(const f32x4*)(gh + part * 16 + i * 8 + 4);
            *(u32x4*)(dst + i * 8) = (u32x4){cvtpk(v[8 * i + 0] * rs * g0[0], v[8 * i + 1] * rs * g0[1]), cvtpk(v[8 * i + 2] * rs * g0[2], v[8 * i + 3] * rs * g0[3]),
                                             cvtpk(v[8 * i + 4] * rs * g1[0], v[8 * i + 5] * rs * g1[1]), cvtpk(v[8 * i + 6] * rs * g1[2], v[8 * i + 7] * rs * g1[3])};
        }
    }
    LDS_WAIT();
}
}
__device__ __forceinline__ const void* lptr(LAS unsigned char* lds, int k) {
    const unsigned long long v = ((const LAS unsigned long long*)(lds + LDS_PTRS))[k];
    const unsigned lo = __builtin_amdgcn_readfirstlane((unsigned)v), hi = __builtin_amdgcn_readfirstlane((unsigned)(v >> 32));
    return (const void*)(((unsigned long long)hi << 32) | lo);
}
__device__ __forceinline__ P load_params(LAS unsigned char* lds, unsigned char* ws) {
    P q;
    q.x = (const float*)lptr(lds, 0); q.pos = (const int*)lptr(lds, 1); q.w_in = (const float*)lptr(lds, 2); q.w_out = (const float*)lptr(lds, 3);
    q.g_mix = (const float*)lptr(lds, 4); q.g_head = (const float*)lptr(lds, 5); q.g_vn = (const float*)lptr(lds, 6); q.w_sp = (const float*)lptr(lds, 7);
    q.b_sp = (const float*)lptr(lds, 8); q.g_ffn = (const float*)lptr(lds, 9); q.w_rg = (const float*)lptr(lds, 10); q.w_re = (const float*)lptr(lds, 11);
    q.w_g = (const float*)lptr(lds, 12); q.w_u = (const float*)lptr(lds, 13); q.w_d = (const float*)lptr(lds, 14); q.g_fin = (const float*)lptr(lds, 15);
    q.out = (float*)lptr(lds, 16); q.ws = ws;
    return q;
}
#ifndef REP_P
#define REP_P 1
#endif
#ifndef REP_A
#define REP_A 1
#endif
#ifndef REP_B
#define REP_B 1
#endif
#ifndef REP_E
#define REP_E 1
#endif
#ifndef REP_F
#define REP_F 1
#endif
#ifndef REP_D
#define REP_D 1
#endif
#ifndef REP_G
#define REP_G 1
#endif
#ifndef REP_C
#define REP_C 1
#endif
#ifndef REP_MOBA
#define REP_MOBA 1
#endif
#ifndef REP_SB
#define REP_SB 1
#endif
#ifndef REP_GM
#define REP_GM 1
#endif
constexpr int NSTEPS = 1 + 7 * DEPTH;
__global__ void __launch_bounds__(NWAVES * 64, 2) mk(P p, int s_lo, int s_hi, int bar_region, int mix_mask) {
    extern __shared__ __attribute__((aligned(16))) unsigned char lds_raw[];
    LAS unsigned char* lds = (LAS unsigned char*)lds_raw;
    const int wave = __builtin_amdgcn_readfirstlane(threadIdx.x >> 6);
    const int G = gridDim.x, bx = blockIdx.x;
    const int vcu = (G % 8 == 0) ? (bx % 8) * (G / 8) + bx / 8 : bx;
    const int gw = vcu * NWAVES + wave, NGW = G * NWAVES;
    unsigned char* ws = p.ws;
    volatile LAS unsigned* misc = (volatile LAS unsigned*)(lds + LDS_MISC);
    if (threadIdx.x < 4) misc[threadIdx.x] = 0u;
    if (threadIdx.x == 0) {
        LAS unsigned long long* pp = (LAS unsigned long long*)(lds + LDS_PTRS);
        pp[0] = (unsigned long long)p.x; pp[1] = (unsigned long long)p.pos; pp[2] = (unsigned long long)p.w_in; pp[3] = (unsigned long long)p.w_out;
        pp[4] = (unsigned long long)p.g_mix; pp[5] = (unsigned long long)p.g_head; pp[6] = (unsigned long long)p.g_vn; pp[7] = (unsigned long long)p.w_sp;
        pp[8] = (unsigned long long)p.b_sp; pp[9] = (unsigned long long)p.g_ffn; pp[10] = (unsigned long long)p.w_rg; pp[11] = (unsigned long long)p.w_re;
        pp[12] = (unsigned long long)p.w_g; pp[13] = (unsigned long long)p.w_u; pp[14] = (unsigned long long)p.w_d; pp[15] = (unsigned long long)p.g_fin;
        pp[16] = (unsigned long long)p.out;
    }
    __syncthreads();
    XcdBarrier bar = xcd_barrier_post((unsigned*)(ws + WS_CTL) + CW_BAR + bar_region * XCD_BAR_WORDS, misc);
#define IN(k) (s_lo <= (k) && (k) < s_hi)
#define SEAM(k) do { if (IN(k) && IN((k) + 1)) xcd_barrier(bar, wave == 0 && lane_id_opaque() == 0); } while (0)

#define OPQ_WS(name) unsigned char* name = ws; asm volatile("" : "+s"(name))
#define OPQ_LDS(name) LAS unsigned char* name = lds; asm volatile("" : "+s"(name))
#define OPQ_LANE(name) const int name = lane_id_opaque()
    if (IN(0)) for (int rep = 0; rep < REP_P; ++rep) { OPQ_WS(w); OPQ_LDS(ld); OPQ_LANE(ln); const P q = load_params(ld, w); phase_prologue(q, ld, gw, NGW, wave, ln); __syncthreads(); }
    SEAM(0);
#pragma unroll 1
    for (int l = 0; l < DEPTH; ++l) {
        const int s0 = 1 + 7 * l;
        if (IN(s0 + 0)) for (int rep = 0; rep < REP_A; ++rep) {
            OPQ_WS(w); OPQ_LDS(ld);
            pg8::StaticOrder S; S.init(T, INC, G, bx, (const bf16*)(w + WS_WIN) + (size_t)l * INC * D);
            pg8::EpiInProj E{(bf16*)(w + WS_PROJ), (const float*)(w + WS_RSTD), (const float*)(w + WS_ROPE), (float*)(w + WS_KMEAN)};
            pg8::gemm_phase<pg8::EpiInProj, pg8::StaticOrder, true>(ld, (const bf16*)(w + WS_XB), D, S, E, wave);
        }
        SEAM(s0 + 0);
        if (IN(s0 + 1)) for (int rep = 0; rep < REP_B; ++rep) {
            OPQ_WS(w); OPQ_LDS(ld); OPQ_LANE(ln);
            int wv = wave; asm volatile("" : "+s"(wv));
            const bf16* PR = (const bf16*)(w + WS_PROJ); bf16* ON = (bf16*)(w + WS_ON);
            const float* ghead = (const float*)lptr(ld, 5) + (size_t)l * 16 * 64;
            if (mix_mask & 1) for (int r2 = 0; r2 < REP_MOBA; ++r2) {
                for (int u = vcu; u < 256; u += G) {
                    const int bh = u >> 2, i = u & 3;
                    mix::moba_unit(ld, PR, ON, (const float*)(w + WS_KMEAN), ghead + (4 + (bh & 7)) * 64, bh >> 3, bh & 7, 7 - i, wv, ln);
                    mix::moba_unit(ld, PR, ON, (const float*)(w + WS_KMEAN), ghead + (4 + (bh & 7)) * 64, bh >> 3, bh & 7, i, wv, ln);
                }
            }
            if (mix_mask & 2) for (int r2 = 0; r2 < REP_SB; ++r2) {
                for (int u = vcu; u < 256; u += G) mix::sb_unit(ld, PR, ON, ghead + ((u >> 3) & 3) * 64, u >> 5, (u >> 3) & 3, u & 7, wv, ln);
            }
            if (mix_mask & 4) for (int r2 = 0; r2 < REP_GM; ++r2) {
                const float* gvn = (const float*)lptr(ld, 6) + (size_t)l * 4 * 64;
                const float* wsp = (const float*)lptr(ld, 7) + (size_t)l * 4 * 128 * 128;
                const float* bsp = (const float*)lptr(ld, 8) + (size_t)l * 4 * 128;
                for (int u = vcu; u < 512; u += G) {
                    const int g = u & 3, c = (u >> 2) & 15, b = u >> 6;
                    mix::gmlp_unit(ld, PR, ON, gvn + g * 64, wsp + (size_t)g * 128 * 128, bsp + g * 128, ghead + (12 + g) * 64, b, c, g, wv, ln);
                }
            }
            __syncthreads();
        }
        SEAM(s0 + 1);
        if (IN(s0 + 2)) for (int rep = 0; rep < REP_C; ++rep) {
            OPQ_WS(w); OPQ_LDS(ld);
            pg8::StaticOrder S; S.init(T, D, G, bx, (const bf16*)(w + WS_WOUT) + (size_t)l * D * D);
            pg8::EpiOutProj E{(bf16*)(w + WS_XB), rep + s_lo < REP_C - 1};
            pg8::gemm_phase<pg8::EpiOutProj, pg8::StaticOrder, false>(ld, (const bf16*)(w + WS_ON), D, S, E, wave);
        }
        SEAM(s0 + 2);
        if (IN(s0 + 3)) {
            OPQ_WS(w); OPQ_LDS(ld); OPQ_LANE(ln);
            int wv = wave; asm volatile("" : "+s"(wv));
            for (int rep = 0; rep < REP_D; ++rep) phase_router(w, ld, l, vcu, G, wv, ln, rep + s_lo < REP_D - 1);
        }
        SEAM(s0 + 3);
        if (IN(s0 + 4) || IN(s0 + 5)) {
            { OPQ_WS(w); OPQ_LDS(ld);
              LAS int* tbl = (LAS int*)(ld + LDS_TBL);
              __syncthreads();
              if (wave == 0 && lane_id_opaque() == 0) {
                  const u32* ecnt = (const u32*)(w + WS_CTL) + CW_ECNT + l * 32; int base = 0;
                  for (int e = 0; e < NE; ++e) { const int c = (int)__hip_atomic_load(ecnt + e, __ATOMIC_RELAXED, __HIP_MEMORY_SCOPE_AGENT); tbl[e] = base; tbl[33 + e] = c; base += (c + 255) >> 8; }
                  tbl[32] = base;
              }
              __syncthreads(); }
            if (IN(s0 + 4)) for (int rep = 0; rep < REP_E; ++rep) {
                OPQ_WS(w); OPQ_LDS(ld);
                pg8::MoeOrder<true, 4> S{(const LAS int*)(ld + LDS_TBL), (const int*)(w + WS_ELIST), (const bf16*)(w + WS_WGU) + (size_t)l * NE * 1024 * 1024, (size_t)1024 * 1024, G, bx};
                pg8::EpiMoe1 E{(bf16*)(w + WS_ABUF), (const float*)(w + WS_RSTD2), (const int*)(w + WS_ELIST)};
                pg8::gemm_phase<pg8::EpiMoe1, pg8::MoeOrder<true, 4>, true>(ld, (const bf16*)(w + WS_XB), D, S, E, wave);
            }
            SEAM(s0 + 4);
            if (IN(s0 + 5)) for (int rep = 0; rep < REP_F; ++rep) {
                OPQ_WS(w); OPQ_LDS(ld);
                pg8::MoeOrder<false, 4> S{(const LAS int*)(ld + LDS_TBL), (const int*)(w + WS_ELIST), (const bf16*)(w + WS_WD) + (size_t)l * NE * 1024 * 512, (size_t)1024 * 512, G, bx};
                pg8::EpiMoe2 E{(bf16*)(w + WS_YS), (const float*)(w + WS_SLOTW), (const int*)(w + WS_ELIST)};
                pg8::gemm_phase<pg8::EpiMoe2, pg8::MoeOrder<false, 4>, true>(ld, (const bf16*)(w + WS_ABUF), DE, S, E, wave);
            }
        }
        SEAM(s0 + 5);
        if (IN(s0 + 6)) { OPQ_WS(w); OPQ_LDS(ld); OPQ_LANE(ln); const P q = load_params(ld, w); for (int rep = 0; rep < REP_G; ++rep) phase_combine(q, l, gw, NGW, ln, rep + s_lo < REP_G - 1); }
        SEAM(s0 + 6);
    }
#undef IN
#undef SEAM
}

__global__ void k_kmean_naive(P p) {
    const int idx = blockIdx.x * blockDim.x + threadIdx.x;
    const int d = idx & 63, blk = (idx >> 6) & 7, h = (idx >> 9) & 7, b = idx >> 12;
    const bf16* PR = (const bf16*)(p.ws + WS_PROJ);
    float s = 0.f;
    for (int j = 0; j < 256; ++j) s += bf2f(PR[(size_t)(b * SEQ + blk * 256 + j) * INC + C_KB + h * 64 + d]);
    ((float*)(p.ws + WS_KMEAN + 262144))[idx] = s * (1.f / 256.f);
}
__global__ void __launch_bounds__(64) k_sb_naive(P p) {
    const int idx = blockIdx.x * 64 + threadIdx.x;
    const int t = idx % SEQ, h = (idx / SEQ) % 4, b = idx / (SEQ * 4);
    const bf16* PR = (const bf16*)(p.ws + WS_PROJ);
    const size_t row = (size_t)b * SEQ + t;
    uint4 q[8];
#pragma unroll
    for (int i = 0; i < 8; ++i) q[i] = *(const uint4*)(PR + row * INC + C_QA + h * 64 + i * 8);
    float acc[64];
#pragma unroll
    for (int i = 0; i < 64; ++i) acc[i] = 0.f;
    float L = 0.f;
    for (int s = t - 1; s >= 0; --s) {
        const bf16* kr = PR + ((size_t)b * SEQ + s) * INC + C_KA + h * 64;
        const bf16* vr = PR + ((size_t)b * SEQ + s) * INC + C_VA + h * 64;
        float z = 0.f;
#pragma unroll
        for (int i = 0; i < 8; ++i) z += dot8(q[i], *(const uint4*)(kr + i * 8));
        z *= 0.125f;
        const float l1p = log1pf(expf(-fabsf(z)));
        const float ls = fminf(z, 0.f) - l1p, lr = fminf(-z, 0.f) - l1p;
        const float w = expf(ls + L);
        L += lr;
#pragma unroll
        for (int i = 0; i < 8; ++i) {
            const uint4 vv = *(const uint4*)(vr + i * 8);
            acc[i * 8 + 0] += w * blo(vv.x); acc[i * 8 + 1] += w * bhi(vv.x); acc[i * 8 + 2] += w * blo(vv.y); acc[i * 8 + 3] += w * bhi(vv.y);
            acc[i * 8 + 4] += w * blo(vv.z); acc[i * 8 + 5] += w * bhi(vv.z); acc[i * 8 + 6] += w * blo(vv.w); acc[i * 8 + 7] += w * bhi(vv.w);
        }
    }
    float* O = (float*)(p.ws + WS_YS) + row * D + h * 64;
#pragma unroll
    for (int i = 0; i < 16; ++i) *(float4*)(O + i * 4) = make_float4(acc[i * 4], acc[i * 4 + 1], acc[i * 4 + 2], acc[i * 4 + 3]);
}
__global__ void __launch_bounds__(64) k_moba_naive(P p) {
    const int idx = blockIdx.x * 64 + threadIdx.x;
    const int t = idx % SEQ, h = (idx / SEQ) % 8, b = idx / (SEQ * 8);
    const bf16* PR = (const bf16*)(p.ws + WS_PROJ);
    const size_t row = (size_t)b * SEQ + t;
    const int own = t >> 8;
    uint4 q[8];
#pragma unroll
    for (int i = 0; i < 8; ++i) q[i] = *(const uint4*)(PR + row * INC + C_QB + h * 64 + i * 8);
    const float* KM = (const float*)(p.ws + WS_KMEAN + 262144) + ((size_t)(b * 8 + h) * 8) * 64;
    float g[8];
#pragma unroll
    for (int j = 0; j < 8; ++j) {
        float s = -1e30f;
        if (j < own) {
            s = 0.f;
#pragma unroll
            for (int i = 0; i < 8; ++i) {
                const float* km = KM + j * 64 + i * 8;
                s += blo(q[i].x) * km[0] + bhi(q[i].x) * km[1] + blo(q[i].y) * km[2] + bhi(q[i].y) * km[3] + blo(q[i].z) * km[4] + bhi(q[i].z) * km[5] + blo(q[i].w) * km[6] + bhi(q[i].w) * km[7];
            }
        }
        g[j] = s;
    }
    unsigned selmask = 0; const int nsel = own < 3 ? own : 3;
    for (int r = 0; r < nsel; ++r) {
        float best = -3e38f; int bi = 0;
#pragma unroll
        for (int j = 0; j < 8; ++j) { const bool ok = !((selmask >> j) & 1u) && g[j] > best; if (ok) { best = g[j]; bi = j; } }
        selmask |= 1u << bi;
    }
    float acc[64];
#pragma unroll
    for (int i = 0; i < 64; ++i) acc[i] = 0.f;
    float mx = -3e38f, lsum = 0.f;
    for (int blk = 0; blk <= own; ++blk) {
        if (blk < own && !((selmask >> blk) & 1u)) continue;
        const int s1 = blk == own ? t : blk * 256 + 255;
        for (int s = blk * 256; s <= s1; ++s) {
            const bf16* kr = PR + ((size_t)b * SEQ + s) * INC + C_KB + h * 64;
            const bf16* vr = PR + ((size_t)b * SEQ + s) * INC + C_VB + h * 64;
            float z = 0.f;
#pragma unroll
            for (int i = 0; i < 8; ++i) z += dot8(q[i], *(const uint4*)(kr + i * 8));
            z *= 0.125f;
            const float mn = fmaxf(mx, z), sc = expf(mx - mn), w = expf(z - mn);
            mx = mn; lsum = lsum * sc + w;
#pragma unroll
            for (int i = 0; i < 8; ++i) {
                const uint4 vv = *(const uint4*)(vr + i * 8);
                acc[i * 8 + 0] = acc[i * 8 + 0] * sc + w * blo(vv.x); acc[i * 8 + 1] = acc[i * 8 + 1] * sc + w * bhi(vv.x);
                acc[i * 8 + 2] = acc[i * 8 + 2] * sc + w * blo(vv.y); acc[i * 8 + 3] = acc[i * 8 + 3] * sc + w * bhi(vv.y);
                acc[i * 8 + 4] = acc[i * 8 + 4] * sc + w * blo(vv.z); acc[i * 8 + 5] = acc[i * 8 + 5] * sc + w * bhi(vv.z);
                acc[i * 8 + 6] = acc[i * 8 + 6] * sc + w * blo(vv.w); acc[i * 8 + 7] = acc[i * 8 + 7] * sc + w * bhi(vv.w);
            }
        }
    }
    const float il = 1.f / lsum;
    float* O = (float*)(p.ws + WS_YS) + row * D + 256 + h * 64;
#pragma unroll
    for (int i = 0; i < 16; ++i) *(float4*)(O + i * 4) = make_float4(acc[i * 4] * il, acc[i * 4 + 1] * il, acc[i * 4 + 2] * il, acc[i * 4 + 3] * il);
}
__global__ void k_gvn_naive(P p, int l) {
    const int idx = blockIdx.x * blockDim.x + threadIdx.x;
    const int g = idx & 3, t = idx >> 2;
    const bf16* v = (const bf16*)(p.ws + WS_PROJ) + (size_t)t * INC + C_VC + g * 64;
    float s = 0.f;
    for (int d = 0; d < 64; ++d) { const float x = bf2f(v[d]); s += x * x; }
    const float rs = rsqrtf(s * (1.f / 64.f) + EPS);
    float* o = (float*)(p.ws + WS_ABUF) + (size_t)t * 256 + g * 64;
    for (int d = 0; d < 64; ++d) o[d] = bf2f(v[d]) * rs * p.g_vn[(l * 4 + g) * 64 + d];
}
__global__ void k_gmlp_naive(P p, int l) {
    const int idx = blockIdx.x * blockDim.x + threadIdx.x;
    const int d = idx & 63, g = (idx >> 6) & 3, t = idx >> 8;
    const int tc = t & 127, t0 = t - tc;
    const float* VN = (const float*)(p.ws + WS_ABUF);
    const float* w = p.w_sp + ((size_t)(l * 4 + g) * 128 + tc) * 128;
    float s = 0.f;
    for (int j = 0; j <= tc; ++j) s += w[j] * VN[(size_t)(t0 + j) * 256 + g * 64 + d];
    s += p.b_sp[(l * 4 + g) * 128 + tc];
    const float u = bf2f(((const bf16*)(p.ws + WS_PROJ))[(size_t)t * INC + C_UC + g * 64 + d]);
    ((float*)(p.ws + WS_YS))[(size_t)t * D + 768 + g * 64 + d] = u * s;
}
__global__ void k_headnorm_naive(P p, int l) {
    const int idx = blockIdx.x * blockDim.x + threadIdx.x;
    const int h = idx & 15, t = idx >> 4;
    const float* o = (const float*)(p.ws + WS_YS) + (size_t)t * D + h * 64;
    float s = 0.f;
    for (int d = 0; d < 64; ++d) s += o[d] * o[d];
    const float rs = rsqrtf(s * (1.f / 64.f) + EPS);
    bf16* on = (bf16*)(p.ws + WS_ON) + (size_t)t * D + h * 64;
    for (int d = 0; d < 64; ++d) on[d] = f2bf(o[d] * rs * p.g_head[(l * 16 + h) * 64 + d]);
}

extern "C" void kernel_launch(void* const* d_in, const int* in_sizes, int n_in, void* d_out, int out_size, void* d_ws, size_t ws_size, hipStream_t stream) {
    static int grid = 0;
    if (grid == 0) {
        if (n_in != 16 || out_size != T * D || ws_size < WS_END) { fprintf(stderr, "kernel_launch: unexpected sizes (n_in %d out %d ws %zu)\n", n_in, out_size, ws_size); grid = -1; return; }
        int dev = 0, cus = 0, per_cu = 0;
        if (hipGetDevice(&dev) != hipSuccess || hipDeviceGetAttribute(&cus, hipDeviceAttributeMultiprocessorCount, dev) != hipSuccess) { grid = -1; return; }
        if (hipFuncSetAttribute((const void*)mk, hipFuncAttributeMaxDynamicSharedMemorySize, LDS_BYTES) != hipSuccess) { fprintf(stderr, "kernel_launch: hipFuncSetAttribute failed\n"); grid = -1; return; }
        if (hipOccupancyMaxActiveBlocksPerMultiprocessor(&per_cu, (const void*)mk, NWAVES * 64, LDS_BYTES) != hipSuccess || per_cu < 1) fprintf(stderr, "kernel_launch: occupancy query says %d\n", per_cu);
        (void)hipGetLastError();
        grid = cus;
    }
    if (grid < 0) return;
    P p{};
    p.x = (const float*)d_in[0]; p.pos = (const int*)d_in[1]; p.w_in = (const float*)d_in[2]; p.w_out = (const float*)d_in[3];
    p.g_mix = (const float*)d_in[4]; p.g_head = (const float*)d_in[5]; p.g_vn = (const float*)d_in[6]; p.w_sp = (const float*)d_in[7];
    p.b_sp = (const float*)d_in[8]; p.g_ffn = (const float*)d_in[9]; p.w_rg = (const float*)d_in[10]; p.w_re = (const float*)d_in[11];
    p.w_g = (const float*)d_in[12]; p.w_u = (const float*)d_in[13]; p.w_d = (const float*)d_in[14]; p.g_fin = (const float*)d_in[15];
    p.out = (float*)d_out; p.ws = (unsigned char*)d_ws;
    (void)hipMemsetAsync((char*)d_ws + WS_CTL, 0, CTL_BYTES, stream);
    int region = 0;
#ifndef NAIVE_MIX
#define NAIVE_MIX 0
#endif
#ifndef MIX_MASK
#define MIX_MASK 7
#endif
    auto launch = [&](int lo, int hi) { hipLaunchKernelGGL(mk, dim3(grid), dim3(NWAVES * 64), LDS_BYTES, stream, p, lo, hi, region, (int)MIX_MASK); ++region; };
#if NAIVE_MIX
    int lo = 0;
    for (int l = 0; l < DEPTH; ++l) {
        const int s0 = 1 + 7 * l;
        launch(lo, s0 + 1);
        k_kmean_naive<<<BATCH * 8 * 8 * 64 / 256, 256, 0, stream>>>(p);
        k_sb_naive<<<BATCH * 4 * SEQ / 64, 64, 0, stream>>>(p);
        k_moba_naive<<<BATCH * 8 * SEQ / 64, 64, 0, stream>>>(p);
        k_gvn_naive<<<T * 4 / 256, 256, 0, stream>>>(p, l);
        k_gmlp_naive<<<T * 256 / 256, 256, 0, stream>>>(p, l);
        k_headnorm_naive<<<T * 16 / 256, 256, 0, stream>>>(p, l);
        lo = s0 + 1;
    }
    launch(lo, NSTEPS);
#else
    launch(0, NSTEPS);
#endif
}
```
